# Optimizing an MI355X kernel written in HIP

```python
import math
import jax, jax.numpy as jnp
from jax import lax
import numpy as np

D_MODEL = 1024
BATCH = 16
SEQ = 2048
DEPTH = 2

N_EVEN = (DEPTH + 1) // 2
N_ODD = DEPTH // 2
EPS = 1e-6
RET_HEADS = 4
RET_HEAD_DIM = D_MODEL // 8
RET_WIDTH = RET_HEADS * RET_HEAD_DIM
RET_CHUNK = 128
ROPE_BASE = 10000.0
LRU_WIDTH = D_MODEL // 2
LRU_BLOCKS = 4
LRU_BLOCK_DIM = LRU_WIDTH // LRU_BLOCKS
CONV_WIDTH = 4
LRU_C = 8.0
IN_EVEN_WIDTH = 4 * RET_WIDTH + 2 * LRU_WIDTH
S5_GROUP = 16
S5_GROUPS = D_MODEL // S5_GROUP
S5_STATE = 64
S5_CHUNK = 128
DT_MIN = 0.001
DT_MAX = 0.1
D_FF = 2816

kernel_name = "hybrid_retention_rglru_s5_macaron"


def rmsnorm(x, g):
    xf = x.astype(jnp.float32)
    y = xf * lax.rsqrt(jnp.mean(xf * xf, axis=-1, keepdims=True) + EPS)
    return (y * g.astype(jnp.float32)).astype(x.dtype)


def swiglu(x, w1, w3, w2):
    return (jax.nn.silu(x @ w1) * (x @ w3)) @ w2


def rope(x):
    S, Dh = x.shape[1], x.shape[-1]
    half = Dh // 2
    inv = ROPE_BASE ** (-jnp.arange(half, dtype=jnp.float32) / half)
    ang = jnp.arange(S, dtype=jnp.float32)[:, None] * inv[None, :]
    cos = jnp.cos(ang)[None, :, None, :]
    sin = jnp.sin(ang)[None, :, None, :]
    x1, x2 = x[..., :half], x[..., half:]
    return jnp.concatenate([x1 * cos - x2 * sin, x1 * sin + x2 * cos], axis=-1)


def retention_chunkwise(q, k, v):
    B_, S, H, Dh = q.shape
    C = RET_CHUNK
    N = S // C
    q = rope(q)
    k = rope(k) * (Dh ** -0.5)
    log_gamma = jnp.log1p(-jnp.power(2.0, -5.0 - jnp.arange(H, dtype=jnp.float32)))
    pos = jnp.arange(C, dtype=jnp.float32)
    diff = pos[:, None] - pos[None, :]
    decay = jnp.where(diff >= 0, jnp.exp(log_gamma[:, None, None] * jnp.maximum(diff, 0.0)), 0.0)
    qc = q.reshape(B_, N, C, H, Dh)
    kc = k.reshape(B_, N, C, H, Dh)
    vc = v.reshape(B_, N, C, H, Dh)
    scores = jnp.einsum('bnihd,bnjhd->bhnij', qc, kc) * decay[None, :, None, :, :]
    intra = jnp.einsum('bhnij,bnjhd->bnihd', scores, vc)
    k_decay = jnp.exp(log_gamma[:, None] * (C - 1.0 - pos)[None, :])
    kv = jnp.einsum('bnjhd,hj,bnjhe->nbhde', kc, k_decay, vc)
    chunk_decay = jnp.exp(log_gamma * C)[None, :, None, None]

    def step(R, kv_n):
        return R * chunk_decay + kv_n, R

    _, R_prev = lax.scan(step, jnp.zeros((B_, H, Dh, Dh), jnp.float32), kv)
    q_decay = jnp.exp(log_gamma[:, None] * (pos + 1.0)[None, :])
    cross = jnp.einsum('bnihd,hi,nbhde->bnihe', qc, q_decay, R_prev)
    return (intra + cross).reshape(B_, S, H, Dh)


def head_layernorm(x, g):
    mu = jnp.mean(x, axis=-1, keepdims=True)
    var = jnp.mean(jnp.square(x - mu), axis=-1, keepdims=True)
    y = (x - mu) * lax.rsqrt(var + EPS)
    B_, S, H, Dh = x.shape
    return y.reshape(B_, S, H * Dh) * g.astype(jnp.float32)


def causal_depthwise_conv(x, w, b):
    K = w.shape[0]
    S = x.shape[1]
    xp = jnp.pad(x, ((0, 0), (K - 1, 0), (0, 0)))
    out = b
    for tap in range(K):
        out = out + xp[:, tap:tap + S, :] * w[tap]
    return out


def rg_lru(x, w_a, b_a, w_i, b_i, lam):
    B_, S, W = x.shape
    xb = x.reshape(B_, S, LRU_BLOCKS, LRU_BLOCK_DIM)
    r = jax.nn.sigmoid(jnp.einsum('bsgi,gio->bsgo', xb, w_a.astype(jnp.float32)).reshape(B_, S, W) + b_a.astype(jnp.float32))
    i = jax.nn.sigmoid(jnp.einsum('bsgi,gio->bsgo', xb, w_i.astype(jnp.float32)).reshape(B_, S, W) + b_i.astype(jnp.float32))
    log_a = -LRU_C * r * jax.nn.softplus(-lam.astype(jnp.float32))
    a = jnp.exp(log_a)
    mult = jnp.sqrt(-jnp.expm1(2.0 * log_a))
    bx = mult * i * x

    def comb(c1, c2):
        a1, b1 = c1
        a2, b2 = c2
        return a1 * a2, a2 * b1 + b2

    _, h = lax.associative_scan(comb, (a, bx), axis=1)
    return h


def s5_ssm(u, lam_re, lam_im, log_dt, b_re, b_im, c_re, c_im, d):
    B_, S, H = u.shape
    G, P = lam_re.shape
    L = S5_CHUNK
    N = S // L
    lam_re = lam_re.astype(jnp.float32)
    lam_im = lam_im.astype(jnp.float32)
    dt = jnp.exp(log_dt.astype(jnp.float32))[:, None]
    mag = jnp.exp(lam_re * dt)
    lbar_re = mag * jnp.cos(lam_im * dt)
    lbar_im = mag * jnp.sin(lam_im * dt)
    den = lam_re * lam_re + lam_im * lam_im
    nr = lbar_re - 1.0
    ni = lbar_im
    f_re = ((nr * lam_re + ni * lam_im) / den)[..., None]
    f_im = ((ni * lam_re - nr * lam_im) / den)[..., None]
    b_re = b_re.astype(jnp.float32)
    b_im = b_im.astype(jnp.float32)
    bbar_re = f_re * b_re - f_im * b_im
    bbar_im = f_re * b_im + f_im * b_re
    c_re = c_re.astype(jnp.float32)
    c_im = c_im.astype(jnp.float32)
    a_re = jnp.broadcast_to(lbar_re, (B_, L, G, P))
    a_im = jnp.broadcast_to(lbar_im, (B_, L, G, P))
    uc = jnp.swapaxes(u.reshape(B_, N, L, G, S5_GROUP), 0, 1)

    def comb(c1, c2):
        ar1, ai1, br1, bi1 = c1
        ar2, ai2, br2, bi2 = c2
        return (ar1 * ar2 - ai1 * ai2,
                ar1 * ai2 + ai1 * ar2,
                ar2 * br1 - ai2 * bi1 + br2,
                ar2 * bi1 + ai2 * br1 + bi2)

    def chunk_step(h0, u_n):
        h0_re, h0_im = h0
        bu_re = jnp.einsum('blgc,gpc->blgp', u_n, bbar_re)
        bu_im = jnp.einsum('blgc,gpc->blgp', u_n, bbar_im)
        p_re, p_im, hl_re, hl_im = lax.associative_scan(comb, (a_re, a_im, bu_re, bu_im), axis=1)
        h_re = hl_re + p_re * h0_re[:, None] - p_im * h0_im[:, None]
        h_im = hl_im + p_re * h0_im[:, None] + p_im * h0_re[:, None]
        y = jnp.einsum('blgp,gcp->blgc', h_re, c_re) - jnp.einsum('blgp,gcp->blgc', h_im, c_im)
        return (h_re[:, -1], h_im[:, -1]), y

    h_init = (jnp.zeros((B_, G, P), jnp.float32), jnp.zeros((B_, G, P), jnp.float32))
    _, y = lax.scan(chunk_step, h_init, uc)
    y = jnp.swapaxes(y, 0, 1).reshape(B_, S, H)
    return y + d.astype(jnp.float32) * u


def even_mixer(h, w_in, w_out, ret_norm_g, conv_w, conv_b, w_a, b_a, w_i, b_i, lam):
    B_, S, _ = h.shape
    proj = (h @ w_in).astype(jnp.float32)
    q, k, v, g_ret, x_lru, g_lru = jnp.split(
        proj, [RET_WIDTH, 2 * RET_WIDTH, 3 * RET_WIDTH, 4 * RET_WIDTH, 4 * RET_WIDTH + LRU_WIDTH], axis=-1)
    shp = (B_, S, RET_HEADS, RET_HEAD_DIM)
    ret = retention_chunkwise(q.reshape(shp), k.reshape(shp), v.reshape(shp))
    ret = head_layernorm(ret, ret_norm_g) * jax.nn.silu(g_ret)
    xc = causal_depthwise_conv(x_lru, conv_w.astype(jnp.float32), conv_b.astype(jnp.float32))
    lru = rg_lru(xc, w_a, b_a, w_i, b_i, lam) * jax.nn.gelu(g_lru)
    merged = jnp.concatenate([ret, lru], axis=-1).astype(h.dtype)
    return merged @ w_out


def odd_mixer(h, lam_re, lam_im, log_dt, b_re, b_im, c_re, c_im, d, glu_w_a, glu_w_b):
    y = s5_ssm(h.astype(jnp.float32), lam_re, lam_im, log_dt, b_re, b_im, c_re, c_im, d)
    y = jax.nn.gelu(y).astype(h.dtype)
    return (y @ glu_w_a) * jax.nn.sigmoid(y @ glu_w_b)


def setup_inputs(seed: int = 0) -> dict:
    key = jax.random.key(seed)
    ks = jax.random.split(key, 32)
    f32 = jnp.float32

    def nrm(k, shape, scale):
        return jax.random.normal(k, shape, f32) * scale

    x = nrm(ks[0], (BATCH, SEQ, D_MODEL), 1.0)
    ffn_norm_g = 1.0 + nrm(ks[1], (DEPTH, 2, D_MODEL), 0.02)
    ffn_w1 = nrm(ks[2], (DEPTH, 2, D_MODEL, D_FF), D_MODEL ** -0.5)
    ffn_w3 = nrm(ks[3], (DEPTH, 2, D_MODEL, D_FF), D_MODEL ** -0.5)
    ffn_w2 = nrm(ks[4], (DEPTH, 2, D_FF, D_MODEL), D_FF ** -0.5)
    mix_norm_g = 1.0 + nrm(ks[5], (DEPTH, D_MODEL), 0.02)
    w_in_even = nrm(ks[6], (N_EVEN, D_MODEL, IN_EVEN_WIDTH), D_MODEL ** -0.5)
    w_out_even = nrm(ks[7], (N_EVEN, RET_WIDTH + LRU_WIDTH, D_MODEL), (RET_WIDTH + LRU_WIDTH) ** -0.5)
    ret_norm_g = 1.0 + nrm(ks[8], (N_EVEN, RET_WIDTH), 0.02)
    conv_w = nrm(ks[9], (N_EVEN, CONV_WIDTH, LRU_WIDTH), CONV_WIDTH ** -0.5)
    conv_b = nrm(ks[10], (N_EVEN, LRU_WIDTH), 0.01)
    lru_w_a = nrm(ks[11], (N_EVEN, LRU_BLOCKS, LRU_BLOCK_DIM, LRU_BLOCK_DIM), LRU_BLOCK_DIM ** -0.5)
    lru_b_a = nrm(ks[12], (N_EVEN, LRU_WIDTH), 0.01)
    lru_w_i = nrm(ks[13], (N_EVEN, LRU_BLOCKS, LRU_BLOCK_DIM, LRU_BLOCK_DIM), LRU_BLOCK_DIM ** -0.5)
    lru_b_i = nrm(ks[14], (N_EVEN, LRU_WIDTH), 0.01)
    a_c = jax.random.uniform(ks[15], (N_EVEN, LRU_WIDTH), f32, 0.9, 0.999)
    s = a_c ** (1.0 / LRU_C)
    lru_lambda = jnp.log(s) - jnp.log1p(-s)
    n = jnp.arange(S5_STATE, dtype=f32)
    s5_lambda_re = -0.5 + nrm(ks[16], (N_ODD, S5_GROUPS, S5_STATE), 0.01)
    s5_lambda_im = math.pi * n + nrm(ks[17], (N_ODD, S5_GROUPS, S5_STATE), 0.01)
    s5_log_dt = jax.random.uniform(ks[18], (N_ODD, S5_GROUPS), f32, math.log(DT_MIN), math.log(DT_MAX))
    s5_b_re = nrm(ks[19], (N_ODD, S5_GROUPS, S5_STATE, S5_GROUP), (2 * S5_GROUP) ** -0.5)
    s5_b_im = nrm(ks[20], (N_ODD, S5_GROUPS, S5_STATE, S5_GROUP), (2 * S5_GROUP) ** -0.5)
    s5_c_re = nrm(ks[21], (N_ODD, S5_GROUPS, S5_GROUP, S5_STATE), (2 * S5_STATE) ** -0.5)
    s5_c_im = nrm(ks[22], (N_ODD, S5_GROUPS, S5_GROUP, S5_STATE), (2 * S5_STATE) ** -0.5)
    s5_d = nrm(ks[23], (N_ODD, D_MODEL), 1.0)
    glu_w_a = nrm(ks[24], (N_ODD, D_MODEL, D_MODEL), D_MODEL ** -0.5)
    glu_w_b = nrm(ks[25], (N_ODD, D_MODEL, D_MODEL), D_MODEL ** -0.5)
    final_norm_g = 1.0 + nrm(ks[26], (D_MODEL,), 0.02)
    return {"x": x, "ffn_norm_g": ffn_norm_g, "ffn_w1": ffn_w1, "ffn_w3": ffn_w3, "ffn_w2": ffn_w2,
            "mix_norm_g": mix_norm_g, "w_in_even": w_in_even, "w_out_even": w_out_even,
            "ret_norm_g": ret_norm_g, "conv_w": conv_w, "conv_b": conv_b,
            "lru_w_a": lru_w_a, "lru_b_a": lru_b_a, "lru_w_i": lru_w_i, "lru_b_i": lru_b_i,
            "lru_lambda": lru_lambda, "s5_lambda_re": s5_lambda_re, "s5_lambda_im": s5_lambda_im,
            "s5_log_dt": s5_log_dt, "s5_b_re": s5_b_re, "s5_b_im": s5_b_im,
            "s5_c_re": s5_c_re, "s5_c_im": s5_c_im, "s5_d": s5_d,
            "glu_w_a": glu_w_a, "glu_w_b": glu_w_b, "final_norm_g": final_norm_g}


def reference(x, ffn_norm_g, ffn_w1, ffn_w3, ffn_w2, mix_norm_g, w_in_even, w_out_even,
              ret_norm_g, conv_w, conv_b, lru_w_a, lru_b_a, lru_w_i, lru_b_i, lru_lambda,
              s5_lambda_re, s5_lambda_im, s5_log_dt, s5_b_re, s5_b_im, s5_c_re, s5_c_im, s5_d,
              glu_w_a, glu_w_b, final_norm_g):
    for layer in range(DEPTH):
        x = x + 0.5 * swiglu(rmsnorm(x, ffn_norm_g[layer, 0]), ffn_w1[layer, 0], ffn_w3[layer, 0], ffn_w2[layer, 0])
        h = rmsnorm(x, mix_norm_g[layer])
        if layer % 2 == 0:
            e = layer // 2
            x = x + even_mixer(h, w_in_even[e], w_out_even[e], ret_norm_g[e], conv_w[e], conv_b[e],
                               lru_w_a[e], lru_b_a[e], lru_w_i[e], lru_b_i[e], lru_lambda[e])
        else:
            o = layer // 2
            x = x + odd_mixer(h, s5_lambda_re[o], s5_lambda_im[o], s5_log_dt[o], s5_b_re[o], s5_b_im[o],
                              s5_c_re[o], s5_c_im[o], s5_d[o], glu_w_a[o], glu_w_b[o])
        x = x + 0.5 * swiglu(rmsnorm(x, ffn_norm_g[layer, 1]), ffn_w1[layer, 1], ffn_w3[layer, 1], ffn_w2[layer, 1])
    return rmsnorm(x, final_norm_g)
```

```cpp
#include <hip/hip_runtime.h>
#include <hip/hip_cooperative_groups.h>
#include <cstdio>
#include <cstdint>
#include <cmath>
namespace cg = cooperative_groups;
namespace pg8 {
#define PG8_LAS __attribute__((address_space(3)))
typedef unsigned short bf16_t;
typedef short bf16x8 __attribute__((ext_vector_type(8)));
typedef float f32x4 __attribute__((ext_vector_type(4)));
typedef unsigned u32x4 __attribute__((ext_vector_type(4)));
constexpr int BM = 256, BK = 64, HALF = 128, HTB = HALF * BK * 2  , STAGE_BYTES = 8 * HTB, NXCD = 8, WGM = 8;

__host__ __device__ __forceinline__ int lds_byte(int r, int c) { const int st = (r >> 4) * 2 + (c >> 5), rr = r & 15, cc = c & 31, ob = rr * 64 + cc * 2; return st * 1024 + (ob ^ (((ob >> 9) & 1) << 5)); }
__host__ __device__ __forceinline__ void stage_rc(int b, int& R, int& C) { const int st = b / 1024, sb = b % 1024, swz = sb ^ (((sb >> 9) & 1) << 5); R = (st >> 1) * 16 + swz / 64; C = (st & 1) * 32 + (swz % 64) / 2; }
__host__ __device__ __forceinline__ int perm32(int rho) { const int n = rho >> 4, i = rho & 15; return 8 * (i >> 2) + 4 * n + (i & 3); }

struct Unit { int pm, pn; };
struct Gemm { const bf16_t* A; const bf16_t* Bt; int M, N, K; };

struct StaticOrder {
    int nM, nN, nwg, G, c;
    __host__ __device__ void init(int M, int N, int G_, int c_) { nM = M / BM; nN = N / BM; nwg = nM * nN; G = G_; c = c_; }
    __host__ __device__ bool next(int i, Unit& u) const {
        const long L = (long)i * G + c; if (L >= nwg) return false;
        int wgid = (int)L; { const int q = nwg / NXCD, r = nwg % NXCD, xcd = wgid % NXCD, off = wgid / NXCD; wgid = (xcd < r ? xcd * (q + 1) : r * (q + 1) + (xcd - r) * q) + off; }
        const int nig = WGM * nN, gid = wgid / nig, fm = gid * WGM, gsz = (nM - fm) < WGM ? (nM - fm) : WGM;
        u.pm = fm + ((wgid % nig) % gsz); u.pn = (wgid % nig) / gsz; return true;
    }
    __device__ __forceinline__ void a_ready(const Unit&) const {}
    __device__ __forceinline__ void done(const Unit&) const {}
};

__device__ __forceinline__ unsigned cvt_pk_bf16(float lo, float hi) { unsigned r; asm volatile("v_cvt_pk_bf16_f32 %0, %1, %2" : "=v"(r) : "v"(lo), "v"(hi)); return r; }
__device__ __forceinline__ u32x4 pack8(const f32x4 a, const f32x4 b) { u32x4 w; w.x = cvt_pk_bf16(a[0], a[1]); w.y = cvt_pk_bf16(a[2], a[3]); w.z = cvt_pk_bf16(b[0], b[1]); w.w = cvt_pk_bf16(b[2], b[3]); return w; }
__device__ __forceinline__ float fast_rcp(float x) { return __builtin_amdgcn_rcpf(x); }
__device__ __forceinline__ float fast_exp2(float x) { return __builtin_amdgcn_exp2f(x); }
__device__ __forceinline__ float sigmoid_f(float x) { return fast_rcp(1.0f + fast_exp2(-1.4426950409f * x)); }
__device__ __forceinline__ float silu_f(float x) { return x * sigmoid_f(x); }
__device__ __forceinline__ float gelu_tanh_f(float v) { const float u = v + 0.044715f * v * v * v; return v * sigmoid_f(1.5957691216f * u); }
__device__ __forceinline__ float row_rs(const float* ssp, int nparts, int row) {
    const f32x4* p = (const f32x4*)(ssp + (size_t)row * 32); float s = 0.f;
#pragma unroll
    for (int i = 0; i < 4; ++i) { const f32x4 v = p[i]; s += (v[0] + v[1]) + (v[2] + v[3]); }
    if (nparts > 16) {
#pragma unroll
        for (int i = 4; i < 8; ++i) { const f32x4 v = p[i]; s += (v[0] + v[1]) + (v[2] + v[3]); } }
    return 1.0f / sqrtf(s * (1.0f / 1024.0f) + 1e-6f);
}
__device__ __forceinline__ void row_rs8(float (&rs)[8], const float* ssp, int nparts, int row0) {
#pragma unroll
    for (int i = 0; i < 8; ++i) { rs[i] = row_rs(ssp, nparts, row0 + (i >> 2) * HALF + (i & 3) * 16); asm volatile("" : "+v"(rs[i]) :: "memory"); }
}

struct EpiSwiglu {
    static constexpr bool PERM = true, AFTER_DRAIN = false;
    bf16_t* O; int ldo; const float* ssp; int nparts;
    __device__ __forceinline__ void operator()(const f32x4 (&acc)[2][2][4][2], const Unit& u, int wr, int wc, int fr, int fq) const {
        const int row0 = u.pm * BM + wr * 64 + fr, col0 = u.pn * 128 + wc * 32 + 8 * fq;
        float rs8[8]; row_rs8(rs8, ssp, nparts, row0);
#pragma unroll
        for (int ai = 0; ai < 2; ++ai)
#pragma unroll
            for (int m = 0; m < 4; ++m) { const int row = row0 + ai * HALF + m * 16; const float rs = rs8[ai * 4 + m];
                f32x4 h[2];
#pragma unroll
                for (int n = 0; n < 2; ++n)
#pragma unroll
                    for (int t = 0; t < 4; ++t) { const float a = acc[ai][0][m][n][t] * rs, b = acc[ai][1][m][n][t] * rs; h[n][t] = silu_f(a) * b; }
                *(u32x4*)(O + (size_t)row * ldo + col0) = pack8(h[0], h[1]); asm volatile("" ::: "memory"); }
    }
};
struct EpiResid {
    static constexpr bool PERM = true, AFTER_DRAIN = false;
    const float* xin; float* xout; bf16_t* xb; float* ssp; float alpha;
    __device__ __forceinline__ void operator()(const f32x4 (&acc)[2][2][4][2], const Unit& u, int wr, int wc, int fr, int fq) const {
        const int row0 = u.pm * BM + wr * 64 + fr, col0 = u.pn * BM + wc * 32 + 8 * fq;
#pragma unroll
        for (int ai = 0; ai < 2; ++ai)
#pragma unroll
            for (int m = 0; m < 4; ++m) { const int row = row0 + ai * HALF + m * 16; float ss = 0.f;
#pragma unroll
                for (int bj = 0; bj < 2; ++bj) { const size_t off = (size_t)row * 1024 + col0 + bj * HALF;
                    const f32x4 o0 = *(const f32x4*)(xin + off), o1 = *(const f32x4*)(xin + off + 4);
                    const f32x4 v0 = o0 + alpha * acc[ai][bj][m][0], v1 = o1 + alpha * acc[ai][bj][m][1];
                    *(f32x4*)(xout + off) = v0; *(f32x4*)(xout + off + 4) = v1; *(u32x4*)(xb + off) = pack8(v0, v1);
                    ss += (v0[0] * v0[0] + v0[1] * v0[1]) + (v0[2] * v0[2] + v0[3] * v0[3]) + (v1[0] * v1[0] + v1[1] * v1[1]) + (v1[2] * v1[2] + v1[3] * v1[3]); }
                ss += __shfl_xor(ss, 16); ss += __shfl_xor(ss, 32);
                if (fq == 0) ssp[(size_t)row * 32 + 4 * u.pn + wc] = ss; asm volatile("" ::: "memory"); }
    }
};
struct EpiGluResid {
    static constexpr bool PERM = true, AFTER_DRAIN = false;
    const float* xin; float* xout; bf16_t* xb; float* ssp;
    __device__ __forceinline__ void operator()(const f32x4 (&acc)[2][2][4][2], const Unit& u, int wr, int wc, int fr, int fq) const {
        const int row0 = u.pm * BM + wr * 64 + fr, col0 = u.pn * 128 + wc * 32 + 8 * fq;
#pragma unroll
        for (int ai = 0; ai < 2; ++ai)
#pragma unroll
            for (int m = 0; m < 4; ++m) { const int row = row0 + ai * HALF + m * 16; const size_t off = (size_t)row * 1024 + col0;
                const f32x4 o0 = *(const f32x4*)(xin + off), o1 = *(const f32x4*)(xin + off + 4); f32x4 v0, v1;
#pragma unroll
                for (int t = 0; t < 4; ++t) { v0[t] = o0[t] + acc[ai][0][m][0][t] * sigmoid_f(acc[ai][1][m][0][t]); v1[t] = o1[t] + acc[ai][0][m][1][t] * sigmoid_f(acc[ai][1][m][1][t]); }
                *(f32x4*)(xout + off) = v0; *(f32x4*)(xout + off + 4) = v1; *(u32x4*)(xb + off) = pack8(v0, v1);
                float ss = (v0[0] * v0[0] + v0[1] * v0[1]) + (v0[2] * v0[2] + v0[3] * v0[3]) + (v1[0] * v1[0] + v1[1] * v1[1]) + (v1[2] * v1[2] + v1[3] * v1[3]);
                ss += __shfl_xor(ss, 16); ss += __shfl_xor(ss, 32);
                if (fq == 0) ssp[(size_t)row * 32 + 4 * u.pn + wc] = ss; asm volatile("" ::: "memory"); }
    }
};
struct EpiPlain {
    static constexpr bool PERM = true, AFTER_DRAIN = false;
    bf16_t* O; int ldo;
    __device__ __forceinline__ void operator()(const f32x4 (&acc)[2][2][4][2], const Unit& u, int wr, int wc, int fr, int fq) const {
        const int row0 = u.pm * BM + wr * 64 + fr, col0 = u.pn * BM + wc * 32 + 8 * fq;
#pragma unroll
        for (int ai = 0; ai < 2; ++ai)
#pragma unroll
            for (int m = 0; m < 4; ++m) { bf16_t* rowp = O + (size_t)(row0 + ai * HALF + m * 16) * ldo + col0;
#pragma unroll
                for (int bj = 0; bj < 2; ++bj) *(u32x4*)(rowp + bj * HALF) = pack8(acc[ai][bj][m][0], acc[ai][bj][m][1]); }
    }
};
__device__ __forceinline__ float lg_gamma(int h) { return h == 0 ? -0.04580368961312479f : h == 1 ? -0.02272007650008353f : h == 2 ? -0.011315313227834146f : -0.005646563141142063f; }
struct EpiRope {
    static constexpr bool PERM = true, AFTER_DRAIN = false;
    bf16_t* Q; bf16_t* K; const float* rope; const float* ssp; int nparts;
    __device__ __forceinline__ void operator()(const f32x4 (&acc)[2][2][4][2], const Unit& u, int wr, int wc, int fr, int fq) const {
        typedef unsigned u32x2 __attribute__((ext_vector_type(2)));
        const int row0 = u.pm * BM + wr * 64 + fr;
        const int head = 2 * (u.pn & 1) + (wc >> 1), jj0 = (wc & 1) * 32 + 8 * fq; bf16_t* dst = (u.pn < 2) ? Q : K;
        const float lg = lg_gamma(head);
#pragma unroll
        for (int ai = 0; ai < 2; ++ai)
#pragma unroll
            for (int m = 0; m < 4; ++m) { const int row = row0 + ai * HALF + m * 16, pos = row & 2047; const float rs = row_rs(ssp, nparts, row);
                const float sc = (u.pn < 2) ? rs * fast_exp2(lg * (float)(pos & 127)) : rs * rs * 0.08838834764831845f * fast_exp2(-lg * (float)(pos & 127));
                const f32x4* rp = (const f32x4*)(rope + ((size_t)pos * 64 + jj0) * 2);
                bf16_t* rowp = dst + (size_t)row * 512 + head * 128 + jj0;
#pragma unroll
                for (int n = 0; n < 2; ++n) { const f32x4 cs0 = rp[2 * n], cs1 = rp[2 * n + 1]; const f32x4 x1 = acc[ai][0][m][n] * sc, x2 = acc[ai][1][m][n] * sc; f32x4 o1, o2;
                    o1[0] = x1[0] * cs0[0] - x2[0] * cs0[1]; o2[0] = x1[0] * cs0[1] + x2[0] * cs0[0];
                    o1[1] = x1[1] * cs0[2] - x2[1] * cs0[3]; o2[1] = x1[1] * cs0[3] + x2[1] * cs0[2];
                    o1[2] = x1[2] * cs1[0] - x2[2] * cs1[1]; o2[2] = x1[2] * cs1[1] + x2[2] * cs1[0];
                    o1[3] = x1[3] * cs1[2] - x2[3] * cs1[3]; o2[3] = x1[3] * cs1[3] + x2[3] * cs1[2];
                    u32x2 w1, w2; w1.x = cvt_pk_bf16(o1[0], o1[1]); w1.y = cvt_pk_bf16(o1[2], o1[3]); w2.x = cvt_pk_bf16(o2[0], o2[1]); w2.y = cvt_pk_bf16(o2[2], o2[3]);
                    *(u32x2*)(rowp + 4 * n) = w1; *(u32x2*)(rowp + 64 + 4 * n) = w2; asm volatile("" ::: "memory"); } }
    }
};
struct EpiScaled {
    static constexpr bool PERM = true, AFTER_DRAIN = false;
    bf16_t* O; int ldo; const float* ssp; int nparts;
    __device__ __forceinline__ void operator()(const f32x4 (&acc)[2][2][4][2], const Unit& u, int wr, int wc, int fr, int fq) const {
        const int row0 = u.pm * BM + wr * 64 + fr, col0 = u.pn * BM + wc * 32 + 8 * fq;
#pragma unroll
        for (int ai = 0; ai < 2; ++ai)
#pragma unroll
            for (int m = 0; m < 4; ++m) { const int row = row0 + ai * HALF + m * 16; const float rs = row_rs(ssp, nparts, row); bf16_t* rowp = O + (size_t)row * ldo + col0;
#pragma unroll
                for (int bj = 0; bj < 2; ++bj) *(u32x4*)(rowp + bj * HALF) = pack8(acc[ai][bj][m][0] * rs, acc[ai][bj][m][1] * rs);
                asm volatile("" ::: "memory"); }
    }
};
template <class Epi, class Sched, bool ALIGN_EPI = false, bool SP2 = false>
__device__ __forceinline__ void gemm_phase(PG8_LAS unsigned char* lds, const Gemm g, const Sched& S, const Epi& E) {
    int tid_ = threadIdx.x; asm volatile("" : "+v"(tid_));
    const int tid = tid_, wid = __builtin_amdgcn_readfirstlane(tid >> 6), lane = tid & 63, wr = wid >> 2, wc = wid & 3, fr = lane & 15, fq = lane >> 4;
    const int K = g.K, nt = K / BK;
    unsigned voffA[2], voffB[2];
#pragma unroll
    for (int i = 0; i < 2; ++i) { int R, C; stage_rc(tid * 16 + i * 8192, R, C); const int Rb = Epi::PERM ? ((R & ~31) + perm32(R & 31)) : R;
        voffA[i] = (unsigned)(R * K + C) * 2u; voffB[i] = (unsigned)(Rb * K + C) * 2u; }
    const size_t kstep = (size_t)(BK * 2);
    const size_t hstep = (size_t)HALF * K * 2;
    const size_t tstep = 2 * hstep;
    const unsigned ldsw = (unsigned)wid * 1024u;
    const int aoff = lds_byte(wr * 64 + fr, fq * 8), boff = lds_byte(wc * 32 + fr, fq * 8);
#define PG8_SA(b, h) (((b) * 2 + (h)) * HTB)
#define PG8_SB(b, h) ((4 + (b) * 2 + (h)) * HTB)
#define PG8_STAGE(bufoff, gbase, voff) do { _Pragma("unroll") for (int _i = 0; _i < 2; ++_i) \
        __builtin_amdgcn_global_load_lds((const unsigned*)((const char*)(gbase) + (voff)[_i]), (PG8_LAS unsigned*)(lds + (bufoff) + ldsw + _i * 8192), 16, 0, 0); } while (0)
#define PG8_LDA(dst, b, h) do { _Pragma("unroll") for (int m = 0; m < 4; ++m) _Pragma("unroll") for (int k = 0; k < 2; ++k) dst[m][k] = *(const PG8_LAS bf16x8*)(lds + PG8_SA(b, h) + aoff + m * 2048 + k * 1024); } while (0)
#define PG8_LDB(dst, b, h) do { _Pragma("unroll") for (int n = 0; n < 2; ++n) _Pragma("unroll") for (int k = 0; k < 2; ++k) dst[n][k] = *(const PG8_LAS bf16x8*)(lds + PG8_SB(b, h) + boff + n * 2048 + k * 1024); } while (0)
#define PG8_MMA(ai, bj, At, Bt) do { __builtin_amdgcn_s_setprio(1); _Pragma("unroll") for (int m = 0; m < 4; ++m) _Pragma("unroll") for (int n = 0; n < 2; ++n) _Pragma("unroll") for (int k = 0; k < 2; ++k) \
        acc[ai][bj][m][n] = __builtin_amdgcn_mfma_f32_16x16x32_bf16(Bt[n][k], At[m][k], acc[ai][bj][m][n], 0, 0, 0); __builtin_amdgcn_s_setprio(0); } while (0)
#define PG8_WAIT_V(n) asm volatile("s_waitcnt vmcnt(" #n ")" ::: "memory")
#define PG8_WAIT_L(n) asm volatile("s_waitcnt lgkmcnt(" #n ")" ::: "memory")
#define PG8_BAR __builtin_amdgcn_s_barrier()
#define PG8_SCHED __builtin_amdgcn_sched_barrier(0)
    Unit cur, nxt; int ui = 0;
    if (!S.next(0, cur)) return;
    f32x4 acc[2][2][4][2];
#pragma unroll
    for (int a = 0; a < 2; ++a)
#pragma unroll
        for (int b = 0; b < 2; ++b)
#pragma unroll
            for (int m = 0; m < 4; ++m)
#pragma unroll
                for (int n = 0; n < 2; ++n) acc[a][b][m][n] = (f32x4){0.f, 0.f, 0.f, 0.f};
    bf16x8 At[4][2], B0[2][2], B1[2][2];
    const char* cA = (const char*)g.A + (size_t)cur.pm * tstep; const char* cB = (const char*)g.Bt + (size_t)cur.pn * tstep;
    S.a_ready(cur);
    if constexpr (SP2) {
        PG8_STAGE(PG8_SB(0, 0), cB, voffB); PG8_STAGE(PG8_SB(0, 1), cB + hstep, voffB); PG8_STAGE(PG8_SA(0, 0), cA, voffA); PG8_STAGE(PG8_SA(0, 1), cA + hstep, voffA);
        if (wr == 1) PG8_BAR;
        PG8_WAIT_V(2); PG8_BAR;
        PG8_STAGE(PG8_SB(1, 0), cB + kstep, voffB); PG8_STAGE(PG8_SA(1, 0), cA + kstep, voffA); PG8_STAGE(PG8_SB(1, 1), cB + hstep + kstep, voffB);
        PG8_WAIT_V(6); PG8_BAR;
    } else {
        PG8_STAGE(PG8_SB(0, 0), cB, voffB); PG8_STAGE(PG8_SA(0, 0), cA, voffA); PG8_STAGE(PG8_SB(0, 1), cB + hstep, voffB); PG8_STAGE(PG8_SA(0, 1), cA + hstep, voffA);
        if (wr == 1) PG8_BAR;
        PG8_WAIT_V(4); PG8_BAR;
        PG8_STAGE(PG8_SB(1, 0), cB + kstep, voffB); PG8_STAGE(PG8_SA(1, 0), cA + kstep, voffA); PG8_STAGE(PG8_SB(1, 1), cB + hstep + kstep, voffB);
        PG8_WAIT_V(6); PG8_BAR;
    }
    for (;;) {
        const bool has_next = S.next(ui + 1, nxt);
        const char* nA = has_next ? (const char*)g.A + (size_t)nxt.pm * tstep : cA; const char* nB = has_next ? (const char*)g.Bt + (size_t)nxt.pn * tstep : cB;
        for (int t = 0; t < nt; t += 2) {
            const bool last = (t == nt - 2);
            const char* a1 = cA + (size_t)(t + 1) * kstep;
            const char* a2 = last ? nA : cA + (size_t)(t + 2) * kstep; const char* b2 = last ? nB : cB + (size_t)(t + 2) * kstep;
            const char* a3 = a2 + kstep; const char* b3 = b2 + kstep;
            if (last && has_next) S.a_ready(nxt);
            if constexpr (SP2) {
            PG8_LDB(B0, 0, 0); PG8_LDB(B1, 0, 1); PG8_SCHED; PG8_LDA(At, 0, 0); PG8_STAGE(PG8_SA(1, 1), a1 + hstep, voffA);
            PG8_WAIT_V(8); PG8_WAIT_L(0); PG8_BAR; PG8_MMA(0, 0, At, B0); PG8_MMA(0, 1, At, B1); PG8_BAR; PG8_SCHED;
            PG8_LDA(At, 0, 1); PG8_STAGE(PG8_SB(0, 0), b2, voffB); PG8_STAGE(PG8_SB(0, 1), b2 + hstep, voffB); PG8_STAGE(PG8_SA(0, 0), a2, voffA);
            PG8_WAIT_V(8); PG8_WAIT_L(0); PG8_BAR; PG8_MMA(1, 0, At, B0); PG8_MMA(1, 1, At, B1); PG8_BAR; PG8_SCHED;
            PG8_LDB(B0, 1, 0); PG8_LDB(B1, 1, 1); PG8_SCHED; PG8_LDA(At, 1, 0); PG8_STAGE(PG8_SA(0, 1), a2 + hstep, voffA);
            PG8_WAIT_V(8); PG8_WAIT_L(0); PG8_BAR; PG8_MMA(0, 0, At, B0); PG8_MMA(0, 1, At, B1); PG8_BAR; PG8_SCHED;
            PG8_LDA(At, 1, 1); PG8_STAGE(PG8_SB(1, 0), b3, voffB); PG8_STAGE(PG8_SB(1, 1), b3 + hstep, voffB); PG8_STAGE(PG8_SA(1, 0), a3, voffA);
            PG8_WAIT_V(8); PG8_WAIT_L(0); PG8_BAR; PG8_MMA(1, 0, At, B0); PG8_MMA(1, 1, At, B1); PG8_BAR; PG8_SCHED;
            } else {
            PG8_LDB(B0, 0, 0); PG8_SCHED; PG8_LDA(At, 0, 0); PG8_STAGE(PG8_SA(1, 1), a1 + hstep, voffA);
            PG8_WAIT_L(8); PG8_BAR; PG8_WAIT_L(0); PG8_MMA(0, 0, At, B0); PG8_BAR; PG8_SCHED;
            PG8_LDB(B1, 0, 1); PG8_STAGE(PG8_SB(0, 0), b2, voffB);
            PG8_BAR; PG8_WAIT_L(0); PG8_MMA(0, 1, At, B1); PG8_BAR;
            PG8_LDA(At, 0, 1); PG8_STAGE(PG8_SA(0, 0), a2, voffA);
            PG8_BAR; PG8_WAIT_L(0); PG8_MMA(1, 0, At, B0); PG8_BAR; PG8_SCHED;
            PG8_STAGE(PG8_SB(0, 1), b2 + hstep, voffB);
            PG8_WAIT_V(6); PG8_BAR; PG8_MMA(1, 1, At, B1); PG8_BAR;
            PG8_LDB(B0, 1, 0); PG8_SCHED; PG8_LDA(At, 1, 0); PG8_STAGE(PG8_SA(0, 1), a2 + hstep, voffA);
            PG8_WAIT_L(8); PG8_BAR; PG8_WAIT_L(0); PG8_MMA(0, 0, At, B0); PG8_BAR; PG8_SCHED;
            PG8_LDB(B1, 1, 1); PG8_STAGE(PG8_SB(1, 0), b3, voffB);
            PG8_BAR; PG8_WAIT_L(0); PG8_MMA(0, 1, At, B1); PG8_BAR;
            PG8_LDA(At, 1, 1); PG8_STAGE(PG8_SA(1, 0), a3, voffA);
            PG8_BAR; PG8_WAIT_L(0); PG8_MMA(1, 0, At, B0); PG8_BAR; PG8_SCHED;
            PG8_STAGE(PG8_SB(1, 1), b3 + hstep, voffB);
            PG8_WAIT_V(6); PG8_BAR; PG8_MMA(1, 1, At, B1); PG8_BAR;
            }
        }
        if constexpr (ALIGN_EPI) { if (wr == 0) PG8_BAR; }
        if constexpr (!Epi::AFTER_DRAIN) { E(acc, cur, wr, wc, fr, fq); S.done(cur); }
        if (!has_next) break;
#pragma unroll
        for (int a = 0; a < 2; ++a)
#pragma unroll
            for (int b = 0; b < 2; ++b)
#pragma unroll
                for (int m = 0; m < 4; ++m)
#pragma unroll
                    for (int n = 0; n < 2; ++n) acc[a][b][m][n] = (f32x4){0.f, 0.f, 0.f, 0.f};
        cur = nxt; cA = nA; cB = nB; ++ui;
        if constexpr (ALIGN_EPI) { if (wr == 1) PG8_BAR; }
    }
    PG8_WAIT_V(0);
    if constexpr (!ALIGN_EPI) { if (wr == 0) PG8_BAR; }
    PG8_BAR;
    if constexpr (Epi::AFTER_DRAIN) { E.fused(acc, cur, wr, wc, fr, fq, lds, wid, lane); S.done(cur); }
#undef PG8_SA
#undef PG8_SB
#undef PG8_STAGE
#undef PG8_LDA
#undef PG8_LDB
#undef PG8_MMA
#undef PG8_WAIT_V
#undef PG8_WAIT_L
#undef PG8_BAR
#undef PG8_SCHED
}
}

#define GAS __attribute__((address_space(1)))
#define LAS __attribute__((address_space(3)))
typedef unsigned short bf16;
typedef unsigned v4u __attribute__((ext_vector_type(4)));
typedef unsigned v2u __attribute__((ext_vector_type(2)));
typedef float f32x4 __attribute__((ext_vector_type(4)));
typedef float f32x2 __attribute__((ext_vector_type(2)));
typedef float f32x16 __attribute__((ext_vector_type(16)));
typedef short bf16x8 __attribute__((ext_vector_type(8)));
#define LDS_WAIT() asm volatile("s_waitcnt lgkmcnt(0)" ::: "memory")
using pg8::cvt_pk_bf16; using pg8::pack8; using pg8::sigmoid_f; using pg8::silu_f; using pg8::gelu_tanh_f; using pg8::row_rs; using pg8::fast_exp2;

#ifndef PHM
#define PHM 255
#endif
#ifndef MK_PER_PHASE
#define MK_PER_PHASE 1
#endif
constexpr int NWAVES = 8;
constexpr int BATCH = 16, SEQ = 2048, D = 1024, FF = 2816, TOK = BATCH * SEQ;
constexpr int NPH = 15;
constexpr size_t MiB = 1u << 20;
constexpr size_t WS_W13 = 1 * MiB;
constexpr size_t WS_W2 = 45 * MiB;
constexpr size_t WS_WIN = 67 * MiB;
constexpr size_t WS_WV = 72 * MiB;
constexpr size_t WS_WOUT = 73 * MiB;
constexpr size_t WS_WGLU = 75 * MiB;
constexpr size_t WS_WLRU = 79 * MiB;
constexpr size_t WS_ROPE = 80 * MiB;
constexpr size_t WS_SSP = 81 * MiB;
constexpr size_t WS_XB = 96 * MiB;
constexpr size_t WS_R1 = 160 * MiB;
constexpr size_t WS_Q = WS_R1, WS_K = WS_R1 + 32 * MiB, WS_VT = WS_R1 + 64 * MiB, WS_G = WS_R1 + 96 * MiB;
constexpr size_t WS_MRG = 352 * MiB;
constexpr size_t WS_END = 416 * MiB;
constexpr int LDS_BYTES = 135168;

__device__ __forceinline__ unsigned f2bf(float f) { unsigned u = __builtin_bit_cast(unsigned, f); return (u + 0x7fffu + ((u >> 16) & 1u)) >> 16; }
__device__ __forceinline__ unsigned pk2(float lo, float hi) { return f2bf(lo) | (f2bf(hi) << 16); }
__device__ __forceinline__ float bf_lo(unsigned w) { return __builtin_bit_cast(float, w << 16); }
__device__ __forceinline__ float bf_hi(unsigned w) { return __builtin_bit_cast(float, w & 0xffff0000u); }
__device__ __forceinline__ float bf1(bf16 h) { return __builtin_bit_cast(float, (unsigned)h << 16); }
__device__ __forceinline__ float wave_sum(float v) {
#pragma unroll
    for (int o = 1; o < 64; o <<= 1) v += __shfl_xor(v, o);
    return v;
}
__device__ __forceinline__ f32x4 mfma16(bf16x8 a, bf16x8 b, f32x4 c) { return __builtin_amdgcn_mfma_f32_16x16x32_bf16(a, b, c, 0, 0, 0); }

__device__ __forceinline__ void transpose_item(const float* __restrict__ W, int N, int K, const float* __restrict__ gk, bf16* WT, int dst_row, int k0, int n0, LAS float* scr, int lane) {
#pragma unroll 8
    for (int i = 0; i < 32; ++i) { const int kk = 2 * i + (lane >> 5); float v = W[(size_t)(k0 + kk) * N + n0 + (lane & 31)]; if (gk) v *= gk[k0 + kk]; scr[kk * 33 + (lane & 31)] = v; }
    LDS_WAIT(); asm volatile("" ::: "memory");
    const int c = lane & 7;
#pragma unroll
    for (int j = 0; j < 4; ++j) { const int n = (lane >> 3) + 8 * j; const LAS float* s = scr + (8 * c) * 33 + n;
        v4u o; o.x = pk2(s[0 * 33], s[1 * 33]); o.y = pk2(s[2 * 33], s[3 * 33]); o.z = pk2(s[4 * 33], s[5 * 33]); o.w = pk2(s[6 * 33], s[7 * 33]);
        *(v4u*)(WT + (size_t)(dst_row + n) * K + k0 + 8 * c) = o; }
    LDS_WAIT(); asm volatile("" ::: "memory");
}
struct Args { const float* in[27]; float* out; unsigned char* ws; int ph_lo, ph_hi; };
typedef const __attribute__((address_space(4))) Args* KArgP;

__device__ __forceinline__ void p0_prologue(KArgP ap, LAS unsigned char* lds, int gw, int NGW, int wave, int lane) {
    LAS float* scr = (LAS float*)(lds + wave * 16384);
    unsigned char* ws = ap->ws;
    constexpr int I_F = 1408, I_IN = 1536, I_OUT = 512, I_GL = 512, I_LRU = 64;
    constexpr int NITEMS = 12 * I_F + I_IN + I_OUT + 2 * I_GL + I_LRU;
    for (int it = gw; it < NITEMS; it += NGW) {
        int r = it;
        if (r < 8 * I_F) { const int w3 = r >= 4 * I_F; if (w3) r -= 4 * I_F; const int l = r / I_F; r -= l * I_F; const int kb = r / 88, nb = r % 88, n0 = 32 * nb;
            transpose_item(ap->in[w3 ? 3 : 2] + (size_t)l * D * FF, FF, D, ap->in[1] + l * D, (bf16*)(ws + WS_W13) + (size_t)l * 5632 * 1024, 256 * (n0 >> 7) + (n0 & 127) + (w3 ? 128 : 0), 64 * kb, n0, scr, lane); continue; }
        r -= 8 * I_F;
        if (r < 4 * I_F) { const int l = r / I_F; r -= l * I_F; const int kb = r / 32, nb = r % 32;
            transpose_item(ap->in[4] + (size_t)l * FF * D, D, FF, nullptr, (bf16*)(ws + WS_W2) + (size_t)l * 1024 * FF, 32 * nb, 64 * kb, 32 * nb, scr, lane); continue; }
        r -= 4 * I_F;
        if (r < I_IN) { const int kb = r / 96, nb = r % 96, n0 = 32 * nb; bf16* dst; int drow;
            if (n0 < 1024) { const int sec = n0 >> 9, nn = n0 & 511, h = nn >> 7, bj = (nn >> 6) & 1, jj0 = nn & 63; dst = (bf16*)(ws + WS_WIN); drow = 512 * sec + 256 * (h >> 1) + 128 * bj + 64 * (h & 1) + jj0; }
            else if (n0 < 1536) { dst = (bf16*)(ws + WS_WV); drow = n0 - 1024; }
            else { dst = (bf16*)(ws + WS_WIN); drow = n0 - 512; }
            transpose_item(ap->in[6], 3072, D, ap->in[5], dst, drow, 64 * kb, n0, scr, lane); continue; }
        r -= I_IN;
        if (r < I_OUT) { const int kb = r / 32, nb = r % 32; transpose_item(ap->in[7], D, D, nullptr, (bf16*)(ws + WS_WOUT), 32 * nb, 64 * kb, 32 * nb, scr, lane); continue; }
        r -= I_OUT;
        if (r < 2 * I_GL) { const int wb = r >= I_GL; if (wb) r -= I_GL; const int kb = r / 32, nb = r % 32, n0 = 32 * nb;
            transpose_item(ap->in[wb ? 25 : 24], D, D, nullptr, (bf16*)(ws + WS_WGLU), 256 * (n0 >> 7) + (n0 & 127) + (wb ? 128 : 0), 64 * kb, n0, scr, lane); continue; }
        r -= 2 * I_GL;
        { const int mat = r >> 3, g = mat >> 1, gate = mat & 1, kb = (r >> 2) & 1, nb = r & 3;
            transpose_item(ap->in[gate ? 13 : 11] + (size_t)g * 128 * 128, 128, 128, nullptr, (bf16*)(ws + WS_WLRU) + (size_t)mat * 128 * 128, 32 * nb, 64 * kb, 32 * nb, scr, lane); }
    }
    { float* rope = (float*)(ws + WS_ROPE);
      for (int i = gw * 64 + lane; i < 2048 * 64; i += NGW * 64) { const int pos = i >> 6, j = i & 63; const double inv = pow(10000.0, -(double)j / 64.0); const double ang = (double)pos * inv;
          rope[2 * i] = (float)cos(ang); rope[2 * i + 1] = (float)sin(ang); } }
    { const float* x = ap->in[0]; bf16* xb = (bf16*)(ws + WS_XB); float* ssp = (float*)(ws + WS_SSP);
      for (int m = gw; m < TOK; m += NGW) { const f32x4* xr = (const f32x4*)(x + (size_t)m * D) + lane; f32x4 v[4]; float s = 0.f;
#pragma unroll
          for (int j = 0; j < 4; ++j) { v[j] = xr[64 * j]; s += (v[j][0] * v[j][0] + v[j][1] * v[j][1]) + (v[j][2] * v[j][2] + v[j][3] * v[j][3]); }
          s = wave_sum(s);
          v2u* o8 = (v2u*)(xb + (size_t)m * D) + lane;
#pragma unroll
          for (int j = 0; j < 4; ++j) { v2u w; w.x = cvt_pk_bf16(v[j][0], v[j][1]); w.y = cvt_pk_bf16(v[j][2], v[j][3]); o8[64 * j] = w; }
          if (lane < 16) ssp[(size_t)m * 32 + lane] = lane == 0 ? s : 0.f; } }
}

__device__ __forceinline__ void ret_unit(int b, int h, int p, const bf16* Q, const bf16* Kb, const bf16* Vt, const bf16* G, const float* ret_g, bf16* MRG, LAS unsigned char* lds, int tid, int wid, int lane) {
    const int fr = lane & 15, fq = lane >> 4;
    const int cq = 2 * p + (wid >> 2), iloc0 = 32 * (wid & 3);
    const size_t tok0 = (size_t)b * SEQ + 256 * p + 32 * wid;
    const float lg = log2f(1.0f - exp2f(-5.0f - (float)h));
    bf16x8 qf[2][4];
#pragma unroll
    for (int mi = 0; mi < 2; ++mi)
#pragma unroll
        for (int kk = 0; kk < 4; ++kk) qf[mi][kk] = *(const bf16x8*)(Q + (tok0 + 16 * mi + fr) * 512 + h * 128 + 32 * kk + 8 * fq);
    f32x4 O[2][8];
#pragma unroll
    for (int mi = 0; mi < 2; ++mi)
#pragma unroll
        for (int e = 0; e < 8; ++e) O[mi][e] = (f32x4){0.f, 0.f, 0.f, 0.f};
    const int nm = 2 * p + 2;
    const int srow = 4 * wid + (lane >> 4), keyK = ((wid >> 1) & 3) * 4 + (lane >> 4), keyV = 4 * (wid & 3) + (lane >> 4);
    const bf16* kbase = Kb + ((size_t)b * SEQ + srow) * 512 + h * 128 + 8 * ((lane & 15) ^ keyK);
    const bf16* vbase = Vt + ((size_t)(h * 128 + srow)) * TOK + (size_t)b * SEQ + 8 * ((lane & 15) ^ keyV);
#define RET_STAGE(m_, buf_) do { _Pragma("unroll") for (int i = 0; i < 4; ++i) { \
        __builtin_amdgcn_global_load_lds((const unsigned*)(kbase + ((size_t)(128 * (m_) + 32 * i)) * 512), (LAS unsigned*)(lds + (buf_) * 65536 + (8 * i + wid) * 1024), 16, 0, 0); \
        __builtin_amdgcn_global_load_lds((const unsigned*)(vbase + (size_t)(32 * i) * TOK + 128 * (m_)), (LAS unsigned*)(lds + (buf_) * 65536 + 32768 + (8 * i + wid) * 1024), 16, 0, 0); } } while (0)
    RET_STAGE(0, 0);
    asm volatile("s_waitcnt vmcnt(0)" ::: "memory"); __syncthreads();
    for (int m = 0; m < nm; ++m) {
        const int buf = m & 1;
        if (m + 1 < nm) RET_STAGE(m + 1, buf ^ 1);
        if (m <= cq) {
            const LAS unsigned char* Kl = lds + buf * 65536; const LAS unsigned char* Vl = Kl + 32768;
            const float sc = fast_exp2(lg * (float)(128 * (cq - m)));
#pragma unroll
            for (int g32 = 0; g32 < 4; ++g32) {
                f32x4 S[2][2];
#pragma unroll
                for (int n = 0; n < 2; ++n) { S[0][n] = (f32x4){0.f, 0.f, 0.f, 0.f}; S[1][n] = (f32x4){0.f, 0.f, 0.f, 0.f};
                    const int krow = 32 * g32 + 8 * (fr >> 2) + 4 * n + (fr & 3);
#pragma unroll
                    for (int kk = 0; kk < 4; ++kk) { const bf16x8 kf = *(const LAS bf16x8*)(Kl + krow * 256 + (((4 * kk + fq) ^ fr) << 4));
                        S[0][n] = mfma16(kf, qf[0][kk], S[0][n]); S[1][n] = mfma16(kf, qf[1][kk], S[1][n]); } }
                bf16x8 pf[2];
#pragma unroll
                for (int mi = 0; mi < 2; ++mi) { f32x4 v0 = S[mi][0] * sc, v1 = S[mi][1] * sc;
                    if (m == cq) { const int il = iloc0 + 16 * mi + fr, jl = 32 * g32 + 8 * fq;
#pragma unroll
                        for (int t = 0; t < 4; ++t) { v0[t] = (jl + t <= il) ? v0[t] : 0.f; v1[t] = (jl + 4 + t <= il) ? v1[t] : 0.f; } }
                    const pg8::u32x4 w = pack8(v0, v1); pf[mi] = __builtin_bit_cast(bf16x8, w); }
#pragma unroll
                for (int ef = 0; ef < 8; ++ef) { const int vrow = 16 * ef + fr;
                    const bf16x8 vf = *(const LAS bf16x8*)(Vl + vrow * 256 + (((4 * g32 + fq) ^ fr) << 4));
                    O[0][ef] = mfma16(vf, pf[0], O[0][ef]); O[1][ef] = mfma16(vf, pf[1], O[1][ef]); }
            }
        }
        asm volatile("s_waitcnt vmcnt(0)" ::: "memory"); __syncthreads();
    }
#undef RET_STAGE
#pragma unroll
    for (int mi = 0; mi < 2; ++mi) { const size_t tok = tok0 + 16 * mi + fr; float s = 0.f;
#pragma unroll
        for (int ef = 0; ef < 8; ++ef) s += (O[mi][ef][0] + O[mi][ef][1]) + (O[mi][ef][2] + O[mi][ef][3]);
        s += __shfl_xor(s, 16); s += __shfl_xor(s, 32); const float mu = s * (1.0f / 128.0f); float q = 0.f;
#pragma unroll
        for (int ef = 0; ef < 8; ++ef) { const f32x4 d = O[mi][ef] - mu; q += (d[0] * d[0] + d[1] * d[1]) + (d[2] * d[2] + d[3] * d[3]); }
        q += __shfl_xor(q, 16); q += __shfl_xor(q, 32); const float rstd = 1.0f / sqrtf(q * (1.0f / 128.0f) + 1e-6f);
#pragma unroll
        for (int ef = 0; ef < 8; ++ef) { const int col = h * 128 + 16 * ef + 4 * fq; const f32x4 gn = *(const f32x4*)(ret_g + col); const v2u gr = *(const v2u*)(G + tok * 1536 + col);
            const float g0 = bf_lo(gr.x), g1 = bf_hi(gr.x), g2 = bf_lo(gr.y), g3 = bf_hi(gr.y);
            const float y0 = (O[mi][ef][0] - mu) * rstd * gn[0] * silu_f(g0), y1 = (O[mi][ef][1] - mu) * rstd * gn[1] * silu_f(g1);
            const float y2 = (O[mi][ef][2] - mu) * rstd * gn[2] * silu_f(g2), y3 = (O[mi][ef][3] - mu) * rstd * gn[3] * silu_f(g3);
            v2u w; w.x = cvt_pk_bf16(y0, y1); w.y = cvt_pk_bf16(y2, y3); *(v2u*)(MRG + tok * 1024 + col) = w; } }
}

__device__ __forceinline__ void lru_unit(int b, int g, int q, const bf16* G, const bf16* LW, const float* conv_w, const float* conv_b, const float* b_a, const float* b_i, const float* lam,
                                         bf16* MRG, LAS unsigned char* lds, int tid, int wid, int lane) {
    const int fr = lane & 15, fq = lane >> 4;
    const bf16* wbase = LW + ((size_t)(g * 2 * 128 + 32 * q + fr)) * 128 + 8 * fq;
    LAS float* A_ = (LAS float*)lds; LAS float* BX = A_ + 8192; LAS float* SEG = BX + 8192; LAS float* CAR = SEG + 1024;
    const bf16* xl = G + (size_t)b * SEQ * 1536 + 512 + 128 * g;
    for (int tile = 0; tile < 8; ++tile) {
        const int s0 = 256 * tile + 32 * wid;
        f32x4 acc[2][4];
#pragma unroll
        for (int mi = 0; mi < 2; ++mi)
#pragma unroll
            for (int nf = 0; nf < 4; ++nf) acc[mi][nf] = (f32x4){0.f, 0.f, 0.f, 0.f};
#pragma unroll 1
        for (int kk = 0; kk < 4; ++kk) { const int ch0 = 32 * kk + 8 * fq, cg0 = 128 * g + ch0;
            bf16x8 wf[4];
#pragma unroll
            for (int nf = 0; nf < 4; ++nf) wf[nf] = *(const bf16x8*)(wbase + (size_t)(((nf >> 1) * 128 + 16 * (nf & 1)) * 128 + 32 * kk));
#pragma unroll
            for (int mi = 0; mi < 2; ++mi) { const int s = s0 + 16 * mi + fr; float xc[8];
                { const f32x4 c0 = *(const f32x4*)(conv_b + cg0), c1 = *(const f32x4*)(conv_b + cg0 + 4); xc[0] = c0[0]; xc[1] = c0[1]; xc[2] = c0[2]; xc[3] = c0[3]; xc[4] = c1[0]; xc[5] = c1[1]; xc[6] = c1[2]; xc[7] = c1[3]; }
#pragma unroll
                for (int tap = 0; tap < 4; ++tap) { const int sp = s - 3 + tap; if (sp >= 0) { const v4u xv = *(const v4u*)(xl + (size_t)sp * 1536 + ch0);
                        const f32x4 w0 = *(const f32x4*)(conv_w + tap * 512 + cg0), w1 = *(const f32x4*)(conv_w + tap * 512 + cg0 + 4);
                        xc[0] += w0[0] * bf_lo(xv.x); xc[1] += w0[1] * bf_hi(xv.x); xc[2] += w0[2] * bf_lo(xv.y); xc[3] += w0[3] * bf_hi(xv.y);
                        xc[4] += w1[0] * bf_lo(xv.z); xc[5] += w1[1] * bf_hi(xv.z); xc[6] += w1[2] * bf_lo(xv.w); xc[7] += w1[3] * bf_hi(xv.w); } }
                pg8::u32x4 aw; aw.x = cvt_pk_bf16(xc[0], xc[1]); aw.y = cvt_pk_bf16(xc[2], xc[3]); aw.z = cvt_pk_bf16(xc[4], xc[5]); aw.w = cvt_pk_bf16(xc[6], xc[7]);
                const bf16x8 af = __builtin_bit_cast(bf16x8, aw);
#pragma unroll
                for (int nf = 0; nf < 4; ++nf) acc[mi][nf] = mfma16(wf[nf], af, acc[mi][nf]); } }
#pragma unroll
        for (int mi = 0; mi < 2; ++mi)
#pragma unroll
            for (int nfl = 0; nfl < 2; ++nfl) { const int cl = 32 * q + 16 * nfl + 4 * fq, cg0 = 128 * g + cl, s = s0 + 16 * mi + fr;
                f32x4 xc = *(const f32x4*)(conv_b + cg0);
#pragma unroll
                for (int tap = 0; tap < 4; ++tap) { const int sp = s - 3 + tap; if (sp >= 0) { const v2u xv = *(const v2u*)(xl + (size_t)sp * 1536 + cl); const f32x4 w0 = *(const f32x4*)(conv_w + tap * 512 + cg0);
                        xc[0] += w0[0] * bf_lo(xv.x); xc[1] += w0[1] * bf_hi(xv.x); xc[2] += w0[2] * bf_lo(xv.y); xc[3] += w0[3] * bf_hi(xv.y); } }
                const f32x4 ba = *(const f32x4*)(b_a + cg0), bi = *(const f32x4*)(b_i + cg0), lm = *(const f32x4*)(lam + cg0); f32x4 av, bv;
#pragma unroll
                for (int t = 0; t < 4; ++t) { const float r = sigmoid_f(acc[mi][nfl][t] + ba[t]), ig = sigmoid_f(acc[mi][nfl + 2][t] + bi[t]);
                    const float la = -8.0f * r * log1pf(__expf(-lm[t])); av[t] = __expf(la); bv[t] = sqrtf(-expm1f(2.0f * la)) * ig * xc[t]; }
                const int rt = 32 * wid + 16 * mi + fr;
                *(LAS f32x4*)(A_ + rt * 32 + 16 * nfl + 4 * fq) = av; *(LAS f32x4*)(BX + rt * 32 + 16 * nfl + 4 * fq) = bv; }
        __syncthreads();
        const int c = tid & 31, seg = tid >> 5;
        { float P = 1.f, hl = 0.f;
#pragma unroll
          for (int k = 0; k < 16; ++k) { const float av = A_[(16 * seg + k) * 32 + c], bv = BX[(16 * seg + k) * 32 + c]; hl = av * hl + bv; P *= av; }
          SEG[(seg * 32 + c) * 2] = P; SEG[(seg * 32 + c) * 2 + 1] = hl; }
        __syncthreads();
        float hin = tile == 0 ? 0.f : CAR[(tile & 1) * 32 + c];
        for (int s2 = 0; s2 < seg; ++s2) hin = SEG[(s2 * 32 + c) * 2] * hin + SEG[(s2 * 32 + c) * 2 + 1];
        const size_t tokb = (size_t)b * SEQ + 256 * tile + 16 * seg;
#pragma unroll
        for (int k = 0; k < 16; ++k) { const float av = A_[(16 * seg + k) * 32 + c], bv = BX[(16 * seg + k) * 32 + c]; hin = av * hin + bv;
            const float gl = bf1(G[(tokb + k) * 1536 + 1024 + 128 * g + 32 * q + c]);
            MRG[(tokb + k) * 1024 + 512 + 128 * g + 32 * q + c] = (bf16)f2bf(hin * gelu_tanh_f(gl)); }
        if (seg == 15) CAR[((tile + 1) & 1) * 32 + c] = hin;
        __syncthreads();
    }
}

constexpr int S5_WLDS = 27648;
__device__ __forceinline__ void s5_unit(int b, int g, KArgP ap, const float* x, const float* ssp, bf16* YS, LAS unsigned char* wl, int lane) {
    const float* lam_re = ap->in[16]; const float* lam_im = ap->in[17]; const float* log_dt = ap->in[18]; const float* b_re = ap->in[19]; const float* b_im = ap->in[20];
    const float* c_re = ap->in[21]; const float* c_im = ap->in[22]; const float* dsk = ap->in[23]; const float* gmix = ap->in[5] + D;
    LAS float* BU = (LAS float*)wl; LAS unsigned char* Hh = wl + 16384; LAS float* U = (LAS float*)(wl + 16384 + 8704);
    const float dt = __expf(log_dt[g]);
    float lr, li;
    { const float re = lam_re[g * 64 + lane], im = lam_im[g * 64 + lane], mag = __expf(re * dt); lr = mag * cosf(im * dt); li = mag * sinf(im * dt); }
    bf16x8 bfr[4];
#pragma unroll
    for (int q = 0; q < 4; ++q) { const int pp = 16 * q + ((lane & 31) >> 1), comp = lane & 1, hh = lane >> 5;
        const float re = lam_re[g * 64 + pp], im = lam_im[g * 64 + pp], mag = __expf(re * dt), lbr = mag * cosf(im * dt), lbi = mag * sinf(im * dt);
        const float den = re * re + im * im, nr = lbr - 1.0f, ni = lbi, fre = (nr * re + ni * im) / den, fim = (ni * re - nr * im) / den;
        const f32x4* pr = (const f32x4*)(b_re + ((size_t)(g * 64 + pp)) * 16 + 8 * hh); const f32x4* pi = (const f32x4*)(b_im + ((size_t)(g * 64 + pp)) * 16 + 8 * hh);
        const f32x4 r0 = pr[0], r1 = pr[1], i0 = pi[0], i1 = pi[1]; f32x4 o0, o1;
#pragma unroll
        for (int t = 0; t < 4; ++t) { o0[t] = comp ? (fre * i0[t] + fim * r0[t]) : (fre * r0[t] - fim * i0[t]); o1[t] = comp ? (fre * i1[t] + fim * r1[t]) : (fre * r1[t] - fim * i1[t]); }
        const pg8::u32x4 w = pack8(o0, o1); bfr[q] = __builtin_bit_cast(bf16x8, w); }
    bf16x8 cfr[4];
#pragma unroll
    for (int kk = 0; kk < 4; ++kk) { const int c = lane & 15, kq = lane >> 4, p0 = 16 * kk + 4 * kq;
        const f32x4 cr = *(const f32x4*)(c_re + ((size_t)(g * 16 + c)) * 64 + p0), ci = *(const f32x4*)(c_im + ((size_t)(g * 16 + c)) * 64 + p0);
        pg8::u32x4 w; w.x = cvt_pk_bf16(cr[0], -ci[0]); w.y = cvt_pk_bf16(cr[1], -ci[1]); w.z = cvt_pk_bf16(cr[2], -ci[2]); w.w = cvt_pk_bf16(cr[3], -ci[3]); cfr[kk] = __builtin_bit_cast(bf16x8, w); }
    const int tr = lane & 31, hh = lane >> 5;
    const f32x4 gm0 = *(const f32x4*)(gmix + 16 * g + 8 * hh), gm1 = *(const f32x4*)(gmix + 16 * g + 8 * hh + 4);
    const float dch = dsk[16 * g + (lane & 15)];
    float hre = 0.f, him = 0.f;
    const size_t tokb = (size_t)b * SEQ;
    f32x4 nx0, nx1; float nrs;
    { const size_t tok = tokb + tr; nx0 = *(const f32x4*)(x + tok * D + 16 * g + 8 * hh); nx1 = *(const f32x4*)(x + tok * D + 16 * g + 8 * hh + 4); nrs = row_rs(ssp, 16, (int)tok); }
    for (int blk = 0; blk < 64; ++blk) {
        f32x4 u0 = nx0 * nrs * gm0, u1 = nx1 * nrs * gm1;
        if (blk + 1 < 64) { const size_t tok = tokb + 32 * (blk + 1) + tr; nx0 = *(const f32x4*)(x + tok * D + 16 * g + 8 * hh); nx1 = *(const f32x4*)(x + tok * D + 16 * g + 8 * hh + 4); nrs = row_rs(ssp, 16, (int)tok); }
        *(LAS f32x4*)(U + tr * 16 + 8 * hh) = u0; *(LAS f32x4*)(U + tr * 16 + 8 * hh + 4) = u1;
        const pg8::u32x4 uw = pack8(u0, u1); const bf16x8 uf = __builtin_bit_cast(bf16x8, uw);
#pragma unroll
        for (int q = 0; q < 4; ++q) { f32x16 d;
#pragma unroll
            for (int r = 0; r < 16; ++r) d[r] = 0.f;
            d = __builtin_amdgcn_mfma_f32_32x32x16_bf16(uf, bfr[q], d, 0, 0, 0);
#pragma unroll
            for (int r = 0; r < 16; ++r) BU[((r & 3) + 8 * (r >> 2) + 4 * hh) * 128 + 32 * q + tr] = d[r]; }
        LDS_WAIT(); asm volatile("" ::: "memory");
#pragma unroll
        for (int t = 0; t < 32; ++t) { const f32x2 bu = *(const LAS f32x2*)(BU + t * 128 + 2 * lane);
            const float nr = lr * hre - li * him + bu[0], ni = lr * him + li * hre + bu[1]; hre = nr; him = ni;
            *(LAS unsigned*)(Hh + t * 272 + 4 * lane) = cvt_pk_bf16(nr, ni); }
        LDS_WAIT(); asm volatile("" ::: "memory");
        const int c = lane & 15, kq = lane >> 4;
#pragma unroll
        for (int tf = 0; tf < 2; ++tf) { f32x4 y = (f32x4){0.f, 0.f, 0.f, 0.f};
#pragma unroll
            for (int kk = 0; kk < 4; ++kk) { const bf16x8 hf = *(const LAS bf16x8*)(Hh + (16 * tf + c) * 272 + (32 * kk + 8 * kq) * 2); y = mfma16(hf, cfr[kk], y); }
#pragma unroll
            for (int r = 0; r < 4; ++r) { const int t = 16 * tf + 4 * kq + r; const float uu = U[t * 16 + c]; const float yv = y[r] + dch * uu;
                YS[(tokb + 32 * blk + t) * 1024 + 16 * g + c] = (bf16)f2bf(gelu_tanh_f(yv)); } }
        LDS_WAIT(); asm volatile("" ::: "memory");
    }
}

template <int ph> __device__ __forceinline__ void phase_body(LAS unsigned char* lds) {
    int tid = threadIdx.x; asm volatile("" : "+v"(tid));
    const int lane = tid & 63, wave = __builtin_amdgcn_readfirstlane(tid >> 6);
    const int G_ = gridDim.x, bx = blockIdx.x;
    const int gw = bx * NWAVES + wave, NGW = G_ * NWAVES;
    KArgP ap = (KArgP)__builtin_amdgcn_kernarg_segment_ptr(); asm volatile("" : "+s"(ap));
    unsigned char* ws = ap->ws;
    float* X = ap->out;
    bf16* XB = (bf16*)(ws + WS_XB); float* SSP = (float*)(ws + WS_SSP); bf16* HID = (bf16*)(ws + WS_R1); bf16* MRG = (bf16*)(ws + WS_MRG);
    (void)gw; (void)NGW; (void)lane; (void)X; (void)XB; (void)SSP; (void)HID; (void)MRG;
        if constexpr (ph == 0 && (PHM & 1)) { p0_prologue(ap, lds, gw, NGW, wave, lane); }
        else if constexpr ((PHM & 2) && (ph == 1 || ph == 6 || ph == 8 || ph == 12)) {
            const int l = ph == 1 ? 0 : ph == 6 ? 1 : ph == 8 ? 2 : 3;
            pg8::Gemm g{XB, (const bf16*)(ws + WS_W13) + (size_t)l * 5632 * 1024, TOK, 5632, D}; pg8::StaticOrder S; S.init(TOK, 5632, G_, bx);
            pg8::EpiSwiglu E{HID, FF, SSP, ph == 12 ? 32 : 16};
            pg8::gemm_phase<pg8::EpiSwiglu, pg8::StaticOrder, true, true>(lds, g, S, E);
        }
        else if constexpr ((PHM & 4) && (ph == 2 || ph == 7 || ph == 9 || ph == 13 || ph == 5)) {
            const int l = ph == 2 ? 0 : ph == 7 ? 1 : ph == 9 ? 2 : 3;
            pg8::Gemm g; g.M = TOK; g.N = D;
            if (ph == 5) { g.A = MRG; g.Bt = (const bf16*)(ws + WS_WOUT); g.K = D; } else { g.A = HID; g.Bt = (const bf16*)(ws + WS_W2) + (size_t)l * 1024 * FF; g.K = FF; }
            pg8::StaticOrder S; S.init(TOK, D, G_, bx);
            pg8::EpiResid E{ph == 2 ? ap->in[0] : X, X, XB, SSP, ph == 5 ? 1.0f : 0.5f};
            pg8::gemm_phase<pg8::EpiResid, pg8::StaticOrder, true, true>(lds, g, S, E);
        }
        else if constexpr ((PHM & 8) && ph == 3) {
            { pg8::Gemm g{XB, (const bf16*)(ws + WS_WIN), TOK, 1024, D}; pg8::StaticOrder S; S.init(TOK, 1024, G_, bx);
              pg8::EpiRope E{(bf16*)(ws + WS_Q), (bf16*)(ws + WS_K), (const float*)(ws + WS_ROPE), SSP, 16};
              pg8::gemm_phase<pg8::EpiRope, pg8::StaticOrder, true, true>(lds, g, S, E); }
            { pg8::Gemm g{XB, (const bf16*)(ws + WS_WIN) + (size_t)1024 * 1024, TOK, 1536, D}; pg8::StaticOrder S; S.init(TOK, 1536, G_, bx);
              pg8::EpiScaled E{(bf16*)(ws + WS_G), 1536, SSP, 16};
              pg8::gemm_phase<pg8::EpiScaled, pg8::StaticOrder, true, true>(lds, g, S, E); }
            { pg8::Gemm g{(const bf16*)(ws + WS_WV), XB, 512, TOK, D}; pg8::StaticOrder S; S.init(512, TOK, G_, bx);
              pg8::EpiPlain E{(bf16*)(ws + WS_VT), TOK};
              pg8::gemm_phase<pg8::EpiPlain, pg8::StaticOrder, true, true>(lds, g, S, E); }
        }
        else if constexpr ((PHM & 16) && ph == 4) {
#ifndef NO_RET
            for (int i = 0; i < 2; ++i) { const int bh = bx >> 2, pp = bx & 3, p = i == 0 ? pp : 7 - pp;
                ret_unit(bh >> 2, bh & 3, p, (const bf16*)(ws + WS_Q), (const bf16*)(ws + WS_K), (const bf16*)(ws + WS_VT), (const bf16*)(ws + WS_G), ap->in[8], MRG, lds, tid, wave, lane); }
#endif
#ifndef NO_LRU
            lru_unit(bx >> 4, (bx >> 2) & 3, bx & 3, (const bf16*)(ws + WS_G), (const bf16*)(ws + WS_WLRU), ap->in[9], ap->in[10], ap->in[12], ap->in[14], ap->in[15], MRG, lds, tid, wave, lane);
#endif
        }
        else if constexpr ((PHM & 32) && ph == 10) {
            if (wave < 4) { const int unit = bx * 4 + wave; s5_unit(unit >> 6, unit & 63, ap, X, SSP, MRG, lds + wave * S5_WLDS, lane); }
        }
        else if constexpr ((PHM & 64) && ph == 11) {
            pg8::Gemm g{MRG, (const bf16*)(ws + WS_WGLU), TOK, 2048, D}; pg8::StaticOrder S; S.init(TOK, 2048, G_, bx);
            pg8::EpiGluResid E{X, X, XB, SSP};
            pg8::gemm_phase<pg8::EpiGluResid, pg8::StaticOrder, true, true>(lds, g, S, E);
        }
        else if constexpr ((PHM & 128) && ph == 14) {
            const float* gf = ap->in[26];
            for (int m = gw; m < TOK; m += NGW) { const float rs = row_rs(SSP, 16, m); f32x4* xr = (f32x4*)(X + (size_t)m * D) + lane; const f32x4* gr = (const f32x4*)gf + lane;
#pragma unroll
                for (int j = 0; j < 4; ++j) xr[64 * j] = xr[64 * j] * rs * gr[64 * j]; }
        }
}
__global__ void __launch_bounds__(NWAVES * 64, 2) mega_fwd(Args a_) {
    extern __shared__ __attribute__((aligned(16))) unsigned char lds_raw[];
    LAS unsigned char* lds = (LAS unsigned char*)lds_raw;
    cg::grid_group grid = cg::this_grid();
    const int ph_lo = a_.ph_lo, ph_hi = a_.ph_hi;
#define PHASE(k) if (ph_lo <= (k) && (k) < ph_hi) { phase_body<k>(lds); if ((k) + 1 < ph_hi) grid.sync(); }
    PHASE(0) PHASE(1) PHASE(2) PHASE(3) PHASE(4) PHASE(5) PHASE(6) PHASE(7) PHASE(8) PHASE(9) PHASE(10) PHASE(11) PHASE(12) PHASE(13) PHASE(14)
#undef PHASE
}

extern "C" void kernel_launch(void* const* d_in, const int* in_sizes, int n_in, void* d_out, int out_size, void* d_ws, size_t ws_size, hipStream_t stream) {
    static int grid = 0;
    if (grid == 0) {
        if (n_in != 27 || in_sizes[0] != TOK * D || out_size != TOK * D || ws_size < WS_END) { fprintf(stderr, "kernel_launch: unexpected shapes (n_in %d, in0 %d, out %d, ws %zu)\n", n_in, n_in > 0 ? in_sizes[0] : -1, out_size, ws_size); grid = -1; return; }
        int dev = 0, cus = 0, per_cu = 0;
        (void)hipGetDevice(&dev); (void)hipDeviceGetAttribute(&cus, hipDeviceAttributeMultiprocessorCount, dev);
        if (hipFuncSetAttribute((const void*)mega_fwd, hipFuncAttributeMaxDynamicSharedMemorySize, LDS_BYTES) != hipSuccess) { fprintf(stderr, "kernel_launch: hipFuncSetAttribute failed\n"); grid = -1; return; }
        if (hipOccupancyMaxActiveBlocksPerMultiprocessor(&per_cu, (const void*)mega_fwd, NWAVES * 64, LDS_BYTES) != hipSuccess || per_cu < 1) { fprintf(stderr, "kernel_launch: occupancy query says %d blocks per CU\n", per_cu); per_cu = 1; }
        (void)hipGetLastError();
        grid = cus * 1;
    }
    if (grid < 0) return;
    Args a{};
    for (int i = 0; i < 27; ++i) a.in[i] = (const float*)d_in[i];
    a.out = (float*)d_out; a.ws = (unsigned char*)d_ws;
#if MK_PER_PHASE
    for (int ph = 0; ph < NPH; ++ph) { a.ph_lo = ph; a.ph_hi = ph + 1; hipLaunchKernelGGL(mega_fwd, dim3(grid), dim3(NWAVES * 64), LDS_BYTES, stream, a); }
#else
    a.ph_lo = 0; a.ph_hi = NPH;
    void* params[] = {&a};
    const hipError_t e = hipLaunchCooperativeKernel((const void*)mega_fwd, dim3(grid), dim3(NWAVES * 64), params, LDS_BYTES, stream);
    if (e != hipSuccess) fprintf(stderr, "kernel_launch: cooperative launch failed: %s (grid %d)\n", hipGetErrorString(e), grid);
#endif
}
```

```cpp
#include <hip/hip_runtime.h>
#include <hip/hip_cooperative_groups.h>
#include <cstdio>
#include <cstdint>
#include <cmath>
namespace cg = cooperative_groups;
namespace pg8 {
#define PG8_LAS __attribute__((address_space(3)))
typedef unsigned short bf16_t;
typedef short bf16x8 __attribute__((ext_vector_type(8)));
typedef float f32x4 __attribute__((ext_vector_type(4)));
typedef unsigned u32x4 __attribute__((ext_vector_type(4)));
constexpr int BM = 256, BK = 64, HALF = 128, HTB = HALF * BK * 2  , STAGE_BYTES = 8 * HTB, NXCD = 8, WGM = 8;

__host__ __device__ __forceinline__ int lds_byte(int r, int c) { const int st = (r >> 4) * 2 + (c >> 5), rr = r & 15, cc = c & 31, ob = rr * 64 + cc * 2; return st * 1024 + (ob ^ (((ob >> 9) & 1) << 5)); }
__host__ __device__ __forceinline__ void stage_rc(int b, int& R, int& C) { const int st = b / 1024, sb = b % 1024, swz = sb ^ (((sb >> 9) & 1) << 5); R = (st >> 1) * 16 + swz / 64; C = (st & 1) * 32 + (swz % 64) / 2; }
__host__ __device__ __forceinline__ int perm32(int rho) { const int n = rho >> 4, i = rho & 15; return 8 * (i >> 2) + 4 * n + (i & 3); }

struct Unit { int pm, pn; };
struct Gemm { const bf16_t* A; const bf16_t* Bt; int M, N, K; };

struct StaticOrder {
    int nM, nN, nwg, G, c;
    __host__ __device__ void init(int M, int N, int G_, int c_) { nM = M / BM; nN = N / BM; nwg = nM * nN; G = G_; c = c_; }
    __host__ __device__ bool next(int i, Unit& u) const {
        const long L = (long)i * G + c; if (L >= nwg) return false;
        int wgid = (int)L; { const int q = nwg / NXCD, r = nwg % NXCD, xcd = wgid % NXCD, off = wgid / NXCD; wgid = (xcd < r ? xcd * (q + 1) : r * (q + 1) + (xcd - r) * q) + off; }
        const int nig = WGM * nN, gid = wgid / nig, fm = gid * WGM, gsz = (nM - fm) < WGM ? (nM - fm) : WGM;
        u.pm = fm + ((wgid % nig) % gsz); u.pn = (wgid % nig) / gsz; return true;
    }
    __device__ __forceinline__ void a_ready(const Unit&) const {}
    __device__ __forceinline__ void done(const Unit&) const {}
};

__device__ __forceinline__ unsigned cvt_pk_bf16(float lo, float hi) { unsigned r; asm volatile("v_cvt_pk_bf16_f32 %0, %1, %2" : "=v"(r) : "v"(lo), "v"(hi)); return r; }
__device__ __forceinline__ u32x4 pack8(const f32x4 a, const f32x4 b) { u32x4 w; w.x = cvt_pk_bf16(a[0], a[1]); w.y = cvt_pk_bf16(a[2], a[3]); w.z = cvt_pk_bf16(b[0], b[1]); w.w = cvt_pk_bf16(b[2], b[3]); return w; }
__device__ __forceinline__ float fast_rcp(float x) { return __builtin_amdgcn_rcpf(x); }
__device__ __forceinline__ float fast_exp2(float x) { return __builtin_amdgcn_exp2f(x); }
__device__ __forceinline__ float sigmoid_f(float x) { return fast_rcp(1.0f + fast_exp2(-1.4426950409f * x)); }
__device__ __forceinline__ float silu_f(float x) { return x * sigmoid_f(x); }
__device__ __forceinline__ float gelu_tanh_f(float v) { const float u = v + 0.044715f * v * v * v; return v * sigmoid_f(1.5957691216f * u); }
__device__ __forceinline__ float row_rs(const float* ssp, int nparts, int row) {
    const f32x4* p = (const f32x4*)(ssp + (size_t)row * 32); float s = 0.f;
#pragma unroll
    for (int i = 0; i < 4; ++i) { const f32x4 v = p[i]; s += (v[0] + v[1]) + (v[2] + v[3]); }
    if (nparts > 16) {
#pragma unroll
        for (int i = 4; i < 8; ++i) { const f32x4 v = p[i]; s += (v[0] + v[1]) + (v[2] + v[3]); } }
    return 1.0f / sqrtf(s * (1.0f / 1024.0f) + 1e-6f);
}
__device__ __forceinline__ void row_rs8(float (&rs)[8], const float* ssp, int nparts, int row0) {
#pragma unroll
    for (int i = 0; i < 8; ++i) { rs[i] = row_rs(ssp, nparts, row0 + (i >> 2) * HALF + (i & 3) * 16); asm volatile("" : "+v"(rs[i]) :: "memory"); }
}

struct EpiSwiglu {
    static constexpr bool PERM = true, AFTER_DRAIN = false;
    bf16_t* O; int ldo; const float* ssp; int nparts;
    __device__ __forceinline__ void operator()(const f32x4 (&acc)[2][2][4][2], const Unit& u, int wr, int wc, int fr, int fq) const {
        const int row0 = u.pm * BM + wr * 64 + fr, col0 = u.pn * 128 + wc * 32 + 8 * fq;
        float rs8[8]; row_rs8(rs8, ssp, nparts, row0);
#pragma unroll
        for (int ai = 0; ai < 2; ++ai)
#pragma unroll
            for (int m = 0; m < 4; ++m) { const int row = row0 + ai * HALF + m * 16; const float rs = rs8[ai * 4 + m];
                f32x4 h[2];
#pragma unroll
                for (int n = 0; n < 2; ++n)
#pragma unroll
                    for (int t = 0; t < 4; ++t) { const float a = acc[ai][0][m][n][t] * rs, b = acc[ai][1][m][n][t] * rs; h[n][t] = silu_f(a) * b; }
                *(u32x4*)(O + (size_t)row * ldo + col0) = pack8(h[0], h[1]); asm volatile("" ::: "memory"); }
    }
};
struct EpiResid {
    static constexpr bool PERM = true, AFTER_DRAIN = false;
    const float* xin; float* xout; bf16_t* xb; float* ssp; float alpha;
    __device__ __forceinline__ void operator()(const f32x4 (&acc)[2][2][4][2], const Unit& u, int wr, int wc, int fr, int fq) const {
        const int row0 = u.pm * BM + wr * 64 + fr, col0 = u.pn * BM + wc * 32 + 8 * fq;
#pragma unroll
        for (int ai = 0; ai < 2; ++ai)
#pragma unroll
            for (int m = 0; m < 4; ++m) { const int row = row0 + ai * HALF + m * 16; float ss = 0.f;
#pragma unroll
                for (int bj = 0; bj < 2; ++bj) { const size_t off = (size_t)row * 1024 + col0 + bj * HALF;
                    const f32x4 o0 = *(const f32x4*)(xin + off), o1 = *(const f32x4*)(xin + off + 4);
                    const f32x4 v0 = o0 + alpha * acc[ai][bj][m][0], v1 = o1 + alpha * acc[ai][bj][m][1];
                    *(f32x4*)(xout + off) = v0; *(f32x4*)(xout + off + 4) = v1; *(u32x4*)(xb + off) = pack8(v0, v1);
                    ss += (v0[0] * v0[0] + v0[1] * v0[1]) + (v0[2] * v0[2] + v0[3] * v0[3]) + (v1[0] * v1[0] + v1[1] * v1[1]) + (v1[2] * v1[2] + v1[3] * v1[3]); }
                ss += __shfl_xor(ss, 16); ss += __shfl_xor(ss, 32);
                if (fq == 0) ssp[(size_t)row * 32 + 4 * u.pn + wc] = ss; asm volatile("" ::: "memory"); }
    }
};
struct EpiGluResid {
    static constexpr bool PERM = true, AFTER_DRAIN = false;
    const float* xin; float* xout; bf16_t* xb; float* ssp;
    __device__ __forceinline__ void operator()(const f32x4 (&acc)[2][2][4][2], const Unit& u, int wr, int wc, int fr, int fq) const {
        const int row0 = u.pm * BM + wr * 64 + fr, col0 = u.pn * 128 + wc * 32 + 8 * fq;
#pragma unroll
        for (int ai = 0; ai < 2; ++ai)
#pragma unroll
            for (int m = 0; m < 4; ++m) { const int row = row0 + ai * HALF + m * 16; const size_t off = (size_t)row * 1024 + col0;
                const f32x4 o0 = *(const f32x4*)(xin + off), o1 = *(const f32x4*)(xin + off + 4); f32x4 v0, v1;
#pragma unroll
                for (int t = 0; t < 4; ++t) { v0[t] = o0[t] + acc[ai][0][m][0][t] * sigmoid_f(acc[ai][1][m][0][t]); v1[t] = o1[t] + acc[ai][0][m][1][t] * sigmoid_f(acc[ai][1][m][1][t]); }
                *(f32x4*)(xout + off) = v0; *(f32x4*)(xout + off + 4) = v1; *(u32x4*)(xb + off) = pack8(v0, v1);
                float ss = (v0[0] * v0[0] + v0[1] * v0[1]) + (v0[2] * v0[2] + v0[3] * v0[3]) + (v1[0] * v1[0] + v1[1] * v1[1]) + (v1[2] * v1[2] + v1[3] * v1[3]);
                ss += __shfl_xor(ss, 16); ss += __shfl_xor(ss, 32);
                if (fq == 0) ssp[(size_t)row * 32 + 4 * u.pn + wc] = ss; asm volatile("" ::: "memory"); }
    }
};
struct EpiPlain {
    static constexpr bool PERM = true, AFTER_DRAIN = false;
    bf16_t* O; int ldo;
    __device__ __forceinline__ void operator()(const f32x4 (&acc)[2][2][4][2], const Unit& u, int wr, int wc, int fr, int fq) const {
        const int row0 = u.pm * BM + wr * 64 + fr, col0 = u.pn * BM + wc * 32 + 8 * fq;
#pragma unroll
        for (int ai = 0; ai < 2; ++ai)
#pragma unroll
            for (int m = 0; m < 4; ++m) { bf16_t* rowp = O + (size_t)(row0 + ai * HALF + m * 16) * ldo + col0;
#pragma unroll
                for (int bj = 0; bj < 2; ++bj) *(u32x4*)(rowp + bj * HALF) = pack8(acc[ai][bj][m][0], acc[ai][bj][m][1]); }
    }
};
__device__ __forceinline__ float lg_gamma(int h) { return h == 0 ? -0.04580368961312479f : h == 1 ? -0.02272007650008353f : h == 2 ? -0.011315313227834146f : -0.005646563141142063f; }
struct EpiRope {
    static constexpr bool PERM = true, AFTER_DRAIN = false;
    bf16_t* Q; bf16_t* K; const float* rope; const float* ssp; int nparts;
    __device__ __forceinline__ void operator()(const f32x4 (&acc)[2][2][4][2], const Unit& u, int wr, int wc, int fr, int fq) const {
        typedef unsigned u32x2 __attribute__((ext_vector_type(2)));
        const int row0 = u.pm * BM + wr * 64 + fr;
        const int head = 2 * (u.pn & 1) + (wc >> 1), jj0 = (wc & 1) * 32 + 8 * fq; bf16_t* dst = (u.pn < 2) ? Q : K;
        const float lg = lg_gamma(head);
#pragma unroll
        for (int ai = 0; ai < 2; ++ai)
#pragma unroll
            for (int m = 0; m < 4; ++m) { const int row = row0 + ai * HALF + m * 16, pos = row & 2047; const float rs = row_rs(ssp, nparts, row);
                const float sc = (u.pn < 2) ? rs * fast_exp2(lg * (float)(pos & 127)) : rs * rs * 0.08838834764831845f * fast_exp2(-lg * (float)(pos & 127));
                const f32x4* rp = (const f32x4*)(rope + ((size_t)pos * 64 + jj0) * 2);
                bf16_t* rowp = dst + (size_t)row * 512 + head * 128 + jj0;
#pragma unroll
                for (int n = 0; n < 2; ++n) { const f32x4 cs0 = rp[2 * n], cs1 = rp[2 * n + 1]; const f32x4 x1 = acc[ai][0][m][n] * sc, x2 = acc[ai][1][m][n] * sc; f32x4 o1, o2;
                    o1[0] = x1[0] * cs0[0] - x2[0] * cs0[1]; o2[0] = x1[0] * cs0[1] + x2[0] * cs0[0];
                    o1[1] = x1[1] * cs0[2] - x2[1] * cs0[3]; o2[1] = x1[1] * cs0[3] + x2[1] * cs0[2];
                    o1[2] = x1[2] * cs1[0] - x2[2] * cs1[1]; o2[2] = x1[2] * cs1[1] + x2[2] * cs1[0];
                    o1[3] = x1[3] * cs1[2] - x2[3] * cs1[3]; o2[3] = x1[3] * cs1[3] + x2[3] * cs1[2];
                    u32x2 w1, w2; w1.x = cvt_pk_bf16(o1[0], o1[1]); w1.y = cvt_pk_bf16(o1[2], o1[3]); w2.x = cvt_pk_bf16(o2[0], o2[1]); w2.y = cvt_pk_bf16(o2[2], o2[3]);
                    *(u32x2*)(rowp + 4 * n) = w1; *(u32x2*)(rowp + 64 + 4 * n) = w2; asm volatile("" ::: "memory"); } }
    }
};
struct EpiScaled {
    static constexpr bool PERM = true, AFTER_DRAIN = false;
    bf16_t* O; int ldo; const float* ssp; int nparts;
    __device__ __forceinline__ void operator()(const f32x4 (&acc)[2][2][4][2], const Unit& u, int wr, int wc, int fr, int fq) const {
        const int row0 = u.pm * BM + wr * 64 + fr, col0 = u.pn * BM + wc * 32 + 8 * fq;
#pragma unroll
        for (int ai = 0; ai < 2; ++ai)
#pragma unroll
            for (int m = 0; m < 4; ++m) { const int row = row0 + ai * HALF + m * 16; const float rs = row_rs(ssp, nparts, row); bf16_t* rowp = O + (size_t)row * ldo + col0;
#pragma unroll
                for (int bj = 0; bj < 2; ++bj) *(u32x4*)(rowp + bj * HALF) = pack8(acc[ai][bj][m][0] * rs, acc[ai][bj][m][1] * rs);
                asm volatile("" ::: "memory"); }
    }
};
template <class Epi, class Sched, bool ALIGN_EPI = false, bool SP2 = false>
__device__ __forceinline__ void gemm_phase(PG8_LAS unsigned char* lds, const Gemm g, const Sched& S, const Epi& E) {
    int tid_ = threadIdx.x; asm volatile("" : "+v"(tid_));
    const int tid = tid_, wid = __builtin_amdgcn_readfirstlane(tid >> 6), lane = tid & 63, wr = wid >> 2, wc = wid & 3, fr = lane & 15, fq = lane >> 4;
    const int K = g.K, nt = K / BK;
    unsigned voffA[2], voffB[2];
#pragma unroll
    for (int i = 0; i < 2; ++i) { int R, C; stage_rc(tid * 16 + i * 8192, R, C); const int Rb = Epi::PERM ? ((R & ~31) + perm32(R & 31)) : R;
        voffA[i] = (unsigned)(R * K + C) * 2u; voffB[i] = (unsigned)(Rb * K + C) * 2u; }
    const size_t kstep = (size_t)(BK * 2);
    const size_t hstep = (size_t)HALF * K * 2;
    const size_t tstep = 2 * hstep;
    const unsigned ldsw = (unsigned)wid * 1024u;
    const int aoff = lds_byte(wr * 64 + fr, fq * 8), boff = lds_byte(wc * 32 + fr, fq * 8);
#define PG8_SA(b, h) (((b) * 2 + (h)) * HTB)
#define PG8_SB(b, h) ((4 + (b) * 2 + (h)) * HTB)
#define PG8_STAGE(bufoff, gbase, voff) do { _Pragma("unroll") for (int _i = 0; _i < 2; ++_i) \
        __builtin_amdgcn_global_load_lds((const unsigned*)((const char*)(gbase) + (voff)[_i]), (PG8_LAS unsigned*)(lds + (bufoff) + ldsw + _i * 8192), 16, 0, 0); } while (0)
#define PG8_LDA(dst, b, h) do { _Pragma("unroll") for (int m = 0; m < 4; ++m) _Pragma("unroll") for (int k = 0; k < 2; ++k) dst[m][k] = *(const PG8_LAS bf16x8*)(lds + PG8_SA(b, h) + aoff + m * 2048 + k * 1024); } while (0)
#define PG8_LDB(dst, b, h) do { _Pragma("unroll") for (int n = 0; n < 2; ++n) _Pragma("unroll") for (int k = 0; k < 2; ++k) dst[n][k] = *(const PG8_LAS bf16x8*)(lds + PG8_SB(b, h) + boff + n * 2048 + k * 1024); } while (0)
#define PG8_MMA(ai, bj, At, Bt) do { __builtin_amdgcn_s_setprio(1); _Pragma("unroll") for (int m = 0; m < 4; ++m) _Pragma("unroll") for (int n = 0; n < 2; ++n) _Pragma("unroll") for (int k = 0; k < 2; ++k) \
        acc[ai][bj][m][n] = __builtin_amdgcn_mfma_f32_16x16x32_bf16(Bt[n][k], At[m][k], acc[ai][bj][m][n], 0, 0, 0); __builtin_amdgcn_s_setprio(0); } while (0)
#define PG8_WAIT_V(n) asm volatile("s_waitcnt vmcnt(" #n ")" ::: "memory")
#define PG8_WAIT_L(n) asm volatile("s_waitcnt lgkmcnt(" #n ")" ::: "memory")
#define PG8_BAR __builtin_amdgcn_s_barrier()
#define PG8_SCHED __builtin_amdgcn_sched_barrier(0)
    Unit cur, nxt; int ui = 0;
    if (!S.next(0, cur)) return;
    f32x4 acc[2][2][4][2];
#pragma unroll
    for (int a = 0; a < 2; ++a)
#pragma unroll
        for (int b = 0; b < 2; ++b)
#pragma unroll
            for (int m = 0; m < 4; ++m)
#pragma unroll
                for (int n = 0; n < 2; ++n) acc[a][b][m][n] = (f32x4){0.f, 0.f, 0.f, 0.f};
    bf16x8 At[4][2], B0[2][2], B1[2][2];
    const char* cA = (const char*)g.A + (size_t)cur.pm * tstep; const char* cB = (const char*)g.Bt + (size_t)cur.pn * tstep;
    S.a_ready(cur);
    if constexpr (SP2) {
        PG8_STAGE(PG8_SB(0, 0), cB, voffB); PG8_STAGE(PG8_SB(0, 1), cB + hstep, voffB); PG8_STAGE(PG8_SA(0, 0), cA, voffA); PG8_STAGE(PG8_SA(0, 1), cA + hstep, voffA);
        if (wr == 1) PG8_BAR;
        PG8_WAIT_V(2); PG8_BAR;
        PG8_STAGE(PG8_SB(1, 0), cB + kstep, voffB); PG8_STAGE(PG8_SA(1, 0), cA + kstep, voffA); PG8_STAGE(PG8_SB(1, 1), cB + hstep + kstep, voffB);
        PG8_WAIT_V(6); PG8_BAR;
    } else {
        PG8_STAGE(PG8_SB(0, 0), cB, voffB); PG8_STAGE(PG8_SA(0, 0), cA, voffA); PG8_STAGE(PG8_SB(0, 1), cB + hstep, voffB); PG8_STAGE(PG8_SA(0, 1), cA + hstep, voffA);
        if (wr == 1) PG8_BAR;
        PG8_WAIT_V(4); PG8_BAR;
        PG8_STAGE(PG8_SB(1, 0), cB + kstep, voffB); PG8_STAGE(PG8_SA(1, 0), cA + kstep, voffA); PG8_STAGE(PG8_SB(1, 1), cB + hstep + kstep, voffB);
        PG8_WAIT_V(6); PG8_BAR;
    }
    for (;;) {
        const bool has_next = S.next(ui + 1, nxt);
        const char* nA = has_next ? (const char*)g.A + (size_t)nxt.pm * tstep : cA; const char* nB = has_next ? (const char*)g.Bt + (size_t)nxt.pn * tstep : cB;
        for (int t = 0; t < nt; t += 2) {
            const bool last = (t == nt - 2);
            const char* a1 = cA + (size_t)(t + 1) * kstep;
            const char* a2 = last ? nA : cA + (size_t)(t + 2) * kstep; const char* b2 = last ? nB : cB + (size_t)(t + 2) * kstep;
            const char* a3 = a2 + kstep; const char* b3 = b2 + kstep;
            if (last && has_next) S.a_ready(nxt);
            if constexpr (SP2) {
            PG8_LDB(B0, 0, 0); PG8_LDB(B1, 0, 1); PG8_SCHED; PG8_LDA(At, 0, 0); PG8_STAGE(PG8_SA(1, 1), a1 + hstep, voffA);
            PG8_WAIT_V(8); PG8_WAIT_L(0); PG8_BAR; PG8_MMA(0, 0, At, B0); PG8_MMA(0, 1, At, B1); PG8_BAR; PG8_SCHED;
            PG8_LDA(At, 0, 1); PG8_STAGE(PG8_SB(0, 0), b2, voffB); PG8_STAGE(PG8_SB(0, 1), b2 + hstep, voffB); PG8_STAGE(PG8_SA(0, 0), a2, voffA);
            PG8_WAIT_V(8); PG8_WAIT_L(0); PG8_BAR; PG8_MMA(1, 0, At, B0); PG8_MMA(1, 1, At, B1); PG8_BAR; PG8_SCHED;
            PG8_LDB(B0, 1, 0); PG8_LDB(B1, 1, 1); PG8_SCHED; PG8_LDA(At, 1, 0); PG8_STAGE(PG8_SA(0, 1), a2 + hstep, voffA);
            PG8_WAIT_V(8); PG8_WAIT_L(0); PG8_BAR; PG8_MMA(0, 0, At, B0); PG8_MMA(0, 1, At, B1); PG8_BAR; PG8_SCHED;
            PG8_LDA(At, 1, 1); PG8_STAGE(PG8_SB(1, 0), b3, voffB); PG8_STAGE(PG8_SB(1, 1), b3 + hstep, voffB); PG8_STAGE(PG8_SA(1, 0), a3, voffA);
            PG8_WAIT_V(8); PG8_WAIT_L(0); PG8_BAR; PG8_MMA(1, 0, At, B0); PG8_MMA(1, 1, At, B1); PG8_BAR; PG8_SCHED;
            } else {
            PG8_LDB(B0, 0, 0); PG8_SCHED; PG8_LDA(At, 0, 0); PG8_STAGE(PG8_SA(1, 1), a1 + hstep, voffA);
            PG8_WAIT_L(8); PG8_BAR; PG8_WAIT_L(0); PG8_MMA(0, 0, At, B0); PG8_BAR; PG8_SCHED;
            PG8_LDB(B1, 0, 1); PG8_STAGE(PG8_SB(0, 0), b2, voffB);
            PG8_BAR; PG8_WAIT_L(0); PG8_MMA(0, 1, At, B1); PG8_BAR;
            PG8_LDA(At, 0, 1); PG8_STAGE(PG8_SA(0, 0), a2, voffA);
            PG8_BAR; PG8_WAIT_L(0); PG8_MMA(1, 0, At, B0); PG8_BAR; PG8_SCHED;
            PG8_STAGE(PG8_SB(0, 1), b2 + hstep, voffB);
            PG8_WAIT_V(6); PG8_BAR; PG8_MMA(1, 1, At, B1); PG8_BAR;
            PG8_LDB(B0, 1, 0); PG8_SCHED; PG8_LDA(At, 1, 0); PG8_STAGE(PG8_SA(0, 1), a2 + hstep, voffA);
            PG8_WAIT_L(8); PG8_BAR; PG8_WAIT_L(0); PG8_MMA(0, 0, At, B0); PG8_BAR; PG8_SCHED;
            PG8_LDB(B1, 1, 1); PG8_STAGE(PG8_SB(1, 0), b3, voffB);
            PG8_BAR; PG8_WAIT_L(0); PG8_MMA(0, 1, At, B1); PG8_BAR;
            PG8_LDA(At, 1, 1); PG8_STAGE(PG8_SA(1, 0), a3, voffA);
            PG8_BAR; PG8_WAIT_L(0); PG8_MMA(1, 0, At, B0); PG8_BAR; PG8_SCHED;
            PG8_STAGE(PG8_SB(1, 1), b3 + hstep, voffB);
            PG8_WAIT_V(6); PG8_BAR; PG8_MMA(1, 1, At, B1); PG8_BAR;
            }
        }
        if constexpr (ALIGN_EPI) { if (wr == 0) PG8_BAR; }
        if constexpr (!Epi::AFTER_DRAIN) { E(acc, cur, wr, wc, fr, fq); S.done(cur); }
        if (!has_next) break;
#pragma unroll
        for (int a = 0; a < 2; ++a)
#pragma unroll
            for (int b = 0; b < 2; ++b)
#pragma unroll
                for (int m = 0; m < 4; ++m)
#pragma unroll
                    for (int n = 0; n < 2; ++n) acc[a][b][m][n] = (f32x4){0.f, 0.f, 0.f, 0.f};
        cur = nxt; cA = nA; cB = nB; ++ui;
        if constexpr (ALIGN_EPI) { if (wr == 1) PG8_BAR; }
    }
    PG8_WAIT_V(0);
    if constexpr (!ALIGN_EPI) { if (wr == 0) PG8_BAR; }
    PG8_BAR;
    if constexpr (Epi::AFTER_DRAIN) { E.fused(acc, cur, wr, wc, fr, fq, lds, wid, lane); S.done(cur); }
#undef PG8_SA
#undef PG8_SB
#undef PG8_STAGE
#undef PG8_LDA
#undef PG8_LDB
#undef PG8_MMA
#undef PG8_WAIT_V
#undef PG8_WAIT_L
#undef PG8_BAR
#undef PG8_SCHED
}
}

#define GAS __attribute__((address_space(1)))
#define LAS __attribute__((address_space(3)))
typedef unsigned short bf16;
typedef unsigned v4u __attribute__((ext_vector_type(4)));
typedef unsigned v2u __attribute__((ext_vector_type(2)));
typedef float f32x4 __attribute__((ext_vector_type(4)));
typedef float f32x2 __attribute__((ext_vector_type(2)));
typedef float f32x16 __attribute__((ext_vector_type(16)));
typedef short bf16x8 __attribute__((ext_vector_type(8)));
#define LDS_WAIT() asm volatile("s_waitcnt lgkmcnt(0)" ::: "memory")
using pg8::cvt_pk_bf16; using pg8::pack8; using pg8::sigmoid_f; using pg8::silu_f; using pg8::gelu_tanh_f; using pg8::row_rs; using pg8::fast_exp2;

#ifndef PHM
#define PHM 255
#endif
#ifndef MK_PER_PHASE
#define MK_PER_PHASE 0
#endif
constexpr int NWAVES = 8;
constexpr int BATCH = 16, SEQ = 2048, D = 1024, FF = 2816, TOK = BATCH * SEQ;
constexpr int NPH = 15;
constexpr size_t MiB = 1u << 20;
constexpr size_t WS_W13 = 1 * MiB;
constexpr size_t WS_W2 = 45 * MiB;
constexpr size_t WS_WIN = 67 * MiB;
constexpr size_t WS_WV = 72 * MiB;
constexpr size_t WS_WOUT = 73 * MiB;
constexpr size_t WS_WGLU = 75 * MiB;
constexpr size_t WS_WLRU = 79 * MiB;
constexpr size_t WS_ROPE = 80 * MiB;
constexpr size_t WS_SSP = 81 * MiB;
constexpr size_t WS_XB = 96 * MiB;
constexpr size_t WS_R1 = 160 * MiB;
constexpr size_t WS_Q = WS_R1, WS_K = WS_R1 + 32 * MiB, WS_VT = WS_R1 + 64 * MiB, WS_G = WS_R1 + 96 * MiB;
constexpr size_t WS_MRG = 352 * MiB;
constexpr size_t WS_END = 416 * MiB;
constexpr int LDS_BYTES = 135168;

__device__ __forceinline__ unsigned f2bf(float f) { unsigned u = __builtin_bit_cast(unsigned, f); return (u + 0x7fffu + ((u >> 16) & 1u)) >> 16; }
__device__ __forceinline__ unsigned pk2(float lo, float hi) { return f2bf(lo) | (f2bf(hi) << 16); }
__device__ __forceinline__ float bf_lo(unsigned w) { return __builtin_bit_cast(float, w << 16); }
__device__ __forceinline__ float bf_hi(unsigned w) { return __builtin_bit_cast(float, w & 0xffff0000u); }
__device__ __forceinline__ float bf1(bf16 h) { return __builtin_bit_cast(float, (unsigned)h << 16); }
__device__ __forceinline__ float wave_sum(float v) {
#pragma unroll
    for (int o = 1; o < 64; o <<= 1) v += __shfl_xor(v, o);
    return v;
}
__device__ __forceinline__ f32x4 mfma16(bf16x8 a, bf16x8 b, f32x4 c) { return __builtin_amdgcn_mfma_f32_16x16x32_bf16(a, b, c, 0, 0, 0); }

__device__ __forceinline__ void transpose_item(const float* __restrict__ W, int N, int K, const float* __restrict__ gk, bf16* WT, int dst_row, int k0, int n0, LAS float* scr, int lane) {
#pragma unroll 8
    for (int i = 0; i < 32; ++i) { const int kk = 2 * i + (lane >> 5); float v = W[(size_t)(k0 + kk) * N + n0 + (lane & 31)]; if (gk) v *= gk[k0 + kk]; scr[kk * 33 + (lane & 31)] = v; }
    LDS_WAIT(); asm volatile("" ::: "memory");
    const int c = lane & 7;
#pragma unroll
    for (int j = 0; j < 4; ++j) { const int n = (lane >> 3) + 8 * j; const LAS float* s = scr + (8 * c) * 33 + n;
        v4u o; o.x = pk2(s[0 * 33], s[1 * 33]); o.y = pk2(s[2 * 33], s[3 * 33]); o.z = pk2(s[4 * 33], s[5 * 33]); o.w = pk2(s[6 * 33], s[7 * 33]);
        *(v4u*)(WT + (size_t)(dst_row + n) * K + k0 + 8 * c) = o; }
    LDS_WAIT(); asm volatile("" ::: "memory");
}
struct Args { const float* in[27]; float* out; unsigned char* ws; int ph_lo, ph_hi; };
typedef const __attribute__((address_space(4))) Args* KArgP;

__device__ __forceinline__ void p0_prologue(KArgP ap, LAS unsigned char* lds, int gw, int NGW, int wave, int lane) {
    LAS float* scr = (LAS float*)(lds + wave * 16384);
    unsigned char* ws = ap->ws;
    constexpr int I_F = 1408, I_IN = 1536, I_OUT = 512, I_GL = 512, I_LRU = 64;
    constexpr int NITEMS = 12 * I_F + I_IN + I_OUT + 2 * I_GL + I_LRU;
    for (int it = gw; it < NITEMS; it += NGW) {
        int r = it;
        if (r < 8 * I_F) { const int w3 = r >= 4 * I_F; if (w3) r -= 4 * I_F; const int l = r / I_F; r -= l * I_F; const int kb = r / 88, nb = r % 88, n0 = 32 * nb;
            transpose_item(ap->in[w3 ? 3 : 2] + (size_t)l * D * FF, FF, D, ap->in[1] + l * D, (bf16*)(ws + WS_W13) + (size_t)l * 5632 * 1024, 256 * (n0 >> 7) + (n0 & 127) + (w3 ? 128 : 0), 64 * kb, n0, scr, lane); continue; }
        r -= 8 * I_F;
        if (r < 4 * I_F) { const int l = r / I_F; r -= l * I_F; const int kb = r / 32, nb = r % 32;
            transpose_item(ap->in[4] + (size_t)l * FF * D, D, FF, nullptr, (bf16*)(ws + WS_W2) + (size_t)l * 1024 * FF, 32 * nb, 64 * kb, 32 * nb, scr, lane); continue; }
        r -= 4 * I_F;
        if (r < I_IN) { const int kb = r / 96, nb = r % 96, n0 = 32 * nb; bf16* dst; int drow;
            if (n0 < 1024) { const int sec = n0 >> 9, nn = n0 & 511, h = nn >> 7, bj = (nn >> 6) & 1, jj0 = nn & 63; dst = (bf16*)(ws + WS_WIN); drow = 512 * sec + 256 * (h >> 1) + 128 * bj + 64 * (h & 1) + jj0; }
            else if (n0 < 1536) { dst = (bf16*)(ws + WS_WV); drow = n0 - 1024; }
            else { dst = (bf16*)(ws + WS_WIN); drow = n0 - 512; }
            transpose_item(ap->in[6], 3072, D, ap->in[5], dst, drow, 64 * kb, n0, scr, lane); continue; }
        r -= I_IN;
        if (r < I_OUT) { const int kb = r / 32, nb = r % 32; transpose_item(ap->in[7], D, D, nullptr, (bf16*)(ws + WS_WOUT), 32 * nb, 64 * kb, 32 * nb, scr, lane); continue; }
        r -= I_OUT;
        if (r < 2 * I_GL) { const int wb = r >= I_GL; if (wb) r -= I_GL; const int kb = r / 32, nb = r % 32, n0 = 32 * nb;
            transpose_item(ap->in[wb ? 25 : 24], D, D, nullptr, (bf16*)(ws + WS_WGLU), 256 * (n0 >> 7) + (n0 & 127) + (wb ? 128 : 0), 64 * kb, n0, scr, lane); continue; }
        r -= 2 * I_GL;
        { const int mat = r >> 3, g = mat >> 1, gate = mat & 1, kb = (r >> 2) & 1, nb = r & 3;
            transpose_item(ap->in[gate ? 13 : 11] + (size_t)g * 128 * 128, 128, 128, nullptr, (bf16*)(ws + WS_WLRU) + (size_t)mat * 128 * 128, 32 * nb, 64 * kb, 32 * nb, scr, lane); }
    }
    { float* rope = (float*)(ws + WS_ROPE);
      for (int i = gw * 64 + lane; i < 2048 * 64; i += NGW * 64) { const int pos = i >> 6, j = i & 63; const double inv = pow(10000.0, -(double)j / 64.0); const double ang = (double)pos * inv;
          rope[2 * i] = (float)cos(ang); rope[2 * i + 1] = (float)sin(ang); } }
    { const float* x = ap->in[0]; bf16* xb = (bf16*)(ws + WS_XB); float* ssp = (float*)(ws + WS_SSP);
      for (int m = gw; m < TOK; m += NGW) { const f32x4* xr = (const f32x4*)(x + (size_t)m * D) + lane; f32x4 v[4]; float s = 0.f;
#pragma unroll
          for (int j = 0; j < 4; ++j) { v[j] = xr[64 * j]; s += (v[j][0] * v[j][0] + v[j][1] * v[j][1]) + (v[j][2] * v[j][2] + v[j][3] * v[j][3]); }
          s = wave_sum(s);
          v2u* o8 = (v2u*)(xb + (size_t)m * D) + lane;
#pragma unroll
          for (int j = 0; j < 4; ++j) { v2u w; w.x = cvt_pk_bf16(v[j][0], v[j][1]); w.y = cvt_pk_bf16(v[j][2], v[j][3]); o8[64 * j] = w; }
          if (lane < 16) ssp[(size_t)m * 32 + lane] = lane == 0 ? s : 0.f; } }
}

__device__ __forceinline__ void ret_unit(int b, int h, int p, const bf16* Q, const bf16* Kb, const bf16* Vt, const bf16* G, const float* ret_g, bf16* MRG, LAS unsigned char* lds, int tid, int wid, int lane) {
    const int fr = lane & 15, fq = lane >> 4;
    const int cq = 2 * p + (wid >> 2), iloc0 = 32 * (wid & 3);
    const size_t tok0 = (size_t)b * SEQ + 256 * p + 32 * wid;
    const float lg = log2f(1.0f - exp2f(-5.0f - (float)h));
    bf16x8 qf[2][4];
#pragma unroll
    for (int mi = 0; mi < 2; ++mi)
#pragma unroll
        for (int kk = 0; kk < 4; ++kk) qf[mi][kk] = *(const bf16x8*)(Q + (tok0 + 16 * mi + fr) * 512 + h * 128 + 32 * kk + 8 * fq);
    f32x4 O[2][8];
#pragma unroll
    for (int mi = 0; mi < 2; ++mi)
#pragma unroll
        for (int e = 0; e < 8; ++e) O[mi][e] = (f32x4){0.f, 0.f, 0.f, 0.f};
    const int nm = 2 * p + 2;
    const int srow = 4 * wid + (lane >> 4), keyK = ((wid >> 1) & 3) * 4 + (lane >> 4), keyV = 4 * (wid & 3) + (lane >> 4);
    const bf16* kbase = Kb + ((size_t)b * SEQ + srow) * 512 + h * 128 + 8 * ((lane & 15) ^ keyK);
    const bf16* vbase = Vt + ((size_t)(h * 128 + srow)) * TOK + (size_t)b * SEQ + 8 * ((lane & 15) ^ keyV);
#define RET_STAGE(m_, buf_) do { _Pragma("unroll") for (int i = 0; i < 4; ++i) { \
        __builtin_amdgcn_global_load_lds((const unsigned*)(kbase + ((size_t)(128 * (m_) + 32 * i)) * 512), (LAS unsigned*)(lds + (buf_) * 65536 + (8 * i + wid) * 1024), 16, 0, 0); \
        __builtin_amdgcn_global_load_lds((const unsigned*)(vbase + (size_t)(32 * i) * TOK + 128 * (m_)), (LAS unsigned*)(lds + (buf_) * 65536 + 32768 + (8 * i + wid) * 1024), 16, 0, 0); } } while (0)
    RET_STAGE(0, 0);
    asm volatile("s_waitcnt vmcnt(0)" ::: "memory"); __syncthreads();
    for (int m = 0; m < nm; ++m) {
        const int buf = m & 1;
        if (m + 1 < nm) RET_STAGE(m + 1, buf ^ 1);
        if (m <= cq) {
            const LAS unsigned char* Kl = lds + buf * 65536; const LAS unsigned char* Vl = Kl + 32768;
            const float sc = fast_exp2(lg * (float)(128 * (cq - m)));
#pragma unroll
            for (int g32 = 0; g32 < 4; ++g32) {
                f32x4 S[2][2];
#pragma unroll
                for (int n = 0; n < 2; ++n) { S[0][n] = (f32x4){0.f, 0.f, 0.f, 0.f}; S[1][n] = (f32x4){0.f, 0.f, 0.f, 0.f};
                    const int krow = 32 * g32 + 8 * (fr >> 2) + 4 * n + (fr & 3);
#pragma unroll
                    for (int kk = 0; kk < 4; ++kk) { const bf16x8 kf = *(const LAS bf16x8*)(Kl + krow * 256 + (((4 * kk + fq) ^ fr) << 4));
                        S[0][n] = mfma16(kf, qf[0][kk], S[0][n]); S[1][n] = mfma16(kf, qf[1][kk], S[1][n]); } }
                bf16x8 pf[2];
#pragma unroll
                for (int mi = 0; mi < 2; ++mi) { f32x4 v0 = S[mi][0] * sc, v1 = S[mi][1] * sc;
                    if (m == cq) { const int il = iloc0 + 16 * mi + fr, jl = 32 * g32 + 8 * fq;
#pragma unroll
                        for (int t = 0; t < 4; ++t) { v0[t] = (jl + t <= il) ? v0[t] : 0.f; v1[t] = (jl + 4 + t <= il) ? v1[t] : 0.f; } }
                    const pg8::u32x4 w = pack8(v0, v1); pf[mi] = __builtin_bit_cast(bf16x8, w); }
#pragma unroll
                for (int ef = 0; ef < 8; ++ef) { const int vrow = 16 * ef + fr;
                    const bf16x8 vf = *(const LAS bf16x8*)(Vl + vrow * 256 + (((4 * g32 + fq) ^ fr) << 4));
                    O[0][ef] = mfma16(vf, pf[0], O[0][ef]); O[1][ef] = mfma16(vf, pf[1], O[1][ef]); }
            }
        }
        asm volatile("s_waitcnt vmcnt(0)" ::: "memory"); __syncthreads();
    }
#undef RET_STAGE
#pragma unroll
    for (int mi = 0; mi < 2; ++mi) { const size_t tok = tok0 + 16 * mi + fr; float s = 0.f;
#pragma unroll
        for (int ef = 0; ef < 8; ++ef) s += (O[mi][ef][0] + O[mi][ef][1]) + (O[mi][ef][2] + O[mi][ef][3]);
        s += __shfl_xor(s, 16); s += __shfl_xor(s, 32); const float mu = s * (1.0f / 128.0f); float q = 0.f;
#pragma unroll
        for (int ef = 0; ef < 8; ++ef) { const f32x4 d = O[mi][ef] - mu; q += (d[0] * d[0] + d[1] * d[1]) + (d[2] * d[2] + d[3] * d[3]); }
        q += __shfl_xor(q, 16); q += __shfl_xor(q, 32); const float rstd = 1.0f / sqrtf(q * (1.0f / 128.0f) + 1e-6f);
#pragma unroll
        for (int ef = 0; ef < 8; ++ef) { const int col = h * 128 + 16 * ef + 4 * fq; const f32x4 gn = *(const f32x4*)(ret_g + col); const v2u gr = *(const v2u*)(G + tok * 1536 + col);
            const float g0 = bf_lo(gr.x), g1 = bf_hi(gr.x), g2 = bf_lo(gr.y), g3 = bf_hi(gr.y);
            const float y0 = (O[mi][ef][0] - mu) * rstd * gn[0] * silu_f(g0), y1 = (O[mi][ef][1] - mu) * rstd * gn[1] * silu_f(g1);
            const float y2 = (O[mi][ef][2] - mu) * rstd * gn[2] * silu_f(g2), y3 = (O[mi][ef][3] - mu) * rstd * gn[3] * silu_f(g3);
            v2u w; w.x = cvt_pk_bf16(y0, y1); w.y = cvt_pk_bf16(y2, y3); *(v2u*)(MRG + tok * 1024 + col) = w; } }
}

__device__ __forceinline__ void lru_unit(int b, int g, int q, const bf16* G, const bf16* LW, const float* conv_w, const float* conv_b, const float* b_a, const float* b_i, const float* lam,
                                         bf16* MRG, LAS unsigned char* lds, int tid, int wid, int lane) {
    const int fr = lane & 15, fq = lane >> 4;
    const bf16* wbase = LW + ((size_t)(g * 2 * 128 + 32 * q + fr)) * 128 + 8 * fq;
    LAS float* A_ = (LAS float*)lds; LAS float* BX = A_ + 8192; LAS float* SEG = BX + 8192; LAS float* CAR = SEG + 1024;
    const bf16* xl = G + (size_t)b * SEQ * 1536 + 512 + 128 * g;
    for (int tile = 0; tile < 8; ++tile) {
        const int s0 = 256 * tile + 32 * wid;
        f32x4 acc[2][4];
#pragma unroll
        for (int mi = 0; mi < 2; ++mi)
#pragma unroll
            for (int nf = 0; nf < 4; ++nf) acc[mi][nf] = (f32x4){0.f, 0.f, 0.f, 0.f};
#pragma unroll 1
        for (int kk = 0; kk < 4; ++kk) { const int ch0 = 32 * kk + 8 * fq, cg0 = 128 * g + ch0;
            bf16x8 wf[4];
#pragma unroll
            for (int nf = 0; nf < 4; ++nf) wf[nf] = *(const bf16x8*)(wbase + (size_t)(((nf >> 1) * 128 + 16 * (nf & 1)) * 128 + 32 * kk));
#pragma unroll
            for (int mi = 0; mi < 2; ++mi) { const int s = s0 + 16 * mi + fr; float xc[8];
                { const f32x4 c0 = *(const f32x4*)(conv_b + cg0), c1 = *(const f32x4*)(conv_b + cg0 + 4); xc[0] = c0[0]; xc[1] = c0[1]; xc[2] = c0[2]; xc[3] = c0[3]; xc[4] = c1[0]; xc[5] = c1[1]; xc[6] = c1[2]; xc[7] = c1[3]; }
#pragma unroll
                for (int tap = 0; tap < 4; ++tap) { const int sp = s - 3 + tap; if (sp >= 0) { const v4u xv = *(const v4u*)(xl + (size_t)sp * 1536 + ch0);
                        const f32x4 w0 = *(const f32x4*)(conv_w + tap * 512 + cg0), w1 = *(const f32x4*)(conv_w + tap * 512 + cg0 + 4);
                        xc[0] += w0[0] * bf_lo(xv.x); xc[1] += w0[1] * bf_hi(xv.x); xc[2] += w0[2] * bf_lo(xv.y); xc[3] += w0[3] * bf_hi(xv.y);
                        xc[4] += w1[0] * bf_lo(xv.z); xc[5] += w1[1] * bf_hi(xv.z); xc[6] += w1[2] * bf_lo(xv.w); xc[7] += w1[3] * bf_hi(xv.w); } }
                pg8::u32x4 aw; aw.x = cvt_pk_bf16(xc[0], xc[1]); aw.y = cvt_pk_bf16(xc[2], xc[3]); aw.z = cvt_pk_bf16(xc[4], xc[5]); aw.w = cvt_pk_bf16(xc[6], xc[7]);
                const bf16x8 af = __builtin_bit_cast(bf16x8, aw);
#pragma unroll
                for (int nf = 0; nf < 4; ++nf) acc[mi][nf] = mfma16(wf[nf], af, acc[mi][nf]); } }
#pragma unroll
        for (int mi = 0; mi < 2; ++mi)
#pragma unroll
            for (int nfl = 0; nfl < 2; ++nfl) { const int cl = 32 * q + 16 * nfl + 4 * fq, cg0 = 128 * g + cl, s = s0 + 16 * mi + fr;
                f32x4 xc = *(const f32x4*)(conv_b + cg0);
#pragma unroll
                for (int tap = 0; tap < 4; ++tap) { const int sp = s - 3 + tap; if (sp >= 0) { const v2u xv = *(const v2u*)(xl + (size_t)sp * 1536 + cl); const f32x4 w0 = *(const f32x4*)(conv_w + tap * 512 + cg0);
                        xc[0] += w0[0] * bf_lo(xv.x); xc[1] += w0[1] * bf_hi(xv.x); xc[2] += w0[2] * bf_lo(xv.y); xc[3] += w0[3] * bf_hi(xv.y); } }
                const f32x4 ba = *(const f32x4*)(b_a + cg0), bi = *(const f32x4*)(b_i + cg0), lm = *(const f32x4*)(lam + cg0); f32x4 av, bv;
#pragma unroll
                for (int t = 0; t < 4; ++t) { const float r = sigmoid_f(acc[mi][nfl][t] + ba[t]), ig = sigmoid_f(acc[mi][nfl + 2][t] + bi[t]);
                    const float la = -8.0f * r * log1pf(__expf(-lm[t])); av[t] = __expf(la); bv[t] = sqrtf(-expm1f(2.0f * la)) * ig * xc[t]; }
                const int rt = 32 * wid + 16 * mi + fr;
                *(LAS f32x4*)(A_ + rt * 32 + 16 * nfl + 4 * fq) = av; *(LAS f32x4*)(BX + rt * 32 + 16 * nfl + 4 * fq) = bv; }
        __syncthreads();
        const int c = tid & 31, seg = tid >> 5;
        { float P = 1.f, hl = 0.f;
#pragma unroll
          for (int k = 0; k < 16; ++k) { const float av = A_[(16 * seg + k) * 32 + c], bv = BX[(16 * seg + k) * 32 + c]; hl = av * hl + bv; P *= av; }
          SEG[(seg * 32 + c) * 2] = P; SEG[(seg * 32 + c) * 2 + 1] = hl; }
        __syncthreads();
        float hin = tile == 0 ? 0.f : CAR[(tile & 1) * 32 + c];
        for (int s2 = 0; s2 < seg; ++s2) hin = SEG[(s2 * 32 + c) * 2] * hin + SEG[(s2 * 32 + c) * 2 + 1];
        const size_t tokb = (size_t)b * SEQ + 256 * tile + 16 * seg;
#pragma unroll
        for (int k = 0; k < 16; ++k) { const float av = A_[(16 * seg + k) * 32 + c], bv = BX[(16 * seg + k) * 32 + c]; hin = av * hin + bv;
            const float gl = bf1(G[(tokb + k) * 1536 + 1024 + 128 * g + 32 * q + c]);
            MRG[(tokb + k) * 1024 + 512 + 128 * g + 32 * q + c] = (bf16)f2bf(hin * gelu_tanh_f(gl)); }
        if (seg == 15) CAR[((tile + 1) & 1) * 32 + c] = hin;
        __syncthreads();
    }
}

constexpr int S5_WLDS = 27648;
__device__ __forceinline__ void s5_unit(int b, int g, KArgP ap, const float* x, const float* ssp, bf16* YS, LAS unsigned char* wl, int lane) {
    const float* lam_re = ap->in[16]; const float* lam_im = ap->in[17]; const float* log_dt = ap->in[18]; const float* b_re = ap->in[19]; const float* b_im = ap->in[20];
    const float* c_re = ap->in[21]; const float* c_im = ap->in[22]; const float* dsk = ap->in[23]; const float* gmix = ap->in[5] + D;
    LAS float* BU = (LAS float*)wl; LAS unsigned char* Hh = wl + 16384; LAS float* U = (LAS float*)(wl + 16384 + 8704);
    const float dt = __expf(log_dt[g]);
    float lr, li;
    { const float re = lam_re[g * 64 + lane], im = lam_im[g * 64 + lane], mag = __expf(re * dt); lr = mag * cosf(im * dt); li = mag * sinf(im * dt); }
    bf16x8 bfr[4];
#pragma unroll
    for (int q = 0; q < 4; ++q) { const int pp = 16 * q + ((lane & 31) >> 1), comp = lane & 1, hh = lane >> 5;
        const float re = lam_re[g * 64 + pp], im = lam_im[g * 64 + pp], mag = __expf(re * dt), lbr = mag * cosf(im * dt), lbi = mag * sinf(im * dt);
        const float den = re * re + im * im, nr = lbr - 1.0f, ni = lbi, fre = (nr * re + ni * im) / den, fim = (ni * re - nr * im) / den;
        const f32x4* pr = (const f32x4*)(b_re + ((size_t)(g * 64 + pp)) * 16 + 8 * hh); const f32x4* pi = (const f32x4*)(b_im + ((size_t)(g * 64 + pp)) * 16 + 8 * hh);
        const f32x4 r0 = pr[0], r1 = pr[1], i0 = pi[0], i1 = pi[1]; f32x4 o0, o1;
#pragma unroll
        for (int t = 0; t < 4; ++t) { o0[t] = comp ? (fre * i0[t] + fim * r0[t]) : (fre * r0[t] - fim * i0[t]); o1[t] = comp ? (fre * i1[t] + fim * r1[t]) : (fre * r1[t] - fim * i1[t]); }
        const pg8::u32x4 w = pack8(o0, o1); bfr[q] = __builtin_bit_cast(bf16x8, w); }
    bf16x8 cfr[4];
#pragma unroll
    for (int kk = 0; kk < 4; ++kk) { const int c = lane & 15, kq = lane >> 4, p0 = 16 * kk + 4 * kq;
        const f32x4 cr = *(const f32x4*)(c_re + ((size_t)(g * 16 + c)) * 64 + p0), ci = *(const f32x4*)(c_im + ((size_t)(g * 16 + c)) * 64 + p0);
        pg8::u32x4 w; w.x = cvt_pk_bf16(cr[0], -ci[0]); w.y = cvt_pk_bf16(cr[1], -ci[1]); w.z = cvt_pk_bf16(cr[2], -ci[2]); w.w = cvt_pk_bf16(cr[3], -ci[3]); cfr[kk] = __builtin_bit_cast(bf16x8, w); }
    const int tr = lane & 31, hh = lane >> 5;
    const f32x4 gm0 = *(const f32x4*)(gmix + 16 * g + 8 * hh), gm1 = *(const f32x4*)(gmix + 16 * g + 8 * hh + 4);
    const float dch = dsk[16 * g + (lane & 15)];
    float hre = 0.f, him = 0.f;
    const size_t tokb = (size_t)b * SEQ;
    f32x4 nx0, nx1; float nrs;
    { const size_t tok = tokb + tr; nx0 = *(const f32x4*)(x + tok * D + 16 * g + 8 * hh); nx1 = *(const f32x4*)(x + tok * D + 16 * g + 8 * hh + 4); nrs = row_rs(ssp, 16, (int)tok); }
    for (int blk = 0; blk < 64; ++blk) {
        f32x4 u0 = nx0 * nrs * gm0, u1 = nx1 * nrs * gm1;
        if (blk + 1 < 64) { const size_t tok = tokb + 32 * (blk + 1) + tr; nx0 = *(const f32x4*)(x + tok * D + 16 * g + 8 * hh); nx1 = *(const f32x4*)(x + tok * D + 16 * g + 8 * hh + 4); nrs = row_rs(ssp, 16, (int)tok); }
        *(LAS f32x4*)(U + tr * 16 + 8 * hh) = u0; *(LAS f32x4*)(U + tr * 16 + 8 * hh + 4) = u1;
        const pg8::u32x4 uw = pack8(u0, u1); const bf16x8 uf = __builtin_bit_cast(bf16x8, uw);
#pragma unroll
        for (int q = 0; q < 4; ++q) { f32x16 d;
#pragma unroll
            for (int r = 0; r < 16; ++r) d[r] = 0.f;
            d = __builtin_amdgcn_mfma_f32_32x32x16_bf16(uf, bfr[q], d, 0, 0, 0);
#pragma unroll
            for (int r = 0; r < 16; ++r) BU[((r & 3) + 8 * (r >> 2) + 4 * hh) * 128 + 32 * q + tr] = d[r]; }
        LDS_WAIT(); asm volatile("" ::: "memory");
#pragma unroll
        for (int t = 0; t < 32; ++t) { const f32x2 bu = *(const LAS f32x2*)(BU + t * 128 + 2 * lane);
            const float nr = lr * hre - li * him + bu[0], ni = lr * him + li * hre + bu[1]; hre = nr; him = ni;
            *(LAS unsigned*)(Hh + t * 272 + 4 * lane) = cvt_pk_bf16(nr, ni); }
        LDS_WAIT(); asm volatile("" ::: "memory");
        const int c = lane & 15, kq = lane >> 4;
#pragma unroll
        for (int tf = 0; tf < 2; ++tf) { f32x4 y = (f32x4){0.f, 0.f, 0.f, 0.f};
#pragma unroll
            for (int kk = 0; kk < 4; ++kk) { const bf16x8 hf = *(const LAS bf16x8*)(Hh + (16 * tf + c) * 272 + (32 * kk + 8 * kq) * 2); y = mfma16(hf, cfr[kk], y); }
#pragma unroll
            for (int r = 0; r < 4; ++r) { const int t = 16 * tf + 4 * kq + r; const float uu = U[t * 16 + c]; const float yv = y[r] + dch * uu;
                YS[(tokb + 32 * blk + t) * 1024 + 16 * g + c] = (bf16)f2bf(gelu_tanh_f(yv)); } }
        LDS_WAIT(); asm volatile("" ::: "memory");
    }
}

template <int ph> __device__ __forceinline__ void phase_body(LAS unsigned char* lds) {
    int tid = threadIdx.x; asm volatile("" : "+v"(tid));
    const int lane = tid & 63, wave = __builtin_amdgcn_readfirstlane(tid >> 6);
    const int G_ = gridDim.x, bx = blockIdx.x;
    const int gw = bx * NWAVES + wave, NGW = G_ * NWAVES;
    KArgP ap = (KArgP)__builtin_amdgcn_kernarg_segment_ptr(); asm volatile("" : "+s"(ap));
    unsigned char* ws = ap->ws;
    float* X = ap->out;
    bf16* XB = (bf16*)(ws + WS_XB); float* SSP = (float*)(ws + WS_SSP); bf16* HID = (bf16*)(ws + WS_R1); bf16* MRG = (bf16*)(ws + WS_MRG);
    (void)gw; (void)NGW; (void)lane; (void)X; (void)XB; (void)SSP; (void)HID; (void)MRG;
        if constexpr (ph == 0 && (PHM & 1)) { p0_prologue(ap, lds, gw, NGW, wave, lane); }
        else if constexpr ((PHM & 2) && (ph == 1 || ph == 6 || ph == 8 || ph == 12)) {
            const int l = ph == 1 ? 0 : ph == 6 ? 1 : ph == 8 ? 2 : 3;
            pg8::Gemm g{XB, (const bf16*)(ws + WS_W13) + (size_t)l * 5632 * 1024, TOK, 5632, D}; pg8::StaticOrder S; S.init(TOK, 5632, G_, bx);
            pg8::EpiSwiglu E{HID, FF, SSP, ph == 12 ? 32 : 16};
            pg8::gemm_phase<pg8::EpiSwiglu, pg8::StaticOrder, true, true>(lds, g, S, E);
        }
        else if constexpr ((PHM & 4) && (ph == 2 || ph == 7 || ph == 9 || ph == 13 || ph == 5)) {
            const int l = ph == 2 ? 0 : ph == 7 ? 1 : ph == 9 ? 2 : 3;
            pg8::Gemm g; g.M = TOK; g.N = D;
            if (ph == 5) { g.A = MRG; g.Bt = (const bf16*)(ws + WS_WOUT); g.K = D; } else { g.A = HID; g.Bt = (const bf16*)(ws + WS_W2) + (size_t)l * 1024 * FF; g.K = FF; }
            pg8::StaticOrder S; S.init(TOK, D, G_, bx);
            pg8::EpiResid E{ph == 2 ? ap->in[0] : X, X, XB, SSP, ph == 5 ? 1.0f : 0.5f};
            pg8::gemm_phase<pg8::EpiResid, pg8::StaticOrder, true, true>(lds, g, S, E);
        }
        else if constexpr ((PHM & 8) && ph == 3) {
            { pg8::Gemm g{XB, (const bf16*)(ws + WS_WIN), TOK, 1024, D}; pg8::StaticOrder S; S.init(TOK, 1024, G_, bx);
              pg8::EpiRope E{(bf16*)(ws + WS_Q), (bf16*)(ws + WS_K), (const float*)(ws + WS_ROPE), SSP, 16};
              pg8::gemm_phase<pg8::EpiRope, pg8::StaticOrder, true, true>(lds, g, S, E); }
            { pg8::Gemm g{XB, (const bf16*)(ws + WS_WIN) + (size_t)1024 * 1024, TOK, 1536, D}; pg8::StaticOrder S; S.init(TOK, 1536, G_, bx);
              pg8::EpiScaled E{(bf16*)(ws + WS_G), 1536, SSP, 16};
              pg8::gemm_phase<pg8::EpiScaled, pg8::StaticOrder, true, true>(lds, g, S, E); }
            { pg8::Gemm g{(const bf16*)(ws + WS_WV), XB, 512, TOK, D}; pg8::StaticOrder S; S.init(512, TOK, G_, bx);
              pg8::EpiPlain E{(bf16*)(ws + WS_VT), TOK};
              pg8::gemm_phase<pg8::EpiPlain, pg8::StaticOrder, true, true>(lds, g, S, E); }
        }
        else if constexpr ((PHM & 16) && ph == 4) {
#ifndef NO_RET
            for (int i = 0; i < 2; ++i) { const int bh = bx >> 2, pp = bx & 3, p = i == 0 ? pp : 7 - pp;
                ret_unit(bh >> 2, bh & 3, p, (const bf16*)(ws + WS_Q), (const bf16*)(ws + WS_K), (const bf16*)(ws + WS_VT), (const bf16*)(ws + WS_G), ap->in[8], MRG, lds, tid, wave, lane); }
#endif
#ifndef NO_LRU
            lru_unit(bx >> 4, (bx >> 2) & 3, bx & 3, (const bf16*)(ws + WS_G), (const bf16*)(ws + WS_WLRU), ap->in[9], ap->in[10], ap->in[12], ap->in[14], ap->in[15], MRG, lds, tid, wave, lane);
#endif
        }
        else if constexpr ((PHM & 32) && ph == 10) {
            if (wave < 4) { const int unit = bx * 4 + wave; s5_unit(unit >> 6, unit & 63, ap, X, SSP, MRG, lds + wave * S5_WLDS, lane); }
        }
        else if constexpr ((PHM & 64) && ph == 11) {
            pg8::Gemm g{MRG, (const bf16*)(ws + WS_WGLU), TOK, 2048, D}; pg8::StaticOrder S; S.init(TOK, 2048, G_, bx);
            pg8::EpiGluResid E{X, X, XB, SSP};
            pg8::gemm_phase<pg8::EpiGluResid, pg8::StaticOrder, true, true>(lds, g, S, E);
        }
        else if constexpr ((PHM & 128) && ph == 14) {
            const float* gf = ap->in[26];
            for (int m = gw; m < TOK; m += NGW) { const float rs = row_rs(SSP, 16, m); f32x4* xr = (f32x4*)(X + (size_t)m * D) + lane; const f32x4* gr = (const f32x4*)gf + lane;
#pragma unroll
                for (int j = 0; j < 4; ++j) xr[64 * j] = xr[64 * j] * rs * gr[64 * j]; }
        }
}
__global__ void __launch_bounds__(NWAVES * 64, 2) mega_fwd(Args a_) {
    extern __shared__ __attribute__((aligned(16))) unsigned char lds_raw[];
    LAS unsigned char* lds = (LAS unsigned char*)lds_raw;
    cg::grid_group grid = cg::this_grid();
    const int ph_lo = a_.ph_lo, ph_hi = a_.ph_hi;
#define PHASE(k) if (ph_lo <= (k) && (k) < ph_hi) { phase_body<k>(lds); if ((k) + 1 < ph_hi) grid.sync(); }
    PHASE(0) PHASE(1) PHASE(2) PHASE(3) PHASE(4) PHASE(5) PHASE(6) PHASE(7) PHASE(8) PHASE(9) PHASE(10) PHASE(11) PHASE(12) PHASE(13) PHASE(14)
#undef PHASE
}

extern "C" void kernel_launch(void* const* d_in, const int* in_sizes, int n_in, void* d_out, int out_size, void* d_ws, size_t ws_size, hipStream_t stream) {
    static int grid = 0;
    if (grid == 0) {
        if (n_in != 27 || in_sizes[0] != TOK * D || out_size != TOK * D || ws_size < WS_END) { fprintf(stderr, "kernel_launch: unexpected shapes (n_in %d, in0 %d, out %d, ws %zu)\n", n_in, n_in > 0 ? in_sizes[0] : -1, out_size, ws_size); grid = -1; return; }
        int dev = 0, cus = 0, per_cu = 0;
        (void)hipGetDevice(&dev); (void)hipDeviceGetAttribute(&cus, hipDeviceAttributeMultiprocessorCount, dev);
        if (hipFuncSetAttribute((const void*)mega_fwd, hipFuncAttributeMaxDynamicSharedMemorySize, LDS_BYTES) != hipSuccess) { fprintf(stderr, "kernel_launch: hipFuncSetAttribute failed\n"); grid = -1; return; }
        if (hipOccupancyMaxActiveBlocksPerMultiprocessor(&per_cu, (const void*)mega_fwd, NWAVES * 64, LDS_BYTES) != hipSuccess || per_cu < 1) { fprintf(stderr, "kernel_launch: occupancy query says %d blocks per CU\n", per_cu); per_cu = 1; }
        (void)hipGetLastError();
        grid = cus * 1;
    }
    if (grid < 0) return;
    Args a{};
    for (int i = 0; i < 27; ++i) a.in[i] = (const float*)d_in[i];
    a.out = (float*)d_out; a.ws = (unsigned char*)d_ws;
#if MK_PER_PHASE
    for (int ph = 0; ph < NPH; ++ph) { a.ph_lo = ph; a.ph_hi = ph + 1; hipLaunchKernelGGL(mega_fwd, dim3(grid), dim3(NWAVES * 64), LDS_BYTES, stream, a); }
#else
    a.ph_lo = 0; a.ph_hi = NPH;
    void* params[] = {&a};
    const hipError_t e = hipLaunchCooperativeKernel((const void*)mega_fwd, dim3(grid), dim3(NWAVES * 64), params, LDS_BYTES, stream);
    if (e != hipSuccess) fprintf(stderr, "kernel_launch: cooperative launch failed: %s (grid %d)\n", hipGetErrorString(e), grid);
#endif
}
```

```cpp
#include <hip/hip_runtime.h>
#include <hip/hip_cooperative_groups.h>
#include <cstdio>
#include <cstdint>
#include <cmath>
namespace cg = cooperative_groups;
namespace pg8 {
#define PG8_LAS __attribute__((address_space(3)))
typedef unsigned short bf16_t;
typedef short bf16x8 __attribute__((ext_vector_type(8)));
typedef float f32x4 __attribute__((ext_vector_type(4)));
typedef unsigned u32x4 __attribute__((ext_vector_type(4)));
constexpr int BM = 256, BK = 64, HALF = 128, HTB = HALF * BK * 2  , STAGE_BYTES = 8 * HTB, NXCD = 8, WGM = 8;

__host__ __device__ __forceinline__ int lds_byte(int r, int c) { const int st = (r >> 4) * 2 + (c >> 5), rr = r & 15, cc = c & 31, ob = rr * 64 + cc * 2; return st * 1024 + (ob ^ (((ob >> 9) & 1) << 5)); }
__host__ __device__ __forceinline__ void stage_rc(int b, int& R, int& C) { const int st = b / 1024, sb = b % 1024, swz = sb ^ (((sb >> 9) & 1) << 5); R = (st >> 1) * 16 + swz / 64; C = (st & 1) * 32 + (swz % 64) / 2; }
__host__ __device__ __forceinline__ int perm32(int rho) { const int n = rho >> 4, i = rho & 15; return 8 * (i >> 2) + 4 * n + (i & 3); }

struct Unit { int pm, pn; };
struct Gemm { const bf16_t* A; const bf16_t* Bt; int M, N, K; };

struct StaticOrder {
    int nM, nN, nwg, G, c;
    __host__ __device__ void init(int M, int N, int G_, int c_) { nM = M / BM; nN = N / BM; nwg = nM * nN; G = G_; c = c_; }
    __host__ __device__ bool next(int i, Unit& u) const {
        const long L = (long)i * G + c; if (L >= nwg) return false;
        int wgid = (int)L; { const int q = nwg / NXCD, r = nwg % NXCD, xcd = wgid % NXCD, off = wgid / NXCD; wgid = (xcd < r ? xcd * (q + 1) : r * (q + 1) + (xcd - r) * q) + off; }
        const int nig = WGM * nN, gid = wgid / nig, fm = gid * WGM, gsz = (nM - fm) < WGM ? (nM - fm) : WGM;
        u.pm = fm + ((wgid % nig) % gsz); u.pn = (wgid % nig) / gsz; return true;
    }
    __device__ __forceinline__ void a_ready(const Unit&) const {}
    __device__ __forceinline__ void done(const Unit&) const {}
};

__device__ __forceinline__ unsigned cvt_pk_bf16(float lo, float hi) { unsigned r; asm volatile("v_cvt_pk_bf16_f32 %0, %1, %2" : "=v"(r) : "v"(lo), "v"(hi)); return r; }
__device__ __forceinline__ u32x4 pack8(const f32x4 a, const f32x4 b) { u32x4 w; w.x = cvt_pk_bf16(a[0], a[1]); w.y = cvt_pk_bf16(a[2], a[3]); w.z = cvt_pk_bf16(b[0], b[1]); w.w = cvt_pk_bf16(b[2], b[3]); return w; }
__device__ __forceinline__ float fast_rcp(float x) { return __builtin_amdgcn_rcpf(x); }
__device__ __forceinline__ float fast_exp2(float x) { return __builtin_amdgcn_exp2f(x); }
__device__ __forceinline__ float sigmoid_f(float x) { return fast_rcp(1.0f + fast_exp2(-1.4426950409f * x)); }
__device__ __forceinline__ float silu_f(float x) { return x * sigmoid_f(x); }
__device__ __forceinline__ float gelu_tanh_f(float v) { const float u = v + 0.044715f * v * v * v; return v * sigmoid_f(1.5957691216f * u); }
__device__ __forceinline__ float row_rs(const float* ssp, int nparts, int row) {
    const f32x4* p = (const f32x4*)(ssp + (size_t)row * 32); float s = 0.f;
#pragma unroll
    for (int i = 0; i < 4; ++i) { const f32x4 v = p[i]; s += (v[0] + v[1]) + (v[2] + v[3]); }
    if (nparts > 16) {
#pragma unroll
        for (int i = 4; i < 8; ++i) { const f32x4 v = p[i]; s += (v[0] + v[1]) + (v[2] + v[3]); } }
    return 1.0f / sqrtf(s * (1.0f / 1024.0f) + 1e-6f);
}
__device__ __forceinline__ void row_rs8(float (&rs)[8], const float* ssp, int nparts, int row0) {
#pragma unroll
    for (int h = 0; h < 2; ++h) {
#pragma unroll
        for (int i = 0; i < 4; ++i) rs[4 * h + i] = row_rs(ssp, nparts, row0 + h * HALF + i * 16);
        asm volatile("" : "+v"(rs[4 * h]), "+v"(rs[4 * h + 1]), "+v"(rs[4 * h + 2]), "+v"(rs[4 * h + 3]) :: "memory"); }
}

struct EpiSwiglu {
    static constexpr bool PERM = true, AFTER_DRAIN = false;
    bf16_t* O; int ldo; const float* ssp; int nparts;
    __device__ __forceinline__ void operator()(const f32x4 (&acc)[2][2][4][2], const Unit& u, int wr, int wc, int fr, int fq) const {
        const int row0 = u.pm * BM + wr * 64 + fr, col0 = u.pn * 128 + wc * 32 + 8 * fq;
        float rs8[8]; row_rs8(rs8, ssp, nparts, row0);
#pragma unroll
        for (int ai = 0; ai < 2; ++ai)
#pragma unroll
            for (int m = 0; m < 4; ++m) { const int row = row0 + ai * HALF + m * 16; const float rs = rs8[ai * 4 + m];
                f32x4 h[2];
#pragma unroll
                for (int n = 0; n < 2; ++n)
#pragma unroll
                    for (int t = 0; t < 4; ++t) { const float a = acc[ai][0][m][n][t] * rs, b = acc[ai][1][m][n][t] * rs; h[n][t] = silu_f(a) * b; }
                *(u32x4*)(O + (size_t)row * ldo + col0) = pack8(h[0], h[1]); }
    }
};
struct EpiResid {
    static constexpr bool PERM = true, AFTER_DRAIN = false;
    const float* xin; float* xout; bf16_t* xb; float* ssp; float alpha;
    __device__ __forceinline__ void operator()(const f32x4 (&acc)[2][2][4][2], const Unit& u, int wr, int wc, int fr, int fq) const {
        const int row0 = u.pm * BM + wr * 64 + fr, col0 = u.pn * BM + wc * 32 + 8 * fq;
#pragma unroll
        for (int ai = 0; ai < 2; ++ai)
#pragma unroll
            for (int m = 0; m < 4; ++m) { const int row = row0 + ai * HALF + m * 16; float ss = 0.f;
#pragma unroll
                for (int bj = 0; bj < 2; ++bj) { const size_t off = (size_t)row * 1024 + col0 + bj * HALF;
                    const f32x4 o0 = *(const f32x4*)(xin + off), o1 = *(const f32x4*)(xin + off + 4);
                    const f32x4 v0 = o0 + alpha * acc[ai][bj][m][0], v1 = o1 + alpha * acc[ai][bj][m][1];
                    *(f32x4*)(xout + off) = v0; *(f32x4*)(xout + off + 4) = v1; *(u32x4*)(xb + off) = pack8(v0, v1);
                    ss += (v0[0] * v0[0] + v0[1] * v0[1]) + (v0[2] * v0[2] + v0[3] * v0[3]) + (v1[0] * v1[0] + v1[1] * v1[1]) + (v1[2] * v1[2] + v1[3] * v1[3]); }
                ss += __shfl_xor(ss, 16); ss += __shfl_xor(ss, 32);
                if (fq == 0) ssp[(size_t)row * 32 + 4 * u.pn + wc] = ss; if (m == 3) asm volatile("" ::: "memory"); }
    }
};
struct EpiGluResid {
    static constexpr bool PERM = true, AFTER_DRAIN = false;
    const float* xin; float* xout; bf16_t* xb; float* ssp;
    __device__ __forceinline__ void operator()(const f32x4 (&acc)[2][2][4][2], const Unit& u, int wr, int wc, int fr, int fq) const {
        const int row0 = u.pm * BM + wr * 64 + fr, col0 = u.pn * 128 + wc * 32 + 8 * fq;
#pragma unroll
        for (int ai = 0; ai < 2; ++ai)
#pragma unroll
            for (int m = 0; m < 4; ++m) { const int row = row0 + ai * HALF + m * 16; const size_t off = (size_t)row * 1024 + col0;
                const f32x4 o0 = *(const f32x4*)(xin + off), o1 = *(const f32x4*)(xin + off + 4); f32x4 v0, v1;
#pragma unroll
                for (int t = 0; t < 4; ++t) { v0[t] = o0[t] + acc[ai][0][m][0][t] * sigmoid_f(acc[ai][1][m][0][t]); v1[t] = o1[t] + acc[ai][0][m][1][t] * sigmoid_f(acc[ai][1][m][1][t]); }
                *(f32x4*)(xout + off) = v0; *(f32x4*)(xout + off + 4) = v1; *(u32x4*)(xb + off) = pack8(v0, v1);
                float ss = (v0[0] * v0[0] + v0[1] * v0[1]) + (v0[2] * v0[2] + v0[3] * v0[3]) + (v1[0] * v1[0] + v1[1] * v1[1]) + (v1[2] * v1[2] + v1[3] * v1[3]);
                ss += __shfl_xor(ss, 16); ss += __shfl_xor(ss, 32);
                if (fq == 0) ssp[(size_t)row * 32 + 4 * u.pn + wc] = ss; if (m == 3) asm volatile("" ::: "memory"); }
    }
};
struct EpiPlain {
    static constexpr bool PERM = true, AFTER_DRAIN = false;
    bf16_t* O; int ldo;
    __device__ __forceinline__ void operator()(const f32x4 (&acc)[2][2][4][2], const Unit& u, int wr, int wc, int fr, int fq) const {
        const int row0 = u.pm * BM + wr * 64 + fr, col0 = u.pn * BM + wc * 32 + 8 * fq;
#pragma unroll
        for (int ai = 0; ai < 2; ++ai)
#pragma unroll
            for (int m = 0; m < 4; ++m) { bf16_t* rowp = O + (size_t)(row0 + ai * HALF + m * 16) * ldo + col0;
#pragma unroll
                for (int bj = 0; bj < 2; ++bj) *(u32x4*)(rowp + bj * HALF) = pack8(acc[ai][bj][m][0], acc[ai][bj][m][1]); }
    }
};
__device__ __forceinline__ float lg_gamma(int h) { return h == 0 ? -0.04580368961312479f : h == 1 ? -0.02272007650008353f : h == 2 ? -0.011315313227834146f : -0.005646563141142063f; }
struct EpiRope {
    static constexpr bool PERM = true, AFTER_DRAIN = false;
    bf16_t* Q; bf16_t* K; const float* rope; const float* ssp; int nparts;
    __device__ __forceinline__ void operator()(const f32x4 (&acc)[2][2][4][2], const Unit& u, int wr, int wc, int fr, int fq) const {
        typedef unsigned u32x2 __attribute__((ext_vector_type(2)));
        const int row0 = u.pm * BM + wr * 64 + fr;
        const int head = 2 * (u.pn & 1) + (wc >> 1), jj0 = (wc & 1) * 32 + 8 * fq; bf16_t* dst = (u.pn < 2) ? Q : K;
        const float lg = lg_gamma(head);
        float rs8[8]; row_rs8(rs8, ssp, nparts, row0);
#pragma unroll
        for (int ai = 0; ai < 2; ++ai)
#pragma unroll
            for (int m = 0; m < 4; ++m) { const int row = row0 + ai * HALF + m * 16, pos = row & 2047; const float rs = rs8[4 * ai + m];
                const float sc = (u.pn < 2) ? rs * fast_exp2(lg * (float)(pos & 127)) : rs * rs * 0.08838834764831845f * fast_exp2(-lg * (float)(pos & 127));
                const f32x4* rp = (const f32x4*)(rope + ((size_t)pos * 64 + jj0) * 2);
                bf16_t* rowp = dst + (size_t)row * 512 + head * 128 + jj0;
#pragma unroll
                for (int n = 0; n < 2; ++n) { const f32x4 cs0 = rp[2 * n], cs1 = rp[2 * n + 1]; const f32x4 x1 = acc[ai][0][m][n] * sc, x2 = acc[ai][1][m][n] * sc; f32x4 o1, o2;
                    o1[0] = x1[0] * cs0[0] - x2[0] * cs0[1]; o2[0] = x1[0] * cs0[1] + x2[0] * cs0[0];
                    o1[1] = x1[1] * cs0[2] - x2[1] * cs0[3]; o2[1] = x1[1] * cs0[3] + x2[1] * cs0[2];
                    o1[2] = x1[2] * cs1[0] - x2[2] * cs1[1]; o2[2] = x1[2] * cs1[1] + x2[2] * cs1[0];
                    o1[3] = x1[3] * cs1[2] - x2[3] * cs1[3]; o2[3] = x1[3] * cs1[3] + x2[3] * cs1[2];
                    u32x2 w1, w2; w1.x = cvt_pk_bf16(o1[0], o1[1]); w1.y = cvt_pk_bf16(o1[2], o1[3]); w2.x = cvt_pk_bf16(o2[0], o2[1]); w2.y = cvt_pk_bf16(o2[2], o2[3]);
                    *(u32x2*)(rowp + 4 * n) = w1; *(u32x2*)(rowp + 64 + 4 * n) = w2; } if (m & 1) asm volatile("" ::: "memory"); }
    }
};
struct EpiScaled {
    static constexpr bool PERM = true, AFTER_DRAIN = false;
    bf16_t* O; int ldo; const float* ssp; int nparts;
    __device__ __forceinline__ void operator()(const f32x4 (&acc)[2][2][4][2], const Unit& u, int wr, int wc, int fr, int fq) const {
        const int row0 = u.pm * BM + wr * 64 + fr, col0 = u.pn * BM + wc * 32 + 8 * fq;
        float rs8[8]; row_rs8(rs8, ssp, nparts, row0);
#pragma unroll
        for (int ai = 0; ai < 2; ++ai)
#pragma unroll
            for (int m = 0; m < 4; ++m) { const int row = row0 + ai * HALF + m * 16; const float rs = rs8[4 * ai + m]; bf16_t* rowp = O + (size_t)row * ldo + col0;
#pragma unroll
                for (int bj = 0; bj < 2; ++bj) *(u32x4*)(rowp + bj * HALF) = pack8(acc[ai][bj][m][0] * rs, acc[ai][bj][m][1] * rs); }
    }
};
template <class Epi, class Sched, bool ALIGN_EPI = false, bool SP2 = false>
__device__ __forceinline__ void gemm_phase(PG8_LAS unsigned char* lds, const Gemm g, const Sched& S, const Epi& E, int tid_in) {
    int tid_ = tid_in; asm volatile("" : "+v"(tid_));
    const int tid = tid_, wid = __builtin_amdgcn_readfirstlane(tid >> 6), lane = tid & 63, wr = wid >> 2, wc = wid & 3, fr = lane & 15, fq = lane >> 4;
    const int K = g.K, nt = K / BK;
    unsigned voffA[2], voffB[2];
#pragma unroll
    for (int i = 0; i < 2; ++i) { int R, C; stage_rc(tid * 16 + i * 8192, R, C); const int Rb = Epi::PERM ? ((R & ~31) + perm32(R & 31)) : R;
        voffA[i] = (unsigned)(R * K + C) * 2u; voffB[i] = (unsigned)(Rb * K + C) * 2u; }
    const size_t kstep = (size_t)(BK * 2);
    const size_t hstep = (size_t)HALF * K * 2;
    const size_t tstep = 2 * hstep;
    const unsigned ldsw = (unsigned)wid * 1024u;
    const int aoff = lds_byte(wr * 64 + fr, fq * 8), boff = lds_byte(wc * 32 + fr, fq * 8);
#define PG8_SA(b, h) (((b) * 2 + (h)) * HTB)
#define PG8_SB(b, h) ((4 + (b) * 2 + (h)) * HTB)
#define PG8_STAGE(bufoff, gbase, voff) do { _Pragma("unroll") for (int _i = 0; _i < 2; ++_i) \
        __builtin_amdgcn_global_load_lds((const unsigned*)((const char*)(gbase) + (voff)[_i]), (PG8_LAS unsigned*)(lds + (bufoff) + ldsw + _i * 8192), 16, 0, 0); } while (0)
#define PG8_LDA(dst, b, h) do { _Pragma("unroll") for (int m = 0; m < 4; ++m) _Pragma("unroll") for (int k = 0; k < 2; ++k) dst[m][k] = *(const PG8_LAS bf16x8*)(lds + PG8_SA(b, h) + aoff + m * 2048 + k * 1024); } while (0)
#define PG8_LDB(dst, b, h) do { _Pragma("unroll") for (int n = 0; n < 2; ++n) _Pragma("unroll") for (int k = 0; k < 2; ++k) dst[n][k] = *(const PG8_LAS bf16x8*)(lds + PG8_SB(b, h) + boff + n * 2048 + k * 1024); } while (0)
#define PG8_MMA(ai, bj, At, Bt) do { __builtin_amdgcn_s_setprio(1); _Pragma("unroll") for (int m = 0; m < 4; ++m) _Pragma("unroll") for (int n = 0; n < 2; ++n) _Pragma("unroll") for (int k = 0; k < 2; ++k) \
        acc[ai][bj][m][n] = __builtin_amdgcn_mfma_f32_16x16x32_bf16(Bt[n][k], At[m][k], acc[ai][bj][m][n], 0, 0, 0); __builtin_amdgcn_s_setprio(0); } while (0)
#define PG8_WAIT_V(n) asm volatile("s_waitcnt vmcnt(" #n ")" ::: "memory")
#define PG8_WAIT_L(n) asm volatile("s_waitcnt lgkmcnt(" #n ")" ::: "memory")
#define PG8_BAR __builtin_amdgcn_s_barrier()
#define PG8_SCHED __builtin_amdgcn_sched_barrier(0)
    Unit cur, nxt; int ui = 0;
    if (!S.next(0, cur)) return;
    f32x4 acc[2][2][4][2];
#pragma unroll
    for (int a = 0; a < 2; ++a)
#pragma unroll
        for (int b = 0; b < 2; ++b)
#pragma unroll
            for (int m = 0; m < 4; ++m)
#pragma unroll
                for (int n = 0; n < 2; ++n) acc[a][b][m][n] = (f32x4){0.f, 0.f, 0.f, 0.f};
    bf16x8 At[4][2], B0[2][2], B1[2][2];
    const char* cA = (const char*)g.A + (size_t)cur.pm * tstep; const char* cB = (const char*)g.Bt + (size_t)cur.pn * tstep;
    S.a_ready(cur);
    if constexpr (SP2) {
        PG8_STAGE(PG8_SB(0, 0), cB, voffB); PG8_STAGE(PG8_SB(0, 1), cB + hstep, voffB); PG8_STAGE(PG8_SA(0, 0), cA, voffA); PG8_STAGE(PG8_SA(0, 1), cA + hstep, voffA);
        if (wr == 1) PG8_BAR;
        PG8_WAIT_V(2); PG8_BAR;
        PG8_STAGE(PG8_SB(1, 0), cB + kstep, voffB); PG8_STAGE(PG8_SA(1, 0), cA + kstep, voffA); PG8_STAGE(PG8_SB(1, 1), cB + hstep + kstep, voffB);
        PG8_WAIT_V(6); PG8_BAR;
    } else {
        PG8_STAGE(PG8_SB(0, 0), cB, voffB); PG8_STAGE(PG8_SA(0, 0), cA, voffA); PG8_STAGE(PG8_SB(0, 1), cB + hstep, voffB); PG8_STAGE(PG8_SA(0, 1), cA + hstep, voffA);
        if (wr == 1) PG8_BAR;
        PG8_WAIT_V(4); PG8_BAR;
        PG8_STAGE(PG8_SB(1, 0), cB + kstep, voffB); PG8_STAGE(PG8_SA(1, 0), cA + kstep, voffA); PG8_STAGE(PG8_SB(1, 1), cB + hstep + kstep, voffB);
        PG8_WAIT_V(6); PG8_BAR;
    }
    for (;;) {
        const bool has_next = S.next(ui + 1, nxt);
        const char* nA = has_next ? (const char*)g.A + (size_t)nxt.pm * tstep : cA; const char* nB = has_next ? (const char*)g.Bt + (size_t)nxt.pn * tstep : cB;
        for (int t = 0; t < nt; t += 2) {
            const bool last = (t == nt - 2);
            const char* a1 = cA + (size_t)(t + 1) * kstep;
            const char* a2 = last ? nA : cA + (size_t)(t + 2) * kstep; const char* b2 = last ? nB : cB + (size_t)(t + 2) * kstep;
            const char* a3 = a2 + kstep; const char* b3 = b2 + kstep;
            if (last && has_next) S.a_ready(nxt);
            if constexpr (SP2) {
            PG8_LDB(B0, 0, 0); PG8_LDB(B1, 0, 1); PG8_SCHED; PG8_LDA(At, 0, 0); PG8_STAGE(PG8_SA(1, 1), a1 + hstep, voffA);
            PG8_WAIT_V(8); PG8_WAIT_L(0); PG8_BAR; PG8_MMA(0, 0, At, B0); PG8_MMA(0, 1, At, B1); PG8_BAR; PG8_SCHED;
            PG8_LDA(At, 0, 1); PG8_STAGE(PG8_SB(0, 0), b2, voffB); PG8_STAGE(PG8_SB(0, 1), b2 + hstep, voffB); PG8_STAGE(PG8_SA(0, 0), a2, voffA);
            PG8_WAIT_V(8); PG8_WAIT_L(0); PG8_BAR; PG8_MMA(1, 0, At, B0); PG8_MMA(1, 1, At, B1); PG8_BAR; PG8_SCHED;
            PG8_LDB(B0, 1, 0); PG8_LDB(B1, 1, 1); PG8_SCHED; PG8_LDA(At, 1, 0); PG8_STAGE(PG8_SA(0, 1), a2 + hstep, voffA);
            PG8_WAIT_V(8); PG8_WAIT_L(0); PG8_BAR; PG8_MMA(0, 0, At, B0); PG8_MMA(0, 1, At, B1); PG8_BAR; PG8_SCHED;
            PG8_LDA(At, 1, 1); PG8_STAGE(PG8_SB(1, 0), b3, voffB); PG8_STAGE(PG8_SB(1, 1), b3 + hstep, voffB); PG8_STAGE(PG8_SA(1, 0), a3, voffA);
            PG8_WAIT_V(8); PG8_WAIT_L(0); PG8_BAR; PG8_MMA(1, 0, At, B0); PG8_MMA(1, 1, At, B1); PG8_BAR; PG8_SCHED;
            } else {
            PG8_LDB(B0, 0, 0); PG8_SCHED; PG8_LDA(At, 0, 0); PG8_STAGE(PG8_SA(1, 1), a1 + hstep, voffA);
            PG8_WAIT_L(8); PG8_BAR; PG8_WAIT_L(0); PG8_MMA(0, 0, At, B0); PG8_BAR; PG8_SCHED;
            PG8_LDB(B1, 0, 1); PG8_STAGE(PG8_SB(0, 0), b2, voffB);
            PG8_BAR; PG8_WAIT_L(0); PG8_MMA(0, 1, At, B1); PG8_BAR;
            PG8_LDA(At, 0, 1); PG8_STAGE(PG8_SA(0, 0), a2, voffA);
            PG8_BAR; PG8_WAIT_L(0); PG8_MMA(1, 0, At, B0); PG8_BAR; PG8_SCHED;
            PG8_STAGE(PG8_SB(0, 1), b2 + hstep, voffB);
            PG8_WAIT_V(6); PG8_BAR; PG8_MMA(1, 1, At, B1); PG8_BAR;
            PG8_LDB(B0, 1, 0); PG8_SCHED; PG8_LDA(At, 1, 0); PG8_STAGE(PG8_SA(0, 1), a2 + hstep, voffA);
            PG8_WAIT_L(8); PG8_BAR; PG8_WAIT_L(0); PG8_MMA(0, 0, At, B0); PG8_BAR; PG8_SCHED;
            PG8_LDB(B1, 1, 1); PG8_STAGE(PG8_SB(1, 0), b3, voffB);
            PG8_BAR; PG8_WAIT_L(0); PG8_MMA(0, 1, At, B1); PG8_BAR;
            PG8_LDA(At, 1, 1); PG8_STAGE(PG8_SA(1, 0), a3, voffA);
            PG8_BAR; PG8_WAIT_L(0); PG8_MMA(1, 0, At, B0); PG8_BAR; PG8_SCHED;
            PG8_STAGE(PG8_SB(1, 1), b3 + hstep, voffB);
            PG8_WAIT_V(6); PG8_BAR; PG8_MMA(1, 1, At, B1); PG8_BAR;
            }
        }
        if constexpr (ALIGN_EPI) { if (wr == 0) PG8_BAR; }
        if constexpr (!Epi::AFTER_DRAIN) { E(acc, cur, wr, wc, fr, fq); S.done(cur); }
        if (!has_next) break;
#pragma unroll
        for (int a = 0; a < 2; ++a)
#pragma unroll
            for (int b = 0; b < 2; ++b)
#pragma unroll
                for (int m = 0; m < 4; ++m)
#pragma unroll
                    for (int n = 0; n < 2; ++n) acc[a][b][m][n] = (f32x4){0.f, 0.f, 0.f, 0.f};
        cur = nxt; cA = nA; cB = nB; ++ui;
        if constexpr (ALIGN_EPI) { if (wr == 1) PG8_BAR; }
    }
    PG8_WAIT_V(0);
    if constexpr (!ALIGN_EPI) { if (wr == 0) PG8_BAR; }
    PG8_BAR;
    if constexpr (Epi::AFTER_DRAIN) { E.fused(acc, cur, wr, wc, fr, fq, lds, wid, lane); S.done(cur); }
#undef PG8_SA
#undef PG8_SB
#undef PG8_STAGE
#undef PG8_LDA
#undef PG8_LDB
#undef PG8_MMA
#undef PG8_WAIT_V
#undef PG8_WAIT_L
#undef PG8_BAR
#undef PG8_SCHED
}
}

#define GAS __attribute__((address_space(1)))
#define LAS __attribute__((address_space(3)))
typedef unsigned short bf16;
typedef unsigned v4u __attribute__((ext_vector_type(4)));
typedef unsigned v2u __attribute__((ext_vector_type(2)));
typedef float f32x4 __attribute__((ext_vector_type(4)));
typedef float f32x2 __attribute__((ext_vector_type(2)));
typedef float f32x16 __attribute__((ext_vector_type(16)));
typedef short bf16x8 __attribute__((ext_vector_type(8)));
#define LDS_WAIT() asm volatile("s_waitcnt lgkmcnt(0)" ::: "memory")
using pg8::cvt_pk_bf16; using pg8::pack8; using pg8::sigmoid_f; using pg8::silu_f; using pg8::gelu_tanh_f; using pg8::row_rs; using pg8::fast_exp2;

#ifndef PHM
#define PHM 255
#endif
#ifndef PROBE_DUPM
#define PROBE_DUPM 0
#endif
#ifndef MK_PER_PHASE
#define MK_PER_PHASE 0
#endif
constexpr int NWAVES = 8;
constexpr int BATCH = 16, SEQ = 2048, D = 1024, FF = 2816, TOK = BATCH * SEQ;
constexpr int NPH = 15;
constexpr size_t MiB = 1u << 20;
constexpr size_t WS_W13 = 1 * MiB;
constexpr size_t WS_W2 = 45 * MiB;
constexpr size_t WS_WIN = 67 * MiB;
constexpr size_t WS_WV = 72 * MiB;
constexpr size_t WS_WOUT = 73 * MiB;
constexpr size_t WS_WGLU = 75 * MiB;
constexpr size_t WS_WLRU = 79 * MiB;
constexpr size_t WS_ROPE = 80 * MiB;
constexpr size_t WS_SSP = 81 * MiB;
constexpr size_t WS_XB = 96 * MiB;
constexpr size_t WS_R1 = 160 * MiB;
constexpr size_t WS_Q = WS_R1, WS_K = WS_R1 + 32 * MiB, WS_VT = WS_R1 + 64 * MiB, WS_G = WS_R1 + 96 * MiB;
constexpr size_t WS_MRG = 352 * MiB;
constexpr size_t WS_END = 416 * MiB;
constexpr int LDS_BYTES = 135168;

__device__ __forceinline__ unsigned f2bf(float f) { unsigned u = __builtin_bit_cast(unsigned, f); return (u + 0x7fffu + ((u >> 16) & 1u)) >> 16; }
__device__ __forceinline__ unsigned pk2(float lo, float hi) { return f2bf(lo) | (f2bf(hi) << 16); }
__device__ __forceinline__ float bf_lo(unsigned w) { return __builtin_bit_cast(float, w << 16); }
__device__ __forceinline__ float bf_hi(unsigned w) { return __builtin_bit_cast(float, w & 0xffff0000u); }
__device__ __forceinline__ float bf1(bf16 h) { return __builtin_bit_cast(float, (unsigned)h << 16); }
__device__ __forceinline__ float wave_sum(float v) {
#pragma unroll
    for (int o = 1; o < 64; o <<= 1) v += __shfl_xor(v, o);
    return v;
}
__device__ __forceinline__ f32x4 mfma16(bf16x8 a, bf16x8 b, f32x4 c) { return __builtin_amdgcn_mfma_f32_16x16x32_bf16(a, b, c, 0, 0, 0); }

__device__ __forceinline__ void transpose_item(const float* __restrict__ W, int N, int K, const float* __restrict__ gk, bf16* WT, int dst_row, int k0, int n0, LAS float* scr, int lane) {
#pragma unroll 8
    for (int i = 0; i < 32; ++i) { const int kk = 2 * i + (lane >> 5); float v = W[(size_t)(k0 + kk) * N + n0 + (lane & 31)]; if (gk) v *= gk[k0 + kk]; scr[kk * 33 + (lane & 31)] = v; }
    LDS_WAIT(); asm volatile("" ::: "memory");
    const int c = lane & 7;
#pragma unroll
    for (int j = 0; j < 4; ++j) { const int n = (lane >> 3) + 8 * j; const LAS float* s = scr + (8 * c) * 33 + n;
        v4u o; o.x = pk2(s[0 * 33], s[1 * 33]); o.y = pk2(s[2 * 33], s[3 * 33]); o.z = pk2(s[4 * 33], s[5 * 33]); o.w = pk2(s[6 * 33], s[7 * 33]);
        *(v4u*)(WT + (size_t)(dst_row + n) * K + k0 + 8 * c) = o; }
    LDS_WAIT(); asm volatile("" ::: "memory");
}
struct Args { const float* in[27]; float* out; unsigned char* ws; int ph_lo, ph_hi; };
typedef const __attribute__((address_space(4))) Args* KArgP;

__device__ __forceinline__ void p0_prologue(KArgP ap, LAS unsigned char* lds, int gw, int NGW, int wave, int lane) {
    LAS float* scr = (LAS float*)(lds + wave * 16384);
    unsigned char* ws = ap->ws;
    constexpr int I_F = 1408, I_IN = 1536, I_OUT = 512, I_GL = 512, I_LRU = 64;
    constexpr int NITEMS = 12 * I_F + I_IN + I_OUT + 2 * I_GL + I_LRU;
    for (int it = gw; it < NITEMS; it += NGW) {
        int r = it;
        if (r < 8 * I_F) { const int w3 = r >= 4 * I_F; if (w3) r -= 4 * I_F; const int l = r / I_F; r -= l * I_F; const int kb = r / 88, nb = r % 88, n0 = 32 * nb;
            transpose_item(ap->in[w3 ? 3 : 2] + (size_t)l * D * FF, FF, D, ap->in[1] + l * D, (bf16*)(ws + WS_W13) + (size_t)l * 5632 * 1024, 256 * (n0 >> 7) + (n0 & 127) + (w3 ? 128 : 0), 64 * kb, n0, scr, lane); continue; }
        r -= 8 * I_F;
        if (r < 4 * I_F) { const int l = r / I_F; r -= l * I_F; const int kb = r / 32, nb = r % 32;
            transpose_item(ap->in[4] + (size_t)l * FF * D, D, FF, nullptr, (bf16*)(ws + WS_W2) + (size_t)l * 1024 * FF, 32 * nb, 64 * kb, 32 * nb, scr, lane); continue; }
        r -= 4 * I_F;
        if (r < I_IN) { const int kb = r / 96, nb = r % 96, n0 = 32 * nb; bf16* dst; int drow;
            if (n0 < 1024) { const int sec = n0 >> 9, nn = n0 & 511, h = nn >> 7, bj = (nn >> 6) & 1, jj0 = nn & 63; dst = (bf16*)(ws + WS_WIN); drow = 512 * sec + 256 * (h >> 1) + 128 * bj + 64 * (h & 1) + jj0; }
            else if (n0 < 1536) { dst = (bf16*)(ws + WS_WV); drow = n0 - 1024; }
            else { dst = (bf16*)(ws + WS_WIN); drow = n0 - 512; }
            transpose_item(ap->in[6], 3072, D, ap->in[5], dst, drow, 64 * kb, n0, scr, lane); continue; }
        r -= I_IN;
        if (r < I_OUT) { const int kb = r / 32, nb = r % 32; transpose_item(ap->in[7], D, D, nullptr, (bf16*)(ws + WS_WOUT), 32 * nb, 64 * kb, 32 * nb, scr, lane); continue; }
        r -= I_OUT;
        if (r < 2 * I_GL) { const int wb = r >= I_GL; if (wb) r -= I_GL; const int kb = r / 32, nb = r % 32, n0 = 32 * nb;
            transpose_item(ap->in[wb ? 25 : 24], D, D, nullptr, (bf16*)(ws + WS_WGLU), 256 * (n0 >> 7) + (n0 & 127) + (wb ? 128 : 0), 64 * kb, n0, scr, lane); continue; }
        r -= 2 * I_GL;
        { const int mat = r >> 3, g = mat >> 1, gate = mat & 1, kb = (r >> 2) & 1, nb = r & 3;
            transpose_item(ap->in[gate ? 13 : 11] + (size_t)g * 128 * 128, 128, 128, nullptr, (bf16*)(ws + WS_WLRU) + (size_t)mat * 128 * 128, 32 * nb, 64 * kb, 32 * nb, scr, lane); }
    }
    { float* rope = (float*)(ws + WS_ROPE);
      for (int i = gw * 64 + lane; i < 2048 * 64; i += NGW * 64) { const int pos = i >> 6, j = i & 63; const double inv = pow(10000.0, -(double)j / 64.0); const double ang = (double)pos * inv;
          rope[2 * i] = (float)cos(ang); rope[2 * i + 1] = (float)sin(ang); } }
    { const float* x = ap->in[0]; bf16* xb = (bf16*)(ws + WS_XB); float* ssp = (float*)(ws + WS_SSP);
      for (int m = gw; m < TOK; m += NGW) { const f32x4* xr = (const f32x4*)(x + (size_t)m * D) + lane; f32x4 v[4]; float s = 0.f;
#pragma unroll
          for (int j = 0; j < 4; ++j) { v[j] = xr[64 * j]; s += (v[j][0] * v[j][0] + v[j][1] * v[j][1]) + (v[j][2] * v[j][2] + v[j][3] * v[j][3]); }
          s = wave_sum(s);
          v2u* o8 = (v2u*)(xb + (size_t)m * D) + lane;
#pragma unroll
          for (int j = 0; j < 4; ++j) { v2u w; w.x = cvt_pk_bf16(v[j][0], v[j][1]); w.y = cvt_pk_bf16(v[j][2], v[j][3]); o8[64 * j] = w; }
          if (lane < 16) ssp[(size_t)m * 32 + lane] = lane == 0 ? s : 0.f; } }
}

__device__ __forceinline__ void ret_unit(int b, int h, int p, const bf16* Q, const bf16* Kb, const bf16* Vt, const bf16* G, const float* ret_g, bf16* MRG, LAS unsigned char* lds, int tid, int wid, int lane) {
    const int fr = lane & 15, fq = lane >> 4;
    const int cq = 2 * p + (wid >> 2), iloc0 = 32 * (wid & 3);
    const size_t tok0 = (size_t)b * SEQ + 256 * p + 32 * wid;
    const float lg = log2f(1.0f - exp2f(-5.0f - (float)h));
    bf16x8 qf[2][4];
#pragma unroll
    for (int mi = 0; mi < 2; ++mi)
#pragma unroll
        for (int kk = 0; kk < 4; ++kk) qf[mi][kk] = *(const bf16x8*)(Q + (tok0 + 16 * mi + fr) * 512 + h * 128 + 32 * kk + 8 * fq);
    f32x4 O[2][8];
#pragma unroll
    for (int mi = 0; mi < 2; ++mi)
#pragma unroll
        for (int e = 0; e < 8; ++e) O[mi][e] = (f32x4){0.f, 0.f, 0.f, 0.f};
    const int nm = 2 * p + 2;
    const int srow = 4 * wid + (lane >> 4), keyK = ((wid >> 1) & 3) * 4 + (lane >> 4), keyV = 4 * (wid & 3) + (lane >> 4);
    const bf16* kbase = Kb + ((size_t)b * SEQ + srow) * 512 + h * 128 + 8 * ((lane & 15) ^ keyK);
    const bf16* vbase = Vt + ((size_t)(h * 128 + srow)) * TOK + (size_t)b * SEQ + 8 * ((lane & 15) ^ keyV);
#define RET_STAGE(m_, buf_) do { _Pragma("unroll") for (int i = 0; i < 4; ++i) { \
        __builtin_amdgcn_global_load_lds((const unsigned*)(kbase + ((size_t)(128 * (m_) + 32 * i)) * 512), (LAS unsigned*)(lds + (buf_) * 65536 + (8 * i + wid) * 1024), 16, 0, 0); \
        __builtin_amdgcn_global_load_lds((const unsigned*)(vbase + (size_t)(32 * i) * TOK + 128 * (m_)), (LAS unsigned*)(lds + (buf_) * 65536 + 32768 + (8 * i + wid) * 1024), 16, 0, 0); } } while (0)
    RET_STAGE(0, 0);
    asm volatile("s_waitcnt vmcnt(0)" ::: "memory"); __syncthreads();
    for (int m = 0; m < nm; ++m) {
        const int buf = m & 1;
        if (m + 1 < nm) RET_STAGE(m + 1, buf ^ 1);
        if (m <= cq) {
            const LAS unsigned char* Kl = lds + buf * 65536; const LAS unsigned char* Vl = Kl + 32768;
            const float sc = fast_exp2(lg * (float)(128 * (cq - m)));
#pragma unroll
            for (int g32 = 0; g32 < 4; ++g32) {
                f32x4 S[2][2];
#pragma unroll
                for (int n = 0; n < 2; ++n) { S[0][n] = (f32x4){0.f, 0.f, 0.f, 0.f}; S[1][n] = (f32x4){0.f, 0.f, 0.f, 0.f};
                    const int krow = 32 * g32 + 8 * (fr >> 2) + 4 * n + (fr & 3);
#pragma unroll
                    for (int kk = 0; kk < 4; ++kk) { const bf16x8 kf = *(const LAS bf16x8*)(Kl + krow * 256 + (((4 * kk + fq) ^ fr) << 4));
                        S[0][n] = mfma16(kf, qf[0][kk], S[0][n]); S[1][n] = mfma16(kf, qf[1][kk], S[1][n]); } }
                bf16x8 pf[2];
#pragma unroll
                for (int mi = 0; mi < 2; ++mi) { f32x4 v0 = S[mi][0] * sc, v1 = S[mi][1] * sc;
                    if (m == cq) { const int il = iloc0 + 16 * mi + fr, jl = 32 * g32 + 8 * fq;
#pragma unroll
                        for (int t = 0; t < 4; ++t) { v0[t] = (jl + t <= il) ? v0[t] : 0.f; v1[t] = (jl + 4 + t <= il) ? v1[t] : 0.f; } }
                    const pg8::u32x4 w = pack8(v0, v1); pf[mi] = __builtin_bit_cast(bf16x8, w); }
#pragma unroll
                for (int ef = 0; ef < 8; ++ef) { const int vrow = 16 * ef + fr;
                    const bf16x8 vf = *(const LAS bf16x8*)(Vl + vrow * 256 + (((4 * g32 + fq) ^ fr) << 4));
                    O[0][ef] = mfma16(vf, pf[0], O[0][ef]); O[1][ef] = mfma16(vf, pf[1], O[1][ef]); }
            }
        }
        asm volatile("s_waitcnt vmcnt(0)" ::: "memory"); __syncthreads();
    }
#undef RET_STAGE
#pragma unroll
    for (int mi = 0; mi < 2; ++mi) { const size_t tok = tok0 + 16 * mi + fr; float s = 0.f;
#pragma unroll
        for (int ef = 0; ef < 8; ++ef) s += (O[mi][ef][0] + O[mi][ef][1]) + (O[mi][ef][2] + O[mi][ef][3]);
        s += __shfl_xor(s, 16); s += __shfl_xor(s, 32); const float mu = s * (1.0f / 128.0f); float q = 0.f;
#pragma unroll
        for (int ef = 0; ef < 8; ++ef) { const f32x4 d = O[mi][ef] - mu; q += (d[0] * d[0] + d[1] * d[1]) + (d[2] * d[2] + d[3] * d[3]); }
        q += __shfl_xor(q, 16); q += __shfl_xor(q, 32); const float rstd = 1.0f / sqrtf(q * (1.0f / 128.0f) + 1e-6f);
#pragma unroll
        for (int ef = 0; ef < 8; ++ef) { const int col = h * 128 + 16 * ef + 4 * fq; const f32x4 gn = *(const f32x4*)(ret_g + col); const v2u gr = *(const v2u*)(G + tok * 1536 + col);
            const float g0 = bf_lo(gr.x), g1 = bf_hi(gr.x), g2 = bf_lo(gr.y), g3 = bf_hi(gr.y);
            const float y0 = (O[mi][ef][0] - mu) * rstd * gn[0] * silu_f(g0), y1 = (O[mi][ef][1] - mu) * rstd * gn[1] * silu_f(g1);
            const float y2 = (O[mi][ef][2] - mu) * rstd * gn[2] * silu_f(g2), y3 = (O[mi][ef][3] - mu) * rstd * gn[3] * silu_f(g3);
            v2u w; w.x = cvt_pk_bf16(y0, y1); w.y = cvt_pk_bf16(y2, y3); *(v2u*)(MRG + tok * 1024 + col) = w; } }
}

__device__ __forceinline__ void lru_unit(int b, int g, int q, const bf16* G, const bf16* LW, const float* conv_w, const float* conv_b, const float* b_a, const float* b_i, const float* lam,
                                         bf16* MRG, LAS unsigned char* lds, int tid, int wid, int lane) {
    const int fr = lane & 15, fq = lane >> 4;
    const bf16* wbase = LW + ((size_t)(g * 2 * 128 + 32 * q + fr)) * 128 + 8 * fq;
    LAS float* A_ = (LAS float*)lds; LAS float* BX = A_ + 8192; LAS float* SEG = BX + 8192; LAS float* CAR = SEG + 1024;
    const bf16* xl = G + (size_t)b * SEQ * 1536 + 512 + 128 * g;
    for (int tile = 0; tile < 8; ++tile) {
        const int s0 = 256 * tile + 32 * wid;
        f32x4 acc[2][4];
#pragma unroll
        for (int mi = 0; mi < 2; ++mi)
#pragma unroll
            for (int nf = 0; nf < 4; ++nf) acc[mi][nf] = (f32x4){0.f, 0.f, 0.f, 0.f};
#pragma unroll 1
        for (int kk = 0; kk < 4; ++kk) { const int ch0 = 32 * kk + 8 * fq, cg0 = 128 * g + ch0;
            bf16x8 wf[4];
#pragma unroll
            for (int nf = 0; nf < 4; ++nf) wf[nf] = *(const bf16x8*)(wbase + (size_t)(((nf >> 1) * 128 + 16 * (nf & 1)) * 128 + 32 * kk));
#pragma unroll
            for (int mi = 0; mi < 2; ++mi) { const int s = s0 + 16 * mi + fr; float xc[8];
                { const f32x4 c0 = *(const f32x4*)(conv_b + cg0), c1 = *(const f32x4*)(conv_b + cg0 + 4); xc[0] = c0[0]; xc[1] = c0[1]; xc[2] = c0[2]; xc[3] = c0[3]; xc[4] = c1[0]; xc[5] = c1[1]; xc[6] = c1[2]; xc[7] = c1[3]; }
#pragma unroll
                for (int tap = 0; tap < 4; ++tap) { const int sp = s - 3 + tap; if (sp >= 0) { const v4u xv = *(const v4u*)(xl + (size_t)sp * 1536 + ch0);
                        const f32x4 w0 = *(const f32x4*)(conv_w + tap * 512 + cg0), w1 = *(const f32x4*)(conv_w + tap * 512 + cg0 + 4);
                        xc[0] += w0[0] * bf_lo(xv.x); xc[1] += w0[1] * bf_hi(xv.x); xc[2] += w0[2] * bf_lo(xv.y); xc[3] += w0[3] * bf_hi(xv.y);
                        xc[4] += w1[0] * bf_lo(xv.z); xc[5] += w1[1] * bf_hi(xv.z); xc[6] += w1[2] * bf_lo(xv.w); xc[7] += w1[3] * bf_hi(xv.w); } }
                pg8::u32x4 aw; aw.x = cvt_pk_bf16(xc[0], xc[1]); aw.y = cvt_pk_bf16(xc[2], xc[3]); aw.z = cvt_pk_bf16(xc[4], xc[5]); aw.w = cvt_pk_bf16(xc[6], xc[7]);
                const bf16x8 af = __builtin_bit_cast(bf16x8, aw);
#pragma unroll
                for (int nf = 0; nf < 4; ++nf) acc[mi][nf] = mfma16(wf[nf], af, acc[mi][nf]); } }
#pragma unroll
        for (int mi = 0; mi < 2; ++mi)
#pragma unroll
            for (int nfl = 0; nfl < 2; ++nfl) { const int cl = 32 * q + 16 * nfl + 4 * fq, cg0 = 128 * g + cl, s = s0 + 16 * mi + fr;
                f32x4 xc = *(const f32x4*)(conv_b + cg0);
#pragma unroll
                for (int tap = 0; tap < 4; ++tap) { const int sp = s - 3 + tap; if (sp >= 0) { const v2u xv = *(const v2u*)(xl + (size_t)sp * 1536 + cl); const f32x4 w0 = *(const f32x4*)(conv_w + tap * 512 + cg0);
                        xc[0] += w0[0] * bf_lo(xv.x); xc[1] += w0[1] * bf_hi(xv.x); xc[2] += w0[2] * bf_lo(xv.y); xc[3] += w0[3] * bf_hi(xv.y); } }
                const f32x4 ba = *(const f32x4*)(b_a + cg0), bi = *(const f32x4*)(b_i + cg0), lm = *(const f32x4*)(lam + cg0); f32x4 av, bv;
#pragma unroll
                for (int t = 0; t < 4; ++t) { const float r = sigmoid_f(acc[mi][nfl][t] + ba[t]), ig = sigmoid_f(acc[mi][nfl + 2][t] + bi[t]);
                    const float la = -8.0f * r * log1pf(__expf(-lm[t])); av[t] = __expf(la); bv[t] = sqrtf(-expm1f(2.0f * la)) * ig * xc[t]; }
                const int rt = 32 * wid + 16 * mi + fr;
                *(LAS f32x4*)(A_ + rt * 32 + 16 * nfl + 4 * fq) = av; *(LAS f32x4*)(BX + rt * 32 + 16 * nfl + 4 * fq) = bv; }
        __syncthreads();
        const int c = tid & 31, seg = tid >> 5;
        { float P = 1.f, hl = 0.f;
#pragma unroll
          for (int k = 0; k < 16; ++k) { const float av = A_[(16 * seg + k) * 32 + c], bv = BX[(16 * seg + k) * 32 + c]; hl = av * hl + bv; P *= av; }
          SEG[(seg * 32 + c) * 2] = P; SEG[(seg * 32 + c) * 2 + 1] = hl; }
        __syncthreads();
        float hin = tile == 0 ? 0.f : CAR[(tile & 1) * 32 + c];
        for (int s2 = 0; s2 < seg; ++s2) hin = SEG[(s2 * 32 + c) * 2] * hin + SEG[(s2 * 32 + c) * 2 + 1];
        const size_t tokb = (size_t)b * SEQ + 256 * tile + 16 * seg;
#pragma unroll
        for (int k = 0; k < 16; ++k) { const float av = A_[(16 * seg + k) * 32 + c], bv = BX[(16 * seg + k) * 32 + c]; hin = av * hin + bv;
            const float gl = bf1(G[(tokb + k) * 1536 + 1024 + 128 * g + 32 * q + c]);
            MRG[(tokb + k) * 1024 + 512 + 128 * g + 32 * q + c] = (bf16)f2bf(hin * gelu_tanh_f(gl)); }
        if (seg == 15) CAR[((tile + 1) & 1) * 32 + c] = hin;
        __syncthreads();
    }
}

constexpr int S5_WLDS = 27648;
__device__ __forceinline__ void s5_unit(int b, int g, KArgP ap, const float* x, const float* ssp, bf16* YS, LAS unsigned char* wl, int lane) {
    const float* lam_re = ap->in[16]; const float* lam_im = ap->in[17]; const float* log_dt = ap->in[18]; const float* b_re = ap->in[19]; const float* b_im = ap->in[20];
    const float* c_re = ap->in[21]; const float* c_im = ap->in[22]; const float* dsk = ap->in[23]; const float* gmix = ap->in[5] + D;
    LAS float* BU = (LAS float*)wl; LAS unsigned char* Hh = wl + 16384; LAS float* U = (LAS float*)(wl + 16384 + 8704);
    const float dt = __expf(log_dt[g]);
    float lr, li;
    { const float re = lam_re[g * 64 + lane], im = lam_im[g * 64 + lane], mag = __expf(re * dt); lr = mag * cosf(im * dt); li = mag * sinf(im * dt); }
    bf16x8 bfr[4];
#pragma unroll
    for (int q = 0; q < 4; ++q) { const int pp = 16 * q + ((lane & 31) >> 1), comp = lane & 1, hh = lane >> 5;
        const float re = lam_re[g * 64 + pp], im = lam_im[g * 64 + pp], mag = __expf(re * dt), lbr = mag * cosf(im * dt), lbi = mag * sinf(im * dt);
        const float den = re * re + im * im, nr = lbr - 1.0f, ni = lbi, fre = (nr * re + ni * im) / den, fim = (ni * re - nr * im) / den;
        const f32x4* pr = (const f32x4*)(b_re + ((size_t)(g * 64 + pp)) * 16 + 8 * hh); const f32x4* pi = (const f32x4*)(b_im + ((size_t)(g * 64 + pp)) * 16 + 8 * hh);
        const f32x4 r0 = pr[0], r1 = pr[1], i0 = pi[0], i1 = pi[1]; f32x4 o0, o1;
#pragma unroll
        for (int t = 0; t < 4; ++t) { o0[t] = comp ? (fre * i0[t] + fim * r0[t]) : (fre * r0[t] - fim * i0[t]); o1[t] = comp ? (fre * i1[t] + fim * r1[t]) : (fre * r1[t] - fim * i1[t]); }
        const pg8::u32x4 w = pack8(o0, o1); bfr[q] = __builtin_bit_cast(bf16x8, w); }
    bf16x8 cfr[4];
#pragma unroll
    for (int kk = 0; kk < 4; ++kk) { const int c = lane & 15, kq = lane >> 4, p0 = 16 * kk + 4 * kq;
        const f32x4 cr = *(const f32x4*)(c_re + ((size_t)(g * 16 + c)) * 64 + p0), ci = *(const f32x4*)(c_im + ((size_t)(g * 16 + c)) * 64 + p0);
        pg8::u32x4 w; w.x = cvt_pk_bf16(cr[0], -ci[0]); w.y = cvt_pk_bf16(cr[1], -ci[1]); w.z = cvt_pk_bf16(cr[2], -ci[2]); w.w = cvt_pk_bf16(cr[3], -ci[3]); cfr[kk] = __builtin_bit_cast(bf16x8, w); }
    const int tr = lane & 31, hh = lane >> 5;
    const f32x4 gm0 = *(const f32x4*)(gmix + 16 * g + 8 * hh), gm1 = *(const f32x4*)(gmix + 16 * g + 8 * hh + 4);
    const float dch = dsk[16 * g + (lane & 15)];
    float hre = 0.f, him = 0.f;
    const size_t tokb = (size_t)b * SEQ;
    f32x4 nx0, nx1; float nrs;
    { const size_t tok = tokb + tr; nx0 = *(const f32x4*)(x + tok * D + 16 * g + 8 * hh); nx1 = *(const f32x4*)(x + tok * D + 16 * g + 8 * hh + 4); nrs = row_rs(ssp, 16, (int)tok); }
    for (int blk = 0; blk < 64; ++blk) {
        f32x4 u0 = nx0 * nrs * gm0, u1 = nx1 * nrs * gm1;
        if (blk + 1 < 64) { const size_t tok = tokb + 32 * (blk + 1) + tr; nx0 = *(const f32x4*)(x + tok * D + 16 * g + 8 * hh); nx1 = *(const f32x4*)(x + tok * D + 16 * g + 8 * hh + 4); nrs = row_rs(ssp, 16, (int)tok); }
        *(LAS f32x4*)(U + tr * 16 + 8 * hh) = u0; *(LAS f32x4*)(U + tr * 16 + 8 * hh + 4) = u1;
        const pg8::u32x4 uw = pack8(u0, u1); const bf16x8 uf = __builtin_bit_cast(bf16x8, uw);
#pragma unroll
        for (int q = 0; q < 4; ++q) { f32x16 d;
#pragma unroll
            for (int r = 0; r < 16; ++r) d[r] = 0.f;
            d = __builtin_amdgcn_mfma_f32_32x32x16_bf16(uf, bfr[q], d, 0, 0, 0);
#pragma unroll
            for (int r = 0; r < 16; ++r) BU[((r & 3) + 8 * (r >> 2) + 4 * hh) * 128 + 32 * q + tr] = d[r]; }
        LDS_WAIT(); asm volatile("" ::: "memory");
#pragma unroll
        for (int t = 0; t < 32; ++t) { const f32x2 bu = *(const LAS f32x2*)(BU + t * 128 + 2 * lane);
            const float nr = lr * hre - li * him + bu[0], ni = lr * him + li * hre + bu[1]; hre = nr; him = ni;
            *(LAS unsigned*)(Hh + t * 272 + 4 * lane) = cvt_pk_bf16(nr, ni); }
        LDS_WAIT(); asm volatile("" ::: "memory");
        const int c = lane & 15, kq = lane >> 4;
#pragma unroll
        for (int tf = 0; tf < 2; ++tf) { f32x4 y = (f32x4){0.f, 0.f, 0.f, 0.f};
#pragma unroll
            for (int kk = 0; kk < 4; ++kk) { const bf16x8 hf = *(const LAS bf16x8*)(Hh + (16 * tf + c) * 272 + (32 * kk + 8 * kq) * 2); y = mfma16(hf, cfr[kk], y); }
#pragma unroll
            for (int r = 0; r < 4; ++r) { const int t = 16 * tf + 4 * kq + r; const float uu = U[t * 16 + c]; const float yv = y[r] + dch * uu;
                YS[(tokb + 32 * blk + t) * 1024 + 16 * g + c] = (bf16)f2bf(gelu_tanh_f(yv)); } }
        LDS_WAIT(); asm volatile("" ::: "memory");
    }
}

#define XB_TMO      128
#define XB_XCNT(j)  (256  + 64 * (j))
#define XB_XSUB(j)  (1280 + 64 * (j))
#define XB_XGEN(j)  (2304 + 64 * (j))
#define XB_TOP      3328
#define XB_TOPGEN   3392
#define XCD_BAR_WORDS 3456
#define XB_SPIN_CAP (1u << 18)

__device__ __forceinline__ unsigned xb_ld(unsigned* p)              { return __hip_atomic_load(p, __ATOMIC_RELAXED, __HIP_MEMORY_SCOPE_AGENT); }
__device__ __forceinline__ unsigned xb_add(unsigned* p, unsigned v) { return __hip_atomic_fetch_add(p, v, __ATOMIC_RELAXED, __HIP_MEMORY_SCOPE_AGENT); }
__device__ __forceinline__ unsigned xb_xcc_id() { return (unsigned)__builtin_amdgcn_s_getreg((3 << 11) | 20) & 0xFu; }
#define XB_SPIN(cond, bar) do { unsigned _sp = 0; while (cond) { __builtin_amdgcn_s_sleep(1); \
    if ((++_sp & 255u) == 0u) { if (xb_ld(&(bar)[XB_TMO])) break; if (_sp > XB_SPIN_CAP) { atomicAdd(&(bar)[XB_TMO], 1u); break; } } } } while (0)

struct XcdBarrier {
    unsigned* bar; unsigned x;
    volatile LAS unsigned* st;
};

__device__ __forceinline__ XcdBarrier xcd_barrier_post(unsigned* bar, volatile LAS unsigned* st, int tid) {
    XcdBarrier b; b.bar = bar; b.x = xb_xcc_id(); b.st = st;
    if (tid == 0) (void)xb_add(&bar[XB_XCNT(b.x)], 1u);
    return b;
}
__device__ __forceinline__ void xcd_barrier_complete(unsigned* bar, unsigned x, unsigned& nloc, unsigned& nx) {
    const unsigned G = gridDim.x * gridDim.y * gridDim.z;
    unsigned sum, cnt, mine, sp = 0u;
    for (;;) {
        sum = 0u; cnt = 0u; mine = 0u;
#pragma unroll
        for (unsigned j = 0; j < 16; ++j) { const unsigned c = xb_ld(&bar[XB_XCNT(j)]); sum += c; cnt += (c > 0u) ? 1u : 0u; mine = (j == x) ? c : mine; }
        if (sum == G) break;
        __builtin_amdgcn_s_sleep(1);
        if ((++sp & 255u) == 0u) { if (xb_ld(&bar[XB_TMO])) break; if (sp > XB_SPIN_CAP) { atomicAdd(&bar[XB_TMO], 1u); break; } }
    }
    nloc = mine > 0u ? mine : 1u; nx = cnt > 0u ? cnt : 1u;
}

__device__ __forceinline__ void xcd_barrier(const XcdBarrier& b, int tid) {
    asm volatile("s_waitcnt vmcnt(0)" ::: "memory");
    __syncthreads();
    if (tid == 0) {
        unsigned* bar = b.bar;
        __builtin_amdgcn_s_waitcnt(0);
        unsigned nloc = b.st[0], nx = b.st[1];
        if (nloc == 0u) { xcd_barrier_complete(bar, b.x, nloc, nx); b.st[0] = nloc; b.st[1] = nx; }
        const unsigned old = xb_add(&bar[XB_XSUB(b.x)], 1u);
        const unsigned gen = old / nloc;
        if (old + 1u == (gen + 1u) * nloc) {
            __builtin_amdgcn_fence(__ATOMIC_RELEASE, "agent");
            asm volatile("s_waitcnt vmcnt(0)" ::: "memory");
            const unsigned og = xb_add(&bar[XB_TOP], 1u);
            const unsigned tg = og / nx;
            if (og + 1u == (tg + 1u) * nx) xb_add(&bar[XB_TOPGEN], 1u);
            else XB_SPIN(xb_ld(&bar[XB_TOPGEN]) == tg, bar);
            __builtin_amdgcn_fence(__ATOMIC_ACQUIRE, "agent");
            xb_add(&bar[XB_XGEN(b.x)], 1u);
            asm volatile("s_waitcnt vmcnt(0)" ::: "memory");
        } else {
            XB_SPIN(xb_ld(&bar[XB_XGEN(b.x)]) == gen, bar);
            __builtin_amdgcn_fence(__ATOMIC_ACQUIRE, "agent");
            asm volatile("s_waitcnt vmcnt(0)" ::: "memory");
        }
    }
    __syncthreads();
}

__device__ __forceinline__ int lane_id() { return (int)__builtin_amdgcn_mbcnt_hi(~0u, __builtin_amdgcn_mbcnt_lo(~0u, 0u)); }
template <int ph> __device__ __forceinline__ void phase_body(LAS unsigned char* lds, int wave) {
    int lane_ = lane_id(); asm volatile("" : "+v"(lane_));
    const int lane = lane_, tid = wave * 64 + lane;
    const int G_ = gridDim.x, bx = blockIdx.x;
    const int gw = bx * NWAVES + wave, NGW = G_ * NWAVES;
    KArgP ap = (KArgP)__builtin_amdgcn_kernarg_segment_ptr(); asm volatile("" : "+s"(ap));
    unsigned char* ws = ap->ws;
    float* X = ap->out;
    bf16* XB = (bf16*)(ws + WS_XB); float* SSP = (float*)(ws + WS_SSP); bf16* HID = (bf16*)(ws + WS_R1); bf16* MRG = (bf16*)(ws + WS_MRG);
    (void)gw; (void)NGW; (void)lane; (void)X; (void)XB; (void)SSP; (void)HID; (void)MRG;
        if constexpr (ph == 0 && (PHM & 1)) { p0_prologue(ap, lds, gw, NGW, wave, lane); }
        else if constexpr ((PHM & 2) && (ph == 1 || ph == 6 || ph == 8 || ph == 12)) {
            const int l = ph == 1 ? 0 : ph == 6 ? 1 : ph == 8 ? 2 : 3;
            pg8::Gemm g{XB, (const bf16*)(ws + WS_W13) + (size_t)l * 5632 * 1024, TOK, 5632, D}; pg8::StaticOrder S; S.init(TOK, 5632, G_, bx);
            pg8::EpiSwiglu E{HID, FF, SSP, ph == 12 ? 32 : 16};
            pg8::gemm_phase<pg8::EpiSwiglu, pg8::StaticOrder, true, true>(lds, g, S, E, tid);
        }
        else if constexpr ((PHM & 4) && (ph == 2 || ph == 7 || ph == 9 || ph == 13 || ph == 5)) {
            const int l = ph == 2 ? 0 : ph == 7 ? 1 : ph == 9 ? 2 : 3;
            pg8::Gemm g; g.M = TOK; g.N = D;
            if (ph == 5) { g.A = MRG; g.Bt = (const bf16*)(ws + WS_WOUT); g.K = D; } else { g.A = HID; g.Bt = (const bf16*)(ws + WS_W2) + (size_t)l * 1024 * FF; g.K = FF; }
            pg8::StaticOrder S; S.init(TOK, D, G_, bx);
            pg8::EpiResid E{ph == 2 ? ap->in[0] : X, X, XB, SSP, ph == 5 ? 1.0f : 0.5f};
            pg8::gemm_phase<pg8::EpiResid, pg8::StaticOrder, true, true>(lds, g, S, E, tid);
        }
        else if constexpr ((PHM & 8) && ph == 3) {
            { pg8::Gemm g{XB, (const bf16*)(ws + WS_WIN), TOK, 1024, D}; pg8::StaticOrder S; S.init(TOK, 1024, G_, bx);
              pg8::EpiRope E{(bf16*)(ws + WS_Q), (bf16*)(ws + WS_K), (const float*)(ws + WS_ROPE), SSP, 16};
              pg8::gemm_phase<pg8::EpiRope, pg8::StaticOrder, true, true>(lds, g, S, E, tid); }
            { pg8::Gemm g{XB, (const bf16*)(ws + WS_WIN) + (size_t)1024 * 1024, TOK, 1536, D}; pg8::StaticOrder S; S.init(TOK, 1536, G_, bx);
              pg8::EpiScaled E{(bf16*)(ws + WS_G), 1536, SSP, 16};
              pg8::gemm_phase<pg8::EpiScaled, pg8::StaticOrder, true, true>(lds, g, S, E, tid); }
            { pg8::Gemm g{(const bf16*)(ws + WS_WV), XB, 512, TOK, D}; pg8::StaticOrder S; S.init(512, TOK, G_, bx);
              pg8::EpiPlain E{(bf16*)(ws + WS_VT), TOK};
              pg8::gemm_phase<pg8::EpiPlain, pg8::StaticOrder, true, true>(lds, g, S, E, tid); }
        }
        else if constexpr ((PHM & 16) && ph == 4) {
#ifndef NO_RET
            for (int i = 0; i < 2; ++i) { const int bh = bx >> 2, pp = bx & 3, p = i == 0 ? pp : 7 - pp;
                ret_unit(bh >> 2, bh & 3, p, (const bf16*)(ws + WS_Q), (const bf16*)(ws + WS_K), (const bf16*)(ws + WS_VT), (const bf16*)(ws + WS_G), ap->in[8], MRG, lds, tid, wave, lane); }
#endif
#ifndef NO_LRU
            lru_unit(bx >> 4, (bx >> 2) & 3, bx & 3, (const bf16*)(ws + WS_G), (const bf16*)(ws + WS_WLRU), ap->in[9], ap->in[10], ap->in[12], ap->in[14], ap->in[15], MRG, lds, tid, wave, lane);
#endif
        }
        else if constexpr ((PHM & 32) && ph == 10) {
            if (wave < 4) { const int unit = bx * 4 + wave; s5_unit(unit >> 6, unit & 63, ap, X, SSP, MRG, lds + wave * S5_WLDS, lane); }
        }
        else if constexpr ((PHM & 64) && ph == 11) {
            pg8::Gemm g{MRG, (const bf16*)(ws + WS_WGLU), TOK, 2048, D}; pg8::StaticOrder S; S.init(TOK, 2048, G_, bx);
            pg8::EpiGluResid E{X, X, XB, SSP};
            pg8::gemm_phase<pg8::EpiGluResid, pg8::StaticOrder, true, true>(lds, g, S, E, tid);
        }
        else if constexpr ((PHM & 128) && ph == 14) {
            const float* gf = ap->in[26];
            for (int m = gw; m < TOK; m += NGW) { const float rs = row_rs(SSP, 16, m); f32x4* xr = (f32x4*)(X + (size_t)m * D) + lane; const f32x4* gr = (const f32x4*)gf + lane;
#pragma unroll
                for (int j = 0; j < 4; ++j) xr[64 * j] = xr[64 * j] * rs * gr[64 * j]; }
        }
}
__global__ void __launch_bounds__(NWAVES * 64, 2) mega_fwd(Args a_) {
    extern __shared__ __attribute__((aligned(16))) unsigned char lds_raw[];
    LAS unsigned char* lds = (LAS unsigned char*)lds_raw;
    cg::grid_group grid = cg::this_grid();
    const int ph_lo = a_.ph_lo, ph_hi = a_.ph_hi;
    const int wave = __builtin_amdgcn_readfirstlane((int)(threadIdx.x >> 6));
    volatile LAS unsigned* bst = (volatile LAS unsigned*)(lds + 131072 + 4000);
    { const int t0 = wave * 64 + lane_id(); if (t0 < 2) bst[t0] = 0u; }
    __syncthreads();
    XcdBarrier bar = xcd_barrier_post((unsigned*)a_.ws, bst, wave * 64 + lane_id());
    if (ph_hi - ph_lo > 1) grid.sync();
#define SEAM(k) xcd_barrier(bar, wave * 64 + lane_id())
#define PHASE(k) if (ph_lo <= (k) && (k) < ph_hi) { if ((PROBE_DUPM >> (k)) & 1) { phase_body<k>(lds, wave); xcd_barrier(bar, wave * 64 + lane_id()); } phase_body<k>(lds, wave); if ((k) + 1 < ph_hi) SEAM(k); }
    PHASE(0) PHASE(1) PHASE(2) PHASE(3) PHASE(4) PHASE(5) PHASE(6) PHASE(7) PHASE(8) PHASE(9) PHASE(10) PHASE(11) PHASE(12) PHASE(13) PHASE(14)
#undef PHASE
#undef SEAM
}

extern "C" void kernel_launch(void* const* d_in, const int* in_sizes, int n_in, void* d_out, int out_size, void* d_ws, size_t ws_size, hipStream_t stream) {
    static int grid = 0;
    if (grid == 0) {
        if (n_in != 27 || in_sizes[0] != TOK * D || out_size != TOK * D || ws_size < WS_END) { fprintf(stderr, "kernel_launch: unexpected shapes (n_in %d, in0 %d, out %d, ws %zu)\n", n_in, n_in > 0 ? in_sizes[0] : -1, out_size, ws_size); grid = -1; return; }
        int dev = 0, cus = 0, per_cu = 0;
        (void)hipGetDevice(&dev); (void)hipDeviceGetAttribute(&cus, hipDeviceAttributeMultiprocessorCount, dev);
        if (hipFuncSetAttribute((const void*)mega_fwd, hipFuncAttributeMaxDynamicSharedMemorySize, LDS_BYTES) != hipSuccess) { fprintf(stderr, "kernel_launch: hipFuncSetAttribute failed\n"); grid = -1; return; }
        if (hipOccupancyMaxActiveBlocksPerMultiprocessor(&per_cu, (const void*)mega_fwd, NWAVES * 64, LDS_BYTES) != hipSuccess || per_cu < 1) { fprintf(stderr, "kernel_launch: occupancy query says %d blocks per CU\n", per_cu); per_cu = 1; }
        (void)hipGetLastError();
        grid = cus * 1;
    }
    if (grid < 0) return;
    (void)hipMemsetAsync(d_ws, 0, 16384, stream);
    Args a{};
    for (int i = 0; i < 27; ++i) a.in[i] = (const float*)d_in[i];
    a.out = (float*)d_out; a.ws = (unsigned char*)d_ws;
#if MK_PER_PHASE
    for (int ph = 0; ph < NPH; ++ph) { a.ph_lo = ph; a.ph_hi = ph + 1; hipLaunchKernelGGL(mega_fwd, dim3(grid), dim3(NWAVES * 64), LDS_BYTES, stream, a); }
#else
    a.ph_lo = 0; a.ph_hi = NPH;
    void* params[] = {&a};
    const hipError_t e = hipLaunchCooperativeKernel((const void*)mega_fwd, dim3(grid), dim3(NWAVES * 64), params, LDS_BYTES, stream);
    if (e != hipSuccess) fprintf(stderr, "kernel_launch: cooperative launch failed: %s (grid %d)\n", hipGetErrorString(e), grid);
#endif
}
```

```cpp
#include <hip/hip_runtime.h>
#include <hip/hip_cooperative_groups.h>
#include <cstdio>
#include <cstdint>
#include <cmath>
namespace cg = cooperative_groups;
namespace pg8 {
#define PG8_LAS __attribute__((address_space(3)))
typedef unsigned short bf16_t;
typedef short bf16x8 __attribute__((ext_vector_type(8)));
typedef float f32x4 __attribute__((ext_vector_type(4)));
typedef unsigned u32x4 __attribute__((ext_vector_type(4)));
constexpr int BM = 256, BK = 64, HALF = 128, HTB = HALF * BK * 2  , STAGE_BYTES = 8 * HTB, NXCD = 8, WGM = 8;

__host__ __device__ __forceinline__ int lds_byte(int r, int c) { const int st = (r >> 4) * 2 + (c >> 5), rr = r & 15, cc = c & 31, ob = rr * 64 + cc * 2; return st * 1024 + (ob ^ (((ob >> 9) & 1) << 5)); }
__host__ __device__ __forceinline__ void stage_rc(int b, int& R, int& C) { const int st = b / 1024, sb = b % 1024, swz = sb ^ (((sb >> 9) & 1) << 5); R = (st >> 1) * 16 + swz / 64; C = (st & 1) * 32 + (swz % 64) / 2; }
__host__ __device__ __forceinline__ int perm32(int rho) { const int n = rho >> 4, i = rho & 15; return 8 * (i >> 2) + 4 * n + (i & 3); }

struct Unit { int pm, pn; };
struct Gemm { const bf16_t* A; const bf16_t* Bt; int M, N, K; };

struct StaticOrder {
    int nM, nN, nwg, G, c;
    __host__ __device__ void init(int M, int N, int G_, int c_) { nM = M / BM; nN = N / BM; nwg = nM * nN; G = G_; c = c_; }
    __host__ __device__ bool next(int i, Unit& u) const {
        const long L = (long)i * G + c; if (L >= nwg) return false;
        int wgid = (int)L; { const int q = nwg / NXCD, r = nwg % NXCD, xcd = wgid % NXCD, off = wgid / NXCD; wgid = (xcd < r ? xcd * (q + 1) : r * (q + 1) + (xcd - r) * q) + off; }
        const int nig = WGM * nN, gid = wgid / nig, fm = gid * WGM, gsz = (nM - fm) < WGM ? (nM - fm) : WGM;
        u.pm = fm + ((wgid % nig) % gsz); u.pn = (wgid % nig) / gsz; return true;
    }
    __device__ __forceinline__ void a_ready(const Unit&) const {}
    __device__ __forceinline__ void done(const Unit&) const {}
};

__device__ __forceinline__ unsigned cvt_pk_bf16(float lo, float hi) { unsigned r; asm volatile("v_cvt_pk_bf16_f32 %0, %1, %2" : "=v"(r) : "v"(lo), "v"(hi)); return r; }
__device__ __forceinline__ u32x4 pack8(const f32x4 a, const f32x4 b) { u32x4 w; w.x = cvt_pk_bf16(a[0], a[1]); w.y = cvt_pk_bf16(a[2], a[3]); w.z = cvt_pk_bf16(b[0], b[1]); w.w = cvt_pk_bf16(b[2], b[3]); return w; }
__device__ __forceinline__ float fast_rcp(float x) { return __builtin_amdgcn_rcpf(x); }
__device__ __forceinline__ float fast_exp2(float x) { return __builtin_amdgcn_exp2f(x); }
__device__ __forceinline__ float sigmoid_f(float x) { return fast_rcp(1.0f + fast_exp2(-1.4426950409f * x)); }
__device__ __forceinline__ float silu_f(float x) { return x * sigmoid_f(x); }
__device__ __forceinline__ float gelu_tanh_f(float v) { const float u = v + 0.044715f * v * v * v; return v * sigmoid_f(1.5957691216f * u); }
__device__ __forceinline__ float row_rs(const float* ssp, int nparts, int row) {
    const f32x4* p = (const f32x4*)(ssp + (size_t)row * 32); float s = 0.f;
#pragma unroll
    for (int i = 0; i < 4; ++i) { const f32x4 v = p[i]; s += (v[0] + v[1]) + (v[2] + v[3]); }
    if (nparts > 16) {
#pragma unroll
        for (int i = 4; i < 8; ++i) { const f32x4 v = p[i]; s += (v[0] + v[1]) + (v[2] + v[3]); } }
    return 1.0f / sqrtf(s * (1.0f / 1024.0f) + 1e-6f);
}
__device__ __forceinline__ void row_rs8(float (&rs)[8], const float* ssp, int nparts, int row0) {
#pragma unroll
    for (int h = 0; h < 2; ++h) {
#pragma unroll
        for (int i = 0; i < 4; ++i) rs[4 * h + i] = row_rs(ssp, nparts, row0 + h * HALF + i * 16);
        asm volatile("" : "+v"(rs[4 * h]), "+v"(rs[4 * h + 1]), "+v"(rs[4 * h + 2]), "+v"(rs[4 * h + 3]) :: "memory"); }
}

struct EpiSwiglu {
    static constexpr bool PERM = true, AFTER_DRAIN = false;
    bf16_t* O; int ldo; const float* ssp; int nparts;
    __device__ __forceinline__ void operator()(const f32x4 (&acc)[2][2][4][2], const Unit& u, int wr, int wc, int fr, int fq) const {
        const int row0 = u.pm * BM + wr * 64 + fr, col0 = u.pn * 128 + wc * 32 + 8 * fq;
        float rs8[8]; row_rs8(rs8, ssp, nparts, row0);
#pragma unroll
        for (int ai = 0; ai < 2; ++ai)
#pragma unroll
            for (int m = 0; m < 4; ++m) { const int row = row0 + ai * HALF + m * 16; const float rs = rs8[ai * 4 + m];
                f32x4 h[2];
#pragma unroll
                for (int n = 0; n < 2; ++n)
#pragma unroll
                    for (int t = 0; t < 4; ++t) { const float a = acc[ai][0][m][n][t] * rs, b = acc[ai][1][m][n][t] * rs; h[n][t] = silu_f(a) * b; }
                *(u32x4*)(O + (size_t)row * ldo + col0) = pack8(h[0], h[1]); }
    }
};
struct EpiResid {
    static constexpr bool PERM = true, AFTER_DRAIN = false;
    const float* xin; float* xout; bf16_t* xb; float* ssp; float alpha;
    __device__ __forceinline__ void operator()(const f32x4 (&acc)[2][2][4][2], const Unit& u, int wr, int wc, int fr, int fq) const {
        const int row0 = u.pm * BM + wr * 64 + fr, col0 = u.pn * BM + wc * 32 + 8 * fq;
#pragma unroll
        for (int ai = 0; ai < 2; ++ai)
#pragma unroll
            for (int m = 0; m < 4; ++m) { const int row = row0 + ai * HALF + m * 16; float ss = 0.f;
#pragma unroll
                for (int bj = 0; bj < 2; ++bj) { const size_t off = (size_t)row * 1024 + col0 + bj * HALF;
                    const f32x4 o0 = *(const f32x4*)(xin + off), o1 = *(const f32x4*)(xin + off + 4);
                    const f32x4 v0 = o0 + alpha * acc[ai][bj][m][0], v1 = o1 + alpha * acc[ai][bj][m][1];
                    *(f32x4*)(xout + off) = v0; *(f32x4*)(xout + off + 4) = v1; *(u32x4*)(xb + off) = pack8(v0, v1);
                    ss += (v0[0] * v0[0] + v0[1] * v0[1]) + (v0[2] * v0[2] + v0[3] * v0[3]) + (v1[0] * v1[0] + v1[1] * v1[1]) + (v1[2] * v1[2] + v1[3] * v1[3]); }
                ss += __shfl_xor(ss, 16); ss += __shfl_xor(ss, 32);
                if (fq == 0) ssp[(size_t)row * 32 + 4 * u.pn + wc] = ss; if (m == 3) asm volatile("" ::: "memory"); }
    }
};
struct EpiGluResid {
    static constexpr bool PERM = true, AFTER_DRAIN = false;
    const float* xin; float* xout; bf16_t* xb; float* ssp;
    __device__ __forceinline__ void operator()(const f32x4 (&acc)[2][2][4][2], const Unit& u, int wr, int wc, int fr, int fq) const {
        const int row0 = u.pm * BM + wr * 64 + fr, col0 = u.pn * 128 + wc * 32 + 8 * fq;
#pragma unroll
        for (int ai = 0; ai < 2; ++ai)
#pragma unroll
            for (int m = 0; m < 4; ++m) { const int row = row0 + ai * HALF + m * 16; const size_t off = (size_t)row * 1024 + col0;
                const f32x4 o0 = *(const f32x4*)(xin + off), o1 = *(const f32x4*)(xin + off + 4); f32x4 v0, v1;
#pragma unroll
                for (int t = 0; t < 4; ++t) { v0[t] = o0[t] + acc[ai][0][m][0][t] * sigmoid_f(acc[ai][1][m][0][t]); v1[t] = o1[t] + acc[ai][0][m][1][t] * sigmoid_f(acc[ai][1][m][1][t]); }
                *(f32x4*)(xout + off) = v0; *(f32x4*)(xout + off + 4) = v1; *(u32x4*)(xb + off) = pack8(v0, v1);
                float ss = (v0[0] * v0[0] + v0[1] * v0[1]) + (v0[2] * v0[2] + v0[3] * v0[3]) + (v1[0] * v1[0] + v1[1] * v1[1]) + (v1[2] * v1[2] + v1[3] * v1[3]);
                ss += __shfl_xor(ss, 16); ss += __shfl_xor(ss, 32);
                if (fq == 0) ssp[(size_t)row * 32 + 4 * u.pn + wc] = ss; if (m == 3) asm volatile("" ::: "memory"); }
    }
};
struct EpiPlain {
    static constexpr bool PERM = true, AFTER_DRAIN = false;
    bf16_t* O; int ldo;
    __device__ __forceinline__ void operator()(const f32x4 (&acc)[2][2][4][2], const Unit& u, int wr, int wc, int fr, int fq) const {
        const int row0 = u.pm * BM + wr * 64 + fr, col0 = u.pn * BM + wc * 32 + 8 * fq;
#pragma unroll
        for (int ai = 0; ai < 2; ++ai)
#pragma unroll
            for (int m = 0; m < 4; ++m) { bf16_t* rowp = O + (size_t)(row0 + ai * HALF + m * 16) * ldo + col0;
#pragma unroll
                for (int bj = 0; bj < 2; ++bj) *(u32x4*)(rowp + bj * HALF) = pack8(acc[ai][bj][m][0], acc[ai][bj][m][1]); }
    }
};
__device__ __forceinline__ float lg_gamma(int h) { return h == 0 ? -0.04580368961312479f : h == 1 ? -0.02272007650008353f : h == 2 ? -0.011315313227834146f : -0.005646563141142063f; }
struct EpiRope {
    static constexpr bool PERM = true, AFTER_DRAIN = false;
    bf16_t* Q; bf16_t* K; const float* rope; const float* ssp; int nparts;
    __device__ __forceinline__ void operator()(const f32x4 (&acc)[2][2][4][2], const Unit& u, int wr, int wc, int fr, int fq) const {
        typedef unsigned u32x2 __attribute__((ext_vector_type(2)));
        const int row0 = u.pm * BM + wr * 64 + fr;
        const int head = 2 * (u.pn & 1) + (wc >> 1), jj0 = (wc & 1) * 32 + 8 * fq; bf16_t* dst = (u.pn < 2) ? Q : K;
        const float lg = lg_gamma(head);
        float rs8[8]; row_rs8(rs8, ssp, nparts, row0);
#pragma unroll
        for (int ai = 0; ai < 2; ++ai)
#pragma unroll
            for (int m = 0; m < 4; ++m) { const int row = row0 + ai * HALF + m * 16, pos = row & 2047; const float rs = rs8[4 * ai + m];
                const float sc = (u.pn < 2) ? rs * fast_exp2(lg * (float)(pos & 127)) : rs * rs * 0.08838834764831845f * fast_exp2(-lg * (float)(pos & 127));
                const f32x4* rp = (const f32x4*)(rope + ((size_t)pos * 64 + jj0) * 2);
                bf16_t* rowp = dst + (size_t)row * 512 + head * 128 + jj0;
#pragma unroll
                for (int n = 0; n < 2; ++n) { const f32x4 cs0 = rp[2 * n], cs1 = rp[2 * n + 1]; const f32x4 x1 = acc[ai][0][m][n] * sc, x2 = acc[ai][1][m][n] * sc; f32x4 o1, o2;
                    o1[0] = x1[0] * cs0[0] - x2[0] * cs0[1]; o2[0] = x1[0] * cs0[1] + x2[0] * cs0[0];
                    o1[1] = x1[1] * cs0[2] - x2[1] * cs0[3]; o2[1] = x1[1] * cs0[3] + x2[1] * cs0[2];
                    o1[2] = x1[2] * cs1[0] - x2[2] * cs1[1]; o2[2] = x1[2] * cs1[1] + x2[2] * cs1[0];
                    o1[3] = x1[3] * cs1[2] - x2[3] * cs1[3]; o2[3] = x1[3] * cs1[3] + x2[3] * cs1[2];
                    u32x2 w1, w2; w1.x = cvt_pk_bf16(o1[0], o1[1]); w1.y = cvt_pk_bf16(o1[2], o1[3]); w2.x = cvt_pk_bf16(o2[0], o2[1]); w2.y = cvt_pk_bf16(o2[2], o2[3]);
                    *(u32x2*)(rowp + 4 * n) = w1; *(u32x2*)(rowp + 64 + 4 * n) = w2; } if (m & 1) asm volatile("" ::: "memory"); }
    }
};
struct EpiScaled {
    static constexpr bool PERM = true, AFTER_DRAIN = false;
    bf16_t* O; int ldo; const float* ssp; int nparts;
    __device__ __forceinline__ void operator()(const f32x4 (&acc)[2][2][4][2], const Unit& u, int wr, int wc, int fr, int fq) const {
        const int row0 = u.pm * BM + wr * 64 + fr, col0 = u.pn * BM + wc * 32 + 8 * fq;
        float rs8[8]; row_rs8(rs8, ssp, nparts, row0);
#pragma unroll
        for (int ai = 0; ai < 2; ++ai)
#pragma unroll
            for (int m = 0; m < 4; ++m) { const int row = row0 + ai * HALF + m * 16; const float rs = rs8[4 * ai + m]; bf16_t* rowp = O + (size_t)row * ldo + col0;
#pragma unroll
                for (int bj = 0; bj < 2; ++bj) *(u32x4*)(rowp + bj * HALF) = pack8(acc[ai][bj][m][0] * rs, acc[ai][bj][m][1] * rs); }
    }
};

struct EpiNull {
    static constexpr bool PERM = true, AFTER_DRAIN = false;
    __device__ __forceinline__ void operator()(const f32x4 (&acc)[2][2][4][2], const Unit& u, int wr, int wc, int fr, int fq) const {
        float s = 0.f;
#pragma unroll
        for (int ai = 0; ai < 2; ++ai)
#pragma unroll
            for (int bj = 0; bj < 2; ++bj)
#pragma unroll
                for (int m = 0; m < 4; ++m) s += acc[ai][bj][m][0][0] + acc[ai][bj][m][1][3];
        asm volatile("" :: "v"(s));
    }
};
template <class Epi, class Sched, bool ALIGN_EPI = false, bool SP2 = false>
__device__ __forceinline__ void gemm_phase(PG8_LAS unsigned char* lds, const Gemm g, const Sched& S, const Epi& E, int tid_in) {
    int tid_ = tid_in; asm volatile("" : "+v"(tid_));
    const int tid = tid_, wid = __builtin_amdgcn_readfirstlane(tid >> 6), lane = tid & 63, wr = wid >> 2, wc = wid & 3, fr = lane & 15, fq = lane >> 4;
    const int K = g.K, nt = K / BK;
    unsigned voffA[2], voffB[2];
#pragma unroll
    for (int i = 0; i < 2; ++i) { int R, C; stage_rc(tid * 16 + i * 8192, R, C); const int Rb = Epi::PERM ? ((R & ~31) + perm32(R & 31)) : R;
        voffA[i] = (unsigned)(R * K + C) * 2u; voffB[i] = (unsigned)(Rb * K + C) * 2u; }
    const size_t kstep = (size_t)(BK * 2);
    const size_t hstep = (size_t)HALF * K * 2;
    const size_t tstep = 2 * hstep;
    const unsigned ldsw = (unsigned)wid * 1024u;
    const int aoff = lds_byte(wr * 64 + fr, fq * 8), boff = lds_byte(wc * 32 + fr, fq * 8);
#define PG8_SA(b, h) (((b) * 2 + (h)) * HTB)
#define PG8_SB(b, h) ((4 + (b) * 2 + (h)) * HTB)
#define PG8_STAGE(bufoff, gbase, voff) do { _Pragma("unroll") for (int _i = 0; _i < 2; ++_i) \
        __builtin_amdgcn_global_load_lds((const unsigned*)((const char*)(gbase) + (voff)[_i]), (PG8_LAS unsigned*)(lds + (bufoff) + ldsw + _i * 8192), 16, 0, 0); } while (0)
#define PG8_LDA(dst, b, h) do { _Pragma("unroll") for (int m = 0; m < 4; ++m) _Pragma("unroll") for (int k = 0; k < 2; ++k) dst[m][k] = *(const PG8_LAS bf16x8*)(lds + PG8_SA(b, h) + aoff + m * 2048 + k * 1024); } while (0)
#define PG8_LDB(dst, b, h) do { _Pragma("unroll") for (int n = 0; n < 2; ++n) _Pragma("unroll") for (int k = 0; k < 2; ++k) dst[n][k] = *(const PG8_LAS bf16x8*)(lds + PG8_SB(b, h) + boff + n * 2048 + k * 1024); } while (0)
#define PG8_MMA(ai, bj, At, Bt) do { __builtin_amdgcn_s_setprio(1); _Pragma("unroll") for (int m = 0; m < 4; ++m) _Pragma("unroll") for (int n = 0; n < 2; ++n) _Pragma("unroll") for (int k = 0; k < 2; ++k) \
        acc[ai][bj][m][n] = __builtin_amdgcn_mfma_f32_16x16x32_bf16(Bt[n][k], At[m][k], acc[ai][bj][m][n], 0, 0, 0); __builtin_amdgcn_s_setprio(0); } while (0)
#define PG8_WAIT_V(n) asm volatile("s_waitcnt vmcnt(" #n ")" ::: "memory")
#define PG8_WAIT_L(n) asm volatile("s_waitcnt lgkmcnt(" #n ")" ::: "memory")
#define PG8_BAR __builtin_amdgcn_s_barrier()
#define PG8_SCHED __builtin_amdgcn_sched_barrier(0)
    Unit cur, nxt; int ui = 0;
    if (!S.next(0, cur)) return;
    f32x4 acc[2][2][4][2];
#pragma unroll
    for (int a = 0; a < 2; ++a)
#pragma unroll
        for (int b = 0; b < 2; ++b)
#pragma unroll
            for (int m = 0; m < 4; ++m)
#pragma unroll
                for (int n = 0; n < 2; ++n) acc[a][b][m][n] = (f32x4){0.f, 0.f, 0.f, 0.f};
    bf16x8 At[4][2], B0[2][2], B1[2][2];
    const char* cA = (const char*)g.A + (size_t)cur.pm * tstep; const char* cB = (const char*)g.Bt + (size_t)cur.pn * tstep;
    S.a_ready(cur);
    if constexpr (SP2) {
        PG8_STAGE(PG8_SB(0, 0), cB, voffB); PG8_STAGE(PG8_SB(0, 1), cB + hstep, voffB); PG8_STAGE(PG8_SA(0, 0), cA, voffA); PG8_STAGE(PG8_SA(0, 1), cA + hstep, voffA);
        if (wr == 1) PG8_BAR;
        PG8_WAIT_V(2); PG8_BAR;
        PG8_STAGE(PG8_SB(1, 0), cB + kstep, voffB); PG8_STAGE(PG8_SA(1, 0), cA + kstep, voffA); PG8_STAGE(PG8_SB(1, 1), cB + hstep + kstep, voffB);
        PG8_WAIT_V(6); PG8_BAR;
    } else {
        PG8_STAGE(PG8_SB(0, 0), cB, voffB); PG8_STAGE(PG8_SA(0, 0), cA, voffA); PG8_STAGE(PG8_SB(0, 1), cB + hstep, voffB); PG8_STAGE(PG8_SA(0, 1), cA + hstep, voffA);
        if (wr == 1) PG8_BAR;
        PG8_WAIT_V(4); PG8_BAR;
        PG8_STAGE(PG8_SB(1, 0), cB + kstep, voffB); PG8_STAGE(PG8_SA(1, 0), cA + kstep, voffA); PG8_STAGE(PG8_SB(1, 1), cB + hstep + kstep, voffB);
        PG8_WAIT_V(6); PG8_BAR;
    }
    for (;;) {
        const bool has_next = S.next(ui + 1, nxt);
        const char* nA = has_next ? (const char*)g.A + (size_t)nxt.pm * tstep : cA; const char* nB = has_next ? (const char*)g.Bt + (size_t)nxt.pn * tstep : cB;
        for (int t = 0; t < nt; t += 2) {
            const bool last = (t == nt - 2);
            const char* a1 = cA + (size_t)(t + 1) * kstep;
            const char* a2 = last ? nA : cA + (size_t)(t + 2) * kstep; const char* b2 = last ? nB : cB + (size_t)(t + 2) * kstep;
            const char* a3 = a2 + kstep; const char* b3 = b2 + kstep;
            if (last && has_next) S.a_ready(nxt);
            if constexpr (SP2) {
            PG8_LDB(B0, 0, 0); PG8_LDB(B1, 0, 1); PG8_SCHED; PG8_LDA(At, 0, 0); PG8_STAGE(PG8_SA(1, 1), a1 + hstep, voffA);
            PG8_WAIT_V(8); PG8_WAIT_L(0); PG8_BAR; PG8_MMA(0, 0, At, B0); PG8_MMA(0, 1, At, B1); PG8_BAR; PG8_SCHED;
            PG8_LDA(At, 0, 1); PG8_STAGE(PG8_SB(0, 0), b2, voffB); PG8_STAGE(PG8_SB(0, 1), b2 + hstep, voffB); PG8_STAGE(PG8_SA(0, 0), a2, voffA);
            PG8_WAIT_V(8); PG8_WAIT_L(0); PG8_BAR; PG8_MMA(1, 0, At, B0); PG8_MMA(1, 1, At, B1); PG8_BAR; PG8_SCHED;
            PG8_LDB(B0, 1, 0); PG8_LDB(B1, 1, 1); PG8_SCHED; PG8_LDA(At, 1, 0); PG8_STAGE(PG8_SA(0, 1), a2 + hstep, voffA);
            PG8_WAIT_V(8); PG8_WAIT_L(0); PG8_BAR; PG8_MMA(0, 0, At, B0); PG8_MMA(0, 1, At, B1); PG8_BAR; PG8_SCHED;
            PG8_LDA(At, 1, 1); PG8_STAGE(PG8_SB(1, 0), b3, voffB); PG8_STAGE(PG8_SB(1, 1), b3 + hstep, voffB); PG8_STAGE(PG8_SA(1, 0), a3, voffA);
            PG8_WAIT_V(8); PG8_WAIT_L(0); PG8_BAR; PG8_MMA(1, 0, At, B0); PG8_MMA(1, 1, At, B1); PG8_BAR; PG8_SCHED;
            } else {
            PG8_LDB(B0, 0, 0); PG8_SCHED; PG8_LDA(At, 0, 0); PG8_STAGE(PG8_SA(1, 1), a1 + hstep, voffA);
            PG8_WAIT_L(8); PG8_BAR; PG8_WAIT_L(0); PG8_MMA(0, 0, At, B0); PG8_BAR; PG8_SCHED;
            PG8_LDB(B1, 0, 1); PG8_STAGE(PG8_SB(0, 0), b2, voffB);
            PG8_BAR; PG8_WAIT_L(0); PG8_MMA(0, 1, At, B1); PG8_BAR;
            PG8_LDA(At, 0, 1); PG8_STAGE(PG8_SA(0, 0), a2, voffA);
            PG8_BAR; PG8_WAIT_L(0); PG8_MMA(1, 0, At, B0); PG8_BAR; PG8_SCHED;
            PG8_STAGE(PG8_SB(0, 1), b2 + hstep, voffB);
            PG8_WAIT_V(6); PG8_BAR; PG8_MMA(1, 1, At, B1); PG8_BAR;
            PG8_LDB(B0, 1, 0); PG8_SCHED; PG8_LDA(At, 1, 0); PG8_STAGE(PG8_SA(0, 1), a2 + hstep, voffA);
            PG8_WAIT_L(8); PG8_BAR; PG8_WAIT_L(0); PG8_MMA(0, 0, At, B0); PG8_BAR; PG8_SCHED;
            PG8_LDB(B1, 1, 1); PG8_STAGE(PG8_SB(1, 0), b3, voffB);
            PG8_BAR; PG8_WAIT_L(0); PG8_MMA(0, 1, At, B1); PG8_BAR;
            PG8_LDA(At, 1, 1); PG8_STAGE(PG8_SA(1, 0), a3, voffA);
            PG8_BAR; PG8_WAIT_L(0); PG8_MMA(1, 0, At, B0); PG8_BAR; PG8_SCHED;
            PG8_STAGE(PG8_SB(1, 1), b3 + hstep, voffB);
            PG8_WAIT_V(6); PG8_BAR; PG8_MMA(1, 1, At, B1); PG8_BAR;
            }
        }
        if constexpr (ALIGN_EPI) { if (wr == 0) PG8_BAR; }
        if constexpr (!Epi::AFTER_DRAIN) { E(acc, cur, wr, wc, fr, fq); S.done(cur); }
        if (!has_next) break;
#pragma unroll
        for (int a = 0; a < 2; ++a)
#pragma unroll
            for (int b = 0; b < 2; ++b)
#pragma unroll
                for (int m = 0; m < 4; ++m)
#pragma unroll
                    for (int n = 0; n < 2; ++n) acc[a][b][m][n] = (f32x4){0.f, 0.f, 0.f, 0.f};
        cur = nxt; cA = nA; cB = nB; ++ui;
        if constexpr (ALIGN_EPI) { if (wr == 1) PG8_BAR; }
    }
    PG8_WAIT_V(0);
    if constexpr (!ALIGN_EPI) { if (wr == 0) PG8_BAR; }
    PG8_BAR;
    if constexpr (Epi::AFTER_DRAIN) { E.fused(acc, cur, wr, wc, fr, fq, lds, wid, lane); S.done(cur); }
#undef PG8_SA
#undef PG8_SB
#undef PG8_STAGE
#undef PG8_LDA
#undef PG8_LDB
#undef PG8_MMA
#undef PG8_WAIT_V
#undef PG8_WAIT_L
#undef PG8_BAR
#undef PG8_SCHED
}
}

#define GAS __attribute__((address_space(1)))
#define LAS __attribute__((address_space(3)))
typedef unsigned short bf16;
typedef unsigned v4u __attribute__((ext_vector_type(4)));
typedef unsigned v2u __attribute__((ext_vector_type(2)));
typedef float f32x4 __attribute__((ext_vector_type(4)));
typedef float f32x2 __attribute__((ext_vector_type(2)));
typedef float f32x16 __attribute__((ext_vector_type(16)));
typedef short bf16x8 __attribute__((ext_vector_type(8)));
#define LDS_WAIT() asm volatile("s_waitcnt lgkmcnt(0)" ::: "memory")
using pg8::cvt_pk_bf16; using pg8::pack8; using pg8::sigmoid_f; using pg8::silu_f; using pg8::gelu_tanh_f; using pg8::row_rs; using pg8::fast_exp2;

#ifndef PHM
#define PHM 255
#endif
#ifndef PROBE_NULLM
#define PROBE_NULLM 0
#endif
#ifndef PROBE_DUPM
#define PROBE_DUPM 0
#endif
#ifndef MK_PER_PHASE
#define MK_PER_PHASE 0
#endif
constexpr int NWAVES = 8;
constexpr int BATCH = 16, SEQ = 2048, D = 1024, FF = 2816, TOK = BATCH * SEQ;
constexpr int NPH = 15;
constexpr size_t MiB = 1u << 20;
constexpr size_t WS_W13 = 1 * MiB;
constexpr size_t WS_W2 = 45 * MiB;
constexpr size_t WS_WIN = 67 * MiB;
constexpr size_t WS_WV = 72 * MiB;
constexpr size_t WS_WOUT = 73 * MiB;
constexpr size_t WS_WGLU = 75 * MiB;
constexpr size_t WS_WLRU = 79 * MiB;
constexpr size_t WS_ROPE = 80 * MiB;
constexpr size_t WS_SSP = 81 * MiB;
constexpr size_t WS_XB = 96 * MiB;
constexpr size_t WS_R1 = 160 * MiB;
constexpr size_t WS_Q = WS_R1, WS_K = WS_R1 + 32 * MiB, WS_VT = WS_R1 + 64 * MiB, WS_G = WS_R1 + 96 * MiB;
constexpr size_t WS_MRG = 352 * MiB;
constexpr size_t WS_END = 416 * MiB;
constexpr int LDS_BYTES = 135168;

__device__ __forceinline__ unsigned f2bf(float f) { unsigned u = __builtin_bit_cast(unsigned, f); return (u + 0x7fffu + ((u >> 16) & 1u)) >> 16; }
__device__ __forceinline__ unsigned pk2(float lo, float hi) { return f2bf(lo) | (f2bf(hi) << 16); }
__device__ __forceinline__ float bf_lo(unsigned w) { return __builtin_bit_cast(float, w << 16); }
__device__ __forceinline__ float bf_hi(unsigned w) { return __builtin_bit_cast(float, w & 0xffff0000u); }
__device__ __forceinline__ float bf1(bf16 h) { return __builtin_bit_cast(float, (unsigned)h << 16); }
__device__ __forceinline__ float wave_sum(float v) {
#pragma unroll
    for (int o = 1; o < 64; o <<= 1) v += __shfl_xor(v, o);
    return v;
}
__device__ __forceinline__ f32x4 mfma16(bf16x8 a, bf16x8 b, f32x4 c) { return __builtin_amdgcn_mfma_f32_16x16x32_bf16(a, b, c, 0, 0, 0); }

__device__ __forceinline__ void transpose_item(const float* __restrict__ W, int N, int K, const float* __restrict__ gk, bf16* WT, int dst_row, int k0, int n0, LAS float* scr, int lane) {
#pragma unroll 8
    for (int i = 0; i < 32; ++i) { const int kk = 2 * i + (lane >> 5); float v = W[(size_t)(k0 + kk) * N + n0 + (lane & 31)]; if (gk) v *= gk[k0 + kk]; scr[kk * 33 + (lane & 31)] = v; }
    LDS_WAIT(); asm volatile("" ::: "memory");
    const int c = lane & 7;
#pragma unroll
    for (int j = 0; j < 4; ++j) { const int n = (lane >> 3) + 8 * j; const LAS float* s = scr + (8 * c) * 33 + n;
        v4u o; o.x = pk2(s[0 * 33], s[1 * 33]); o.y = pk2(s[2 * 33], s[3 * 33]); o.z = pk2(s[4 * 33], s[5 * 33]); o.w = pk2(s[6 * 33], s[7 * 33]);
        *(v4u*)(WT + (size_t)(dst_row + n) * K + k0 + 8 * c) = o; }
    LDS_WAIT(); asm volatile("" ::: "memory");
}
struct Args { const float* in[27]; float* out; unsigned char* ws; int ph_lo, ph_hi; };
typedef const __attribute__((address_space(4))) Args* KArgP;

__device__ __forceinline__ void p0_prologue(KArgP ap, LAS unsigned char* lds, int gw, int NGW, int wave, int lane) {
    LAS float* scr = (LAS float*)(lds + wave * 16384);
    unsigned char* ws = ap->ws;
    constexpr int I_F = 1408, I_IN = 1536, I_OUT = 512, I_GL = 512, I_LRU = 64;
    constexpr int NITEMS = 12 * I_F + I_IN + I_OUT + 2 * I_GL + I_LRU;
    for (int it = gw; it < NITEMS; it += NGW) {
        int r = it;
        if (r < 8 * I_F) { const int w3 = r >= 4 * I_F; if (w3) r -= 4 * I_F; const int l = r / I_F; r -= l * I_F; const int kb = r / 88, nb = r % 88, n0 = 32 * nb;
            transpose_item(ap->in[w3 ? 3 : 2] + (size_t)l * D * FF, FF, D, ap->in[1] + l * D, (bf16*)(ws + WS_W13) + (size_t)l * 5632 * 1024, 256 * (n0 >> 7) + (n0 & 127) + (w3 ? 128 : 0), 64 * kb, n0, scr, lane); continue; }
        r -= 8 * I_F;
        if (r < 4 * I_F) { const int l = r / I_F; r -= l * I_F; const int kb = r / 32, nb = r % 32;
            transpose_item(ap->in[4] + (size_t)l * FF * D, D, FF, nullptr, (bf16*)(ws + WS_W2) + (size_t)l * 1024 * FF, 32 * nb, 64 * kb, 32 * nb, scr, lane); continue; }
        r -= 4 * I_F;
        if (r < I_IN) { const int kb = r / 96, nb = r % 96, n0 = 32 * nb; bf16* dst; int drow;
            if (n0 < 1024) { const int sec = n0 >> 9, nn = n0 & 511, h = nn >> 7, bj = (nn >> 6) & 1, jj0 = nn & 63; dst = (bf16*)(ws + WS_WIN); drow = 512 * sec + 256 * (h >> 1) + 128 * bj + 64 * (h & 1) + jj0; }
            else if (n0 < 1536) { dst = (bf16*)(ws + WS_WV); drow = n0 - 1024; }
            else { dst = (bf16*)(ws + WS_WIN); drow = n0 - 512; }
            transpose_item(ap->in[6], 3072, D, ap->in[5], dst, drow, 64 * kb, n0, scr, lane); continue; }
        r -= I_IN;
        if (r < I_OUT) { const int kb = r / 32, nb = r % 32; transpose_item(ap->in[7], D, D, nullptr, (bf16*)(ws + WS_WOUT), 32 * nb, 64 * kb, 32 * nb, scr, lane); continue; }
        r -= I_OUT;
        if (r < 2 * I_GL) { const int wb = r >= I_GL; if (wb) r -= I_GL; const int kb = r / 32, nb = r % 32, n0 = 32 * nb;
            transpose_item(ap->in[wb ? 25 : 24], D, D, nullptr, (bf16*)(ws + WS_WGLU), 256 * (n0 >> 7) + (n0 & 127) + (wb ? 128 : 0), 64 * kb, n0, scr, lane); continue; }
        r -= 2 * I_GL;
        { const int mat = r >> 3, g = mat >> 1, gate = mat & 1, kb = (r >> 2) & 1, nb = r & 3;
            transpose_item(ap->in[gate ? 13 : 11] + (size_t)g * 128 * 128, 128, 128, nullptr, (bf16*)(ws + WS_WLRU) + (size_t)mat * 128 * 128, 32 * nb, 64 * kb, 32 * nb, scr, lane); }
    }
    { float* rope = (float*)(ws + WS_ROPE);
      for (int i = gw * 64 + lane; i < 2048 * 64; i += NGW * 64) { const int pos = i >> 6, j = i & 63; const double inv = pow(10000.0, -(double)j / 64.0); const double ang = (double)pos * inv;
          rope[2 * i] = (float)cos(ang); rope[2 * i + 1] = (float)sin(ang); } }
    { const float* x = ap->in[0]; bf16* xb = (bf16*)(ws + WS_XB); float* ssp = (float*)(ws + WS_SSP);
      for (int m = gw; m < TOK; m += NGW) { const f32x4* xr = (const f32x4*)(x + (size_t)m * D) + lane; f32x4 v[4]; float s = 0.f;
#pragma unroll
          for (int j = 0; j < 4; ++j) { v[j] = xr[64 * j]; s += (v[j][0] * v[j][0] + v[j][1] * v[j][1]) + (v[j][2] * v[j][2] + v[j][3] * v[j][3]); }
          s = wave_sum(s);
          v2u* o8 = (v2u*)(xb + (size_t)m * D) + lane;
#pragma unroll
          for (int j = 0; j < 4; ++j) { v2u w; w.x = cvt_pk_bf16(v[j][0], v[j][1]); w.y = cvt_pk_bf16(v[j][2], v[j][3]); o8[64 * j] = w; }
          if (lane < 16) ssp[(size_t)m * 32 + lane] = lane == 0 ? s : 0.f; } }
}

__device__ __forceinline__ void ret_unit(int b, int h, int p, const bf16* Q, const bf16* Kb, const bf16* Vt, const bf16* G, const float* ret_g, bf16* MRG, LAS unsigned char* lds, int tid, int wid, int lane) {
    const int fr = lane & 15, fq = lane >> 4;
    const int cq = 2 * p + (wid >> 2), iloc0 = 32 * (wid & 3);
    const size_t tok0 = (size_t)b * SEQ + 256 * p + 32 * wid;
    const float lg = log2f(1.0f - exp2f(-5.0f - (float)h));
    bf16x8 qf[2][4];
#pragma unroll
    for (int mi = 0; mi < 2; ++mi)
#pragma unroll
        for (int kk = 0; kk < 4; ++kk) qf[mi][kk] = *(const bf16x8*)(Q + (tok0 + 16 * mi + fr) * 512 + h * 128 + 32 * kk + 8 * fq);
    f32x4 O[2][8];
#pragma unroll
    for (int mi = 0; mi < 2; ++mi)
#pragma unroll
        for (int e = 0; e < 8; ++e) O[mi][e] = (f32x4){0.f, 0.f, 0.f, 0.f};
    const int nm = 2 * p + 2;
    const int srow = 4 * wid + (lane >> 4), keyK = ((wid >> 1) & 3) * 4 + (lane >> 4), keyV = 4 * (wid & 3) + (lane >> 4);
    const bf16* kbase = Kb + ((size_t)b * SEQ + srow) * 512 + h * 128 + 8 * ((lane & 15) ^ keyK);
    const bf16* vbase = Vt + ((size_t)(h * 128 + srow)) * TOK + (size_t)b * SEQ + 8 * ((lane & 15) ^ keyV);
#define RET_STAGE(m_, buf_) do { _Pragma("unroll") for (int i = 0; i < 4; ++i) { \
        __builtin_amdgcn_global_load_lds((const unsigned*)(kbase + ((size_t)(128 * (m_) + 32 * i)) * 512), (LAS unsigned*)(lds + (buf_) * 65536 + (8 * i + wid) * 1024), 16, 0, 0); \
        __builtin_amdgcn_global_load_lds((const unsigned*)(vbase + (size_t)(32 * i) * TOK + 128 * (m_)), (LAS unsigned*)(lds + (buf_) * 65536 + 32768 + (8 * i + wid) * 1024), 16, 0, 0); } } while (0)
    RET_STAGE(0, 0);
    asm volatile("s_waitcnt vmcnt(0)" ::: "memory"); __syncthreads();
    for (int m = 0; m < nm; ++m) {
        const int buf = m & 1;
        if (m + 1 < nm) RET_STAGE(m + 1, buf ^ 1);
        if (m <= cq) {
            const LAS unsigned char* Kl = lds + buf * 65536; const LAS unsigned char* Vl = Kl + 32768;
            const float sc = fast_exp2(lg * (float)(128 * (cq - m)));
#pragma unroll
            for (int g32 = 0; g32 < 4; ++g32) {
                f32x4 S[2][2];
#pragma unroll
                for (int n = 0; n < 2; ++n) { S[0][n] = (f32x4){0.f, 0.f, 0.f, 0.f}; S[1][n] = (f32x4){0.f, 0.f, 0.f, 0.f};
                    const int krow = 32 * g32 + 8 * (fr >> 2) + 4 * n + (fr & 3);
#pragma unroll
                    for (int kk = 0; kk < 4; ++kk) { const bf16x8 kf = *(const LAS bf16x8*)(Kl + krow * 256 + (((4 * kk + fq) ^ fr) << 4));
                        S[0][n] = mfma16(kf, qf[0][kk], S[0][n]); S[1][n] = mfma16(kf, qf[1][kk], S[1][n]); } }
                bf16x8 pf[2];
#pragma unroll
                for (int mi = 0; mi < 2; ++mi) { f32x4 v0 = S[mi][0] * sc, v1 = S[mi][1] * sc;
                    if (m == cq) { const int il = iloc0 + 16 * mi + fr, jl = 32 * g32 + 8 * fq;
#pragma unroll
                        for (int t = 0; t < 4; ++t) { v0[t] = (jl + t <= il) ? v0[t] : 0.f; v1[t] = (jl + 4 + t <= il) ? v1[t] : 0.f; } }
                    const pg8::u32x4 w = pack8(v0, v1); pf[mi] = __builtin_bit_cast(bf16x8, w); }
#pragma unroll
                for (int ef = 0; ef < 8; ++ef) { const int vrow = 16 * ef + fr;
                    const bf16x8 vf = *(const LAS bf16x8*)(Vl + vrow * 256 + (((4 * g32 + fq) ^ fr) << 4));
                    O[0][ef] = mfma16(vf, pf[0], O[0][ef]); O[1][ef] = mfma16(vf, pf[1], O[1][ef]); }
            }
        }
        asm volatile("s_waitcnt vmcnt(0)" ::: "memory"); __syncthreads();
    }
#undef RET_STAGE
#pragma unroll
    for (int mi = 0; mi < 2; ++mi) { const size_t tok = tok0 + 16 * mi + fr; float s = 0.f;
#pragma unroll
        for (int ef = 0; ef < 8; ++ef) s += (O[mi][ef][0] + O[mi][ef][1]) + (O[mi][ef][2] + O[mi][ef][3]);
        s += __shfl_xor(s, 16); s += __shfl_xor(s, 32); const float mu = s * (1.0f / 128.0f); float q = 0.f;
#pragma unroll
        for (int ef = 0; ef < 8; ++ef) { const f32x4 d = O[mi][ef] - mu; q += (d[0] * d[0] + d[1] * d[1]) + (d[2] * d[2] + d[3] * d[3]); }
        q += __shfl_xor(q, 16); q += __shfl_xor(q, 32); const float rstd = 1.0f / sqrtf(q * (1.0f / 128.0f) + 1e-6f);
#pragma unroll
        for (int ef = 0; ef < 8; ++ef) { const int col = h * 128 + 16 * ef + 4 * fq; const f32x4 gn = *(const f32x4*)(ret_g + col); const v2u gr = *(const v2u*)(G + tok * 1536 + col);
            const float g0 = bf_lo(gr.x), g1 = bf_hi(gr.x), g2 = bf_lo(gr.y), g3 = bf_hi(gr.y);
            const float y0 = (O[mi][ef][0] - mu) * rstd * gn[0] * silu_f(g0), y1 = (O[mi][ef][1] - mu) * rstd * gn[1] * silu_f(g1);
            const float y2 = (O[mi][ef][2] - mu) * rstd * gn[2] * silu_f(g2), y3 = (O[mi][ef][3] - mu) * rstd * gn[3] * silu_f(g3);
            v2u w; w.x = cvt_pk_bf16(y0, y1); w.y = cvt_pk_bf16(y2, y3); *(v2u*)(MRG + tok * 1024 + col) = w; } }
}

__device__ __forceinline__ void lru_unit(int b, int g, int q, const bf16* G, const bf16* LW, const float* conv_w, const float* conv_b, const float* b_a, const float* b_i, const float* lam,
                                         bf16* MRG, LAS unsigned char* lds, int tid, int wid, int lane) {
    const int fr = lane & 15, fq = lane >> 4;
    const bf16* wbase = LW + ((size_t)(g * 2 * 128 + 32 * q + fr)) * 128 + 8 * fq;
    LAS float* A_ = (LAS float*)lds; LAS float* BX = A_ + 8192; LAS float* SEG = BX + 8192; LAS float* CAR = SEG + 1024;
    const bf16* xl = G + (size_t)b * SEQ * 1536 + 512 + 128 * g;
    f32x4 gba[2], gbi[2], gsp[2];
#pragma unroll
    for (int nfl = 0; nfl < 2; ++nfl) { const int cg0 = 128 * g + 32 * q + 16 * nfl + 4 * fq; gba[nfl] = *(const f32x4*)(b_a + cg0); gbi[nfl] = *(const f32x4*)(b_i + cg0); const f32x4 lm = *(const f32x4*)(lam + cg0);
#pragma unroll
        for (int t = 0; t < 4; ++t) gsp[nfl][t] = -8.0f * 1.4426950408889634f * log1pf(__expf(-lm[t])); }
    for (int tile = 0; tile < 8; ++tile) {
        const int s0 = 256 * tile + 32 * wid;
        f32x4 acc[2][4];
#pragma unroll
        for (int mi = 0; mi < 2; ++mi)
#pragma unroll
            for (int nf = 0; nf < 4; ++nf) acc[mi][nf] = (f32x4){0.f, 0.f, 0.f, 0.f};
#pragma unroll 1
        for (int kk = 0; kk < 4; ++kk) { const int ch0 = 32 * kk + 8 * fq, cg0 = 128 * g + ch0;
            bf16x8 wf[4];
#pragma unroll
            for (int nf = 0; nf < 4; ++nf) wf[nf] = *(const bf16x8*)(wbase + (size_t)(((nf >> 1) * 128 + 16 * (nf & 1)) * 128 + 32 * kk));
#pragma unroll
            for (int mi = 0; mi < 2; ++mi) { const int s = s0 + 16 * mi + fr; float xc[8];
                { const f32x4 c0 = *(const f32x4*)(conv_b + cg0), c1 = *(const f32x4*)(conv_b + cg0 + 4); xc[0] = c0[0]; xc[1] = c0[1]; xc[2] = c0[2]; xc[3] = c0[3]; xc[4] = c1[0]; xc[5] = c1[1]; xc[6] = c1[2]; xc[7] = c1[3]; }
#pragma unroll
                for (int tap = 0; tap < 4; ++tap) { const int sp = s - 3 + tap; if (sp >= 0) { const v4u xv = *(const v4u*)(xl + (size_t)sp * 1536 + ch0);
                        const f32x4 w0 = *(const f32x4*)(conv_w + tap * 512 + cg0), w1 = *(const f32x4*)(conv_w + tap * 512 + cg0 + 4);
                        xc[0] += w0[0] * bf_lo(xv.x); xc[1] += w0[1] * bf_hi(xv.x); xc[2] += w0[2] * bf_lo(xv.y); xc[3] += w0[3] * bf_hi(xv.y);
                        xc[4] += w1[0] * bf_lo(xv.z); xc[5] += w1[1] * bf_hi(xv.z); xc[6] += w1[2] * bf_lo(xv.w); xc[7] += w1[3] * bf_hi(xv.w); } }
                pg8::u32x4 aw; aw.x = cvt_pk_bf16(xc[0], xc[1]); aw.y = cvt_pk_bf16(xc[2], xc[3]); aw.z = cvt_pk_bf16(xc[4], xc[5]); aw.w = cvt_pk_bf16(xc[6], xc[7]);
                const bf16x8 af = __builtin_bit_cast(bf16x8, aw);
#pragma unroll
                for (int nf = 0; nf < 4; ++nf) acc[mi][nf] = mfma16(wf[nf], af, acc[mi][nf]); } }
#pragma unroll
        for (int mi = 0; mi < 2; ++mi)
#pragma unroll
            for (int nfl = 0; nfl < 2; ++nfl) { const int cl = 32 * q + 16 * nfl + 4 * fq, cg0 = 128 * g + cl, s = s0 + 16 * mi + fr;
                f32x4 xc = *(const f32x4*)(conv_b + cg0);
#pragma unroll
                for (int tap = 0; tap < 4; ++tap) { const int sp = s - 3 + tap; if (sp >= 0) { const v2u xv = *(const v2u*)(xl + (size_t)sp * 1536 + cl); const f32x4 w0 = *(const f32x4*)(conv_w + tap * 512 + cg0);
                        xc[0] += w0[0] * bf_lo(xv.x); xc[1] += w0[1] * bf_hi(xv.x); xc[2] += w0[2] * bf_lo(xv.y); xc[3] += w0[3] * bf_hi(xv.y); } }
                f32x4 av, bv;
#pragma unroll
                for (int t = 0; t < 4; ++t) { const float r = sigmoid_f(acc[mi][nfl][t] + gba[nfl][t]), ig = sigmoid_f(acc[mi][nfl + 2][t] + gbi[nfl][t]);
                    const float a_ = fast_exp2(r * gsp[nfl][t]); av[t] = a_; bv[t] = sqrtf(fmaxf(1.0f - a_ * a_, 0.f)) * ig * xc[t]; }
                const int rt = 32 * wid + 16 * mi + fr;
                *(LAS f32x4*)(A_ + rt * 32 + 16 * nfl + 4 * fq) = av; *(LAS f32x4*)(BX + rt * 32 + 16 * nfl + 4 * fq) = bv; }
        __syncthreads();
        const int c = tid & 31, seg = tid >> 5;
        float sa[16], sb[16];
#pragma unroll
        for (int k = 0; k < 16; ++k) { sa[k] = A_[(16 * seg + k) * 32 + c]; sb[k] = BX[(16 * seg + k) * 32 + c]; }
        const size_t tokb = (size_t)b * SEQ + 256 * tile + 16 * seg;
        float gl[16];
#pragma unroll
        for (int k = 0; k < 16; ++k) gl[k] = bf1(G[(tokb + k) * 1536 + 1024 + 128 * g + 32 * q + c]);
        { float P = 1.f, hl = 0.f;
#pragma unroll
          for (int k = 0; k < 16; ++k) { hl = sa[k] * hl + sb[k]; P *= sa[k]; }
          SEG[(seg * 32 + c) * 2] = P; SEG[(seg * 32 + c) * 2 + 1] = hl; }
        __syncthreads();
        float hin = tile == 0 ? 0.f : CAR[(tile & 1) * 32 + c];
        { f32x2 sg[15];
#pragma unroll
          for (int s2 = 0; s2 < 15; ++s2) sg[s2] = *(const LAS f32x2*)(SEG + (s2 * 32 + c) * 2);
#pragma unroll
          for (int s2 = 0; s2 < 15; ++s2) if (s2 < seg) hin = sg[s2][0] * hin + sg[s2][1]; }
#pragma unroll
        for (int k = 0; k < 16; ++k) { hin = sa[k] * hin + sb[k];
            MRG[(tokb + k) * 1024 + 512 + 128 * g + 32 * q + c] = (bf16)f2bf(hin * gelu_tanh_f(gl[k])); }
        if (seg == 15) CAR[((tile + 1) & 1) * 32 + c] = hin;
        __syncthreads();
    }
}

constexpr int S5_WLDS = 27648;
__device__ __forceinline__ void s5_unit(int b, int g, KArgP ap, const float* x, const float* ssp, bf16* YS, LAS unsigned char* wl, int lane) {
    const float* lam_re = ap->in[16]; const float* lam_im = ap->in[17]; const float* log_dt = ap->in[18]; const float* b_re = ap->in[19]; const float* b_im = ap->in[20];
    const float* c_re = ap->in[21]; const float* c_im = ap->in[22]; const float* dsk = ap->in[23]; const float* gmix = ap->in[5] + D;
    LAS float* BU = (LAS float*)wl; LAS unsigned char* Hh = wl + 16384; LAS float* U = (LAS float*)(wl + 16384 + 8704);
    const float dt = __expf(log_dt[g]);
    float lr, li;
    { const float re = lam_re[g * 64 + lane], im = lam_im[g * 64 + lane], mag = __expf(re * dt); lr = mag * cosf(im * dt); li = mag * sinf(im * dt); }
    bf16x8 bfr[4];
#pragma unroll
    for (int q = 0; q < 4; ++q) { const int pp = 16 * q + ((lane & 31) >> 1), comp = lane & 1, hh = lane >> 5;
        const float re = lam_re[g * 64 + pp], im = lam_im[g * 64 + pp], mag = __expf(re * dt), lbr = mag * cosf(im * dt), lbi = mag * sinf(im * dt);
        const float den = re * re + im * im, nr = lbr - 1.0f, ni = lbi, fre = (nr * re + ni * im) / den, fim = (ni * re - nr * im) / den;
        const f32x4* pr = (const f32x4*)(b_re + ((size_t)(g * 64 + pp)) * 16 + 8 * hh); const f32x4* pi = (const f32x4*)(b_im + ((size_t)(g * 64 + pp)) * 16 + 8 * hh);
        const f32x4 r0 = pr[0], r1 = pr[1], i0 = pi[0], i1 = pi[1]; f32x4 o0, o1;
#pragma unroll
        for (int t = 0; t < 4; ++t) { o0[t] = comp ? (fre * i0[t] + fim * r0[t]) : (fre * r0[t] - fim * i0[t]); o1[t] = comp ? (fre * i1[t] + fim * r1[t]) : (fre * r1[t] - fim * i1[t]); }
        const pg8::u32x4 w = pack8(o0, o1); bfr[q] = __builtin_bit_cast(bf16x8, w); }
    bf16x8 cfr[4];
#pragma unroll
    for (int kk = 0; kk < 4; ++kk) { const int c = lane & 15, kq = lane >> 4, p0 = 16 * kk + 4 * kq;
        const f32x4 cr = *(const f32x4*)(c_re + ((size_t)(g * 16 + c)) * 64 + p0), ci = *(const f32x4*)(c_im + ((size_t)(g * 16 + c)) * 64 + p0);
        pg8::u32x4 w; w.x = cvt_pk_bf16(cr[0], -ci[0]); w.y = cvt_pk_bf16(cr[1], -ci[1]); w.z = cvt_pk_bf16(cr[2], -ci[2]); w.w = cvt_pk_bf16(cr[3], -ci[3]); cfr[kk] = __builtin_bit_cast(bf16x8, w); }
    const int tr = lane & 31, hh = lane >> 5;
    const f32x4 gm0 = *(const f32x4*)(gmix + 16 * g + 8 * hh), gm1 = *(const f32x4*)(gmix + 16 * g + 8 * hh + 4);
    const float dch = dsk[16 * g + (lane & 15)];
    float hre = 0.f, him = 0.f;
    const size_t tokb = (size_t)b * SEQ;
    f32x4 nx0, nx1; float nrs;
    { const size_t tok = tokb + tr; nx0 = *(const f32x4*)(x + tok * D + 16 * g + 8 * hh); nx1 = *(const f32x4*)(x + tok * D + 16 * g + 8 * hh + 4); nrs = row_rs(ssp, 16, (int)tok); }
    for (int blk = 0; blk < 64; ++blk) {
        f32x4 u0 = nx0 * nrs * gm0, u1 = nx1 * nrs * gm1;
        if (blk + 1 < 64) { const size_t tok = tokb + 32 * (blk + 1) + tr; nx0 = *(const f32x4*)(x + tok * D + 16 * g + 8 * hh); nx1 = *(const f32x4*)(x + tok * D + 16 * g + 8 * hh + 4); nrs = row_rs(ssp, 16, (int)tok); }
        *(LAS f32x4*)(U + tr * 16 + 8 * hh) = u0; *(LAS f32x4*)(U + tr * 16 + 8 * hh + 4) = u1;
        const pg8::u32x4 uw = pack8(u0, u1); const bf16x8 uf = __builtin_bit_cast(bf16x8, uw);
#pragma unroll
        for (int q = 0; q < 4; ++q) { f32x16 d;
#pragma unroll
            for (int r = 0; r < 16; ++r) d[r] = 0.f;
            d = __builtin_amdgcn_mfma_f32_32x32x16_bf16(uf, bfr[q], d, 0, 0, 0);
#pragma unroll
            for (int r = 0; r < 16; ++r) BU[((r & 3) + 8 * (r >> 2) + 4 * hh) * 128 + 32 * q + tr] = d[r]; }
        LDS_WAIT(); asm volatile("" ::: "memory");
        { f32x2 bu[32];
#pragma unroll
          for (int t = 0; t < 32; ++t) bu[t] = *(const LAS f32x2*)(BU + t * 128 + 2 * lane);
          LDS_WAIT(); asm volatile("" ::: "memory");
#pragma unroll
          for (int t = 0; t < 32; ++t) { const float nr = lr * hre - li * him + bu[t][0], ni = lr * him + li * hre + bu[t][1]; hre = nr; him = ni;
              *(LAS unsigned*)(Hh + t * 272 + 4 * lane) = cvt_pk_bf16(nr, ni); } }
        LDS_WAIT(); asm volatile("" ::: "memory");
        const int c = lane & 15, kq = lane >> 4;
#pragma unroll
        for (int tf = 0; tf < 2; ++tf) { f32x4 y = (f32x4){0.f, 0.f, 0.f, 0.f};
#pragma unroll
            for (int kk = 0; kk < 4; ++kk) { const bf16x8 hf = *(const LAS bf16x8*)(Hh + (16 * tf + c) * 272 + (32 * kk + 8 * kq) * 2); y = mfma16(hf, cfr[kk], y); }
#pragma unroll
            for (int r = 0; r < 4; ++r) { const int t = 16 * tf + 4 * kq + r; const float uu = U[t * 16 + c]; const float yv = y[r] + dch * uu;
                YS[(tokb + 32 * blk + t) * 1024 + 16 * g + c] = (bf16)f2bf(gelu_tanh_f(yv)); } }
        LDS_WAIT(); asm volatile("" ::: "memory");
    }
}

#define XB_TMO      128
#define XB_XCNT(j)  (256  + 64 * (j))
#define XB_XSUB(j)  (1280 + 64 * (j))
#define XB_XGEN(j)  (2304 + 64 * (j))
#define XB_TOP      3328
#define XB_TOPGEN   3392
#define XCD_BAR_WORDS 3456
#define XB_SPIN_CAP (1u << 18)

__device__ __forceinline__ unsigned xb_ld(unsigned* p)              { return __hip_atomic_load(p, __ATOMIC_RELAXED, __HIP_MEMORY_SCOPE_AGENT); }
__device__ __forceinline__ unsigned xb_add(unsigned* p, unsigned v) { return __hip_atomic_fetch_add(p, v, __ATOMIC_RELAXED, __HIP_MEMORY_SCOPE_AGENT); }
__device__ __forceinline__ unsigned xb_xcc_id() { return (unsigned)__builtin_amdgcn_s_getreg((3 << 11) | 20) & 0xFu; }
#define XB_SPIN(cond, bar) do { unsigned _sp = 0; while (cond) { __builtin_amdgcn_s_sleep(1); \
    if ((++_sp & 255u) == 0u) { if (xb_ld(&(bar)[XB_TMO])) break; if (_sp > XB_SPIN_CAP) { atomicAdd(&(bar)[XB_TMO], 1u); break; } } } } while (0)

struct XcdBarrier {
    unsigned* bar; unsigned x;
    volatile LAS unsigned* st;
};

__device__ __forceinline__ XcdBarrier xcd_barrier_post(unsigned* bar, volatile LAS unsigned* st, int tid) {
    XcdBarrier b; b.bar = bar; b.x = xb_xcc_id(); b.st = st;
    if (tid == 0) (void)xb_add(&bar[XB_XCNT(b.x)], 1u);
    return b;
}
__device__ __forceinline__ void xcd_barrier_complete(unsigned* bar, unsigned x, unsigned& nloc, unsigned& nx) {
    const unsigned G = gridDim.x * gridDim.y * gridDim.z;
    unsigned sum, cnt, mine, sp = 0u;
    for (;;) {
        sum = 0u; cnt = 0u; mine = 0u;
#pragma unroll
        for (unsigned j = 0; j < 16; ++j) { const unsigned c = xb_ld(&bar[XB_XCNT(j)]); sum += c; cnt += (c > 0u) ? 1u : 0u; mine = (j == x) ? c : mine; }
        if (sum == G) break;
        __builtin_amdgcn_s_sleep(1);
        if ((++sp & 255u) == 0u) { if (xb_ld(&bar[XB_TMO])) break; if (sp > XB_SPIN_CAP) { atomicAdd(&bar[XB_TMO], 1u); break; } }
    }
    nloc = mine > 0u ? mine : 1u; nx = cnt > 0u ? cnt : 1u;
}

__device__ __forceinline__ void xcd_barrier(const XcdBarrier& b, int tid) {
    asm volatile("s_waitcnt vmcnt(0)" ::: "memory");
    __syncthreads();
    if (tid == 0) {
        unsigned* bar = b.bar;
        __builtin_amdgcn_s_waitcnt(0);
        unsigned nloc = b.st[0], nx = b.st[1];
        if (nloc == 0u) { xcd_barrier_complete(bar, b.x, nloc, nx); b.st[0] = nloc; b.st[1] = nx; }
        const unsigned old = xb_add(&bar[XB_XSUB(b.x)], 1u);
        const unsigned gen = old / nloc;
        if (old + 1u == (gen + 1u) * nloc) {
            __builtin_amdgcn_fence(__ATOMIC_RELEASE, "agent");
            asm volatile("s_waitcnt vmcnt(0)" ::: "memory");
            const unsigned og = xb_add(&bar[XB_TOP], 1u);
            const unsigned tg = og / nx;
            if (og + 1u == (tg + 1u) * nx) xb_add(&bar[XB_TOPGEN], 1u);
            else XB_SPIN(xb_ld(&bar[XB_TOPGEN]) == tg, bar);
            __builtin_amdgcn_fence(__ATOMIC_ACQUIRE, "agent");
            xb_add(&bar[XB_XGEN(b.x)], 1u);
            asm volatile("s_waitcnt vmcnt(0)" ::: "memory");
        } else {
            XB_SPIN(xb_ld(&bar[XB_XGEN(b.x)]) == gen, bar);
            __builtin_amdgcn_fence(__ATOMIC_ACQUIRE, "agent");
            asm volatile("s_waitcnt vmcnt(0)" ::: "memory");
        }
    }
    __syncthreads();
}

__device__ __forceinline__ int lane_id() { return (int)__builtin_amdgcn_mbcnt_hi(~0u, __builtin_amdgcn_mbcnt_lo(~0u, 0u)); }
template <int ph> __device__ __forceinline__ void phase_body(LAS unsigned char* lds, int wave) {
    int lane_ = lane_id(); asm volatile("" : "+v"(lane_));
    const int lane = lane_, tid = wave * 64 + lane;
    const int G_ = gridDim.x, bx = blockIdx.x;
    const int gw = bx * NWAVES + wave, NGW = G_ * NWAVES;
    KArgP ap = (KArgP)__builtin_amdgcn_kernarg_segment_ptr(); asm volatile("" : "+s"(ap));
    unsigned char* ws = ap->ws;
    float* X = ap->out;
    bf16* XB = (bf16*)(ws + WS_XB); float* SSP = (float*)(ws + WS_SSP); bf16* HID = (bf16*)(ws + WS_R1); bf16* MRG = (bf16*)(ws + WS_MRG);
    (void)gw; (void)NGW; (void)lane; (void)X; (void)XB; (void)SSP; (void)HID; (void)MRG;
        if constexpr (ph == 0 && (PHM & 1)) { p0_prologue(ap, lds, gw, NGW, wave, lane); }
        else if constexpr ((PHM & 2) && (ph == 1 || ph == 6 || ph == 8 || ph == 12)) {
            const int l = ph == 1 ? 0 : ph == 6 ? 1 : ph == 8 ? 2 : 3;
            if constexpr (ph == 1 && (PROBE_NULLM & 1)) { pg8::Gemm g{XB, (const bf16*)(ws + WS_W13), TOK, 5632, D}; pg8::StaticOrder S; S.init(TOK, 5632, G_, bx); pg8::EpiNull E; pg8::gemm_phase<pg8::EpiNull, pg8::StaticOrder, true, true>(lds, g, S, E, tid); }
            pg8::Gemm g{XB, (const bf16*)(ws + WS_W13) + (size_t)l * 5632 * 1024, TOK, 5632, D}; pg8::StaticOrder S; S.init(TOK, 5632, G_, bx);
            pg8::EpiSwiglu E{HID, FF, SSP, ph == 12 ? 32 : 16};
            pg8::gemm_phase<pg8::EpiSwiglu, pg8::StaticOrder, true, true>(lds, g, S, E, tid);
        }
        else if constexpr ((PHM & 4) && (ph == 2 || ph == 7 || ph == 9 || ph == 13 || ph == 5)) {
            const int l = ph == 2 ? 0 : ph == 7 ? 1 : ph == 9 ? 2 : 3;
            pg8::Gemm g; g.M = TOK; g.N = D;
            if (ph == 5) { g.A = MRG; g.Bt = (const bf16*)(ws + WS_WOUT); g.K = D; } else { g.A = HID; g.Bt = (const bf16*)(ws + WS_W2) + (size_t)l * 1024 * FF; g.K = FF; }
            pg8::StaticOrder S; S.init(TOK, D, G_, bx);
            if constexpr (ph == 7 && (PROBE_NULLM & 2)) { pg8::EpiNull E0; pg8::gemm_phase<pg8::EpiNull, pg8::StaticOrder, true, true>(lds, g, S, E0, tid); }
            pg8::EpiResid E{ph == 2 ? ap->in[0] : X, X, XB, SSP, ph == 5 ? 1.0f : 0.5f};
            pg8::gemm_phase<pg8::EpiResid, pg8::StaticOrder, true, true>(lds, g, S, E, tid);
        }
        else if constexpr ((PHM & 8) && ph == 3) {
            { pg8::Gemm g{XB, (const bf16*)(ws + WS_WIN), TOK, 1024, D}; pg8::StaticOrder S; S.init(TOK, 1024, G_, bx);
              pg8::EpiRope E{(bf16*)(ws + WS_Q), (bf16*)(ws + WS_K), (const float*)(ws + WS_ROPE), SSP, 16};
              pg8::gemm_phase<pg8::EpiRope, pg8::StaticOrder, true, true>(lds, g, S, E, tid); }
            { pg8::Gemm g{XB, (const bf16*)(ws + WS_WIN) + (size_t)1024 * 1024, TOK, 1536, D}; pg8::StaticOrder S; S.init(TOK, 1536, G_, bx);
              pg8::EpiScaled E{(bf16*)(ws + WS_G), 1536, SSP, 16};
              pg8::gemm_phase<pg8::EpiScaled, pg8::StaticOrder, true, true>(lds, g, S, E, tid); }
            { pg8::Gemm g{(const bf16*)(ws + WS_WV), XB, 512, TOK, D}; pg8::StaticOrder S; S.init(512, TOK, G_, bx);
              pg8::EpiPlain E{(bf16*)(ws + WS_VT), TOK};
              pg8::gemm_phase<pg8::EpiPlain, pg8::StaticOrder, true, true>(lds, g, S, E, tid); }
        }
        else if constexpr ((PHM & 16) && ph == 4) {
#ifndef NO_RET
            for (int i = 0; i < 2; ++i) { const int bh = bx >> 2, pp = bx & 3, p = i == 0 ? pp : 7 - pp;
                ret_unit(bh >> 2, bh & 3, p, (const bf16*)(ws + WS_Q), (const bf16*)(ws + WS_K), (const bf16*)(ws + WS_VT), (const bf16*)(ws + WS_G), ap->in[8], MRG, lds, tid, wave, lane); }
#endif
#ifndef NO_LRU
            lru_unit(bx >> 4, (bx >> 2) & 3, bx & 3, (const bf16*)(ws + WS_G), (const bf16*)(ws + WS_WLRU), ap->in[9], ap->in[10], ap->in[12], ap->in[14], ap->in[15], MRG, lds, tid, wave, lane);
#endif
        }
        else if constexpr ((PHM & 32) && ph == 10) {
            if (wave < 4) { const int unit = bx * 4 + wave; s5_unit(unit >> 6, unit & 63, ap, X, SSP, MRG, lds + wave * S5_WLDS, lane); }
        }
        else if constexpr ((PHM & 64) && ph == 11) {
            pg8::Gemm g{MRG, (const bf16*)(ws + WS_WGLU), TOK, 2048, D}; pg8::StaticOrder S; S.init(TOK, 2048, G_, bx);
            pg8::EpiGluResid E{X, X, XB, SSP};
            pg8::gemm_phase<pg8::EpiGluResid, pg8::StaticOrder, true, true>(lds, g, S, E, tid);
        }
        else if constexpr ((PHM & 128) && ph == 14) {
            const float* gf = ap->in[26];
            for (int m = gw; m < TOK; m += NGW) { const float rs = row_rs(SSP, 16, m); f32x4* xr = (f32x4*)(X + (size_t)m * D) + lane; const f32x4* gr = (const f32x4*)gf + lane;
#pragma unroll
                for (int j = 0; j < 4; ++j) xr[64 * j] = xr[64 * j] * rs * gr[64 * j]; }
        }
}
__global__ void __launch_bounds__(NWAVES * 64, 2) mega_fwd(Args a_) {
    extern __shared__ __attribute__((aligned(16))) unsigned char lds_raw[];
    LAS unsigned char* lds = (LAS unsigned char*)lds_raw;
    cg::grid_group grid = cg::this_grid();
    const int ph_lo = a_.ph_lo, ph_hi = a_.ph_hi;
    const int wave = __builtin_amdgcn_readfirstlane((int)(threadIdx.x >> 6));
    volatile LAS unsigned* bst = (volatile LAS unsigned*)(lds + 131072 + 4000);
    { const int t0 = wave * 64 + lane_id(); if (t0 < 2) bst[t0] = 0u; }
    __syncthreads();
    XcdBarrier bar = xcd_barrier_post((unsigned*)a_.ws, bst, wave * 64 + lane_id());
    if (ph_hi - ph_lo > 1) grid.sync();
#define SEAM(k) xcd_barrier(bar, wave * 64 + lane_id())
#define PHASE(k) if (ph_lo <= (k) && (k) < ph_hi) { if ((PROBE_DUPM >> (k)) & 1) { phase_body<k>(lds, wave); xcd_barrier(bar, wave * 64 + lane_id()); } phase_body<k>(lds, wave); if ((k) + 1 < ph_hi) SEAM(k); }
    PHASE(0) PHASE(1) PHASE(2) PHASE(3) PHASE(4) PHASE(5) PHASE(6) PHASE(7) PHASE(8) PHASE(9) PHASE(10) PHASE(11) PHASE(12) PHASE(13) PHASE(14)
#undef PHASE
#undef SEAM
}

extern "C" void kernel_launch(void* const* d_in, const int* in_sizes, int n_in, void* d_out, int out_size, void* d_ws, size_t ws_size, hipStream_t stream) {
    static int grid = 0;
    if (grid == 0) {
        if (n_in != 27 || in_sizes[0] != TOK * D || out_size != TOK * D || ws_size < WS_END) { fprintf(stderr, "kernel_launch: unexpected shapes (n_in %d, in0 %d, out %d, ws %zu)\n", n_in, n_in > 0 ? in_sizes[0] : -1, out_size, ws_size); grid = -1; return; }
        int dev = 0, cus = 0, per_cu = 0;
        (void)hipGetDevice(&dev); (void)hipDeviceGetAttribute(&cus, hipDeviceAttributeMultiprocessorCount, dev);
        if (hipFuncSetAttribute((const void*)mega_fwd, hipFuncAttributeMaxDynamicSharedMemorySize, LDS_BYTES) != hipSuccess) { fprintf(stderr, "kernel_launch: hipFuncSetAttribute failed\n"); grid = -1; return; }
        if (hipOccupancyMaxActiveBlocksPerMultiprocessor(&per_cu, (const void*)mega_fwd, NWAVES * 64, LDS_BYTES) != hipSuccess || per_cu < 1) { fprintf(stderr, "kernel_launch: occupancy query says %d blocks per CU\n", per_cu); per_cu = 1; }
        (void)hipGetLastError();
        grid = cus * 1;
    }
    if (grid < 0) return;
    (void)hipMemsetAsync(d_ws, 0, 16384, stream);
    Args a{};
    for (int i = 0; i < 27; ++i) a.in[i] = (const float*)d_in[i];
    a.out = (float*)d_out; a.ws = (unsigned char*)d_ws;
#if MK_PER_PHASE
    for (int ph = 0; ph < NPH; ++ph) { a.ph_lo = ph; a.ph_hi = ph + 1; hipLaunchKernelGGL(mega_fwd, dim3(grid), dim3(NWAVES * 64), LDS_BYTES, stream, a); }
#else
    a.ph_lo = 0; a.ph_hi = NPH;
    void* params[] = {&a};
    const hipError_t e = hipLaunchCooperativeKernel((const void*)mega_fwd, dim3(grid), dim3(NWAVES * 64), params, LDS_BYTES, stream);
    if (e != hipSuccess) fprintf(stderr, "kernel_launch: cooperative launch failed: %s (grid %d)\n", hipGetErrorString(e), grid);
#endif
}
```

```cpp
#include <hip/hip_runtime.h>
#include <hip/hip_cooperative_groups.h>
#include <cstdio>
#include <cstdint>
#include <cmath>
namespace cg = cooperative_groups;
namespace pg8 {
#define PG8_LAS __attribute__((address_space(3)))
typedef unsigned short bf16_t;
typedef short bf16x8 __attribute__((ext_vector_type(8)));
typedef float f32x4 __attribute__((ext_vector_type(4)));
typedef unsigned u32x4 __attribute__((ext_vector_type(4)));
constexpr int BM = 256, BK = 64, HALF = 128, HTB = HALF * BK * 2  , STAGE_BYTES = 8 * HTB, NXCD = 8, WGM = 8;

__host__ __device__ __forceinline__ int lds_byte(int r, int c) { const int st = (r >> 4) * 2 + (c >> 5), rr = r & 15, cc = c & 31, ob = rr * 64 + cc * 2; return st * 1024 + (ob ^ (((ob >> 9) & 1) << 5)); }
__host__ __device__ __forceinline__ void stage_rc(int b, int& R, int& C) { const int st = b / 1024, sb = b % 1024, swz = sb ^ (((sb >> 9) & 1) << 5); R = (st >> 1) * 16 + swz / 64; C = (st & 1) * 32 + (swz % 64) / 2; }
__host__ __device__ __forceinline__ int perm32(int rho) { const int n = rho >> 4, i = rho & 15; return 8 * (i >> 2) + 4 * n + (i & 3); }

struct Unit { int pm, pn; };
struct Gemm { const bf16_t* A; const bf16_t* Bt; int M, N, K; };

struct StaticOrder {
    int nM, nN, nwg, G, c;
    __host__ __device__ void init(int M, int N, int G_, int c_) { nM = M / BM; nN = N / BM; nwg = nM * nN; G = G_; c = c_; }
    __host__ __device__ bool next(int i, Unit& u) const {
        const long L = (long)i * G + c; if (L >= nwg) return false;
        int wgid = (int)L; { const int q = nwg / NXCD, r = nwg % NXCD, xcd = wgid % NXCD, off = wgid / NXCD; wgid = (xcd < r ? xcd * (q + 1) : r * (q + 1) + (xcd - r) * q) + off; }
        const int nig = WGM * nN, gid = wgid / nig, fm = gid * WGM, gsz = (nM - fm) < WGM ? (nM - fm) : WGM;
        u.pm = fm + ((wgid % nig) % gsz); u.pn = (wgid % nig) / gsz; return true;
    }
    __device__ __forceinline__ void a_ready(const Unit&) const {}
    __device__ __forceinline__ void done(const Unit&) const {}
};

__device__ __forceinline__ unsigned cvt_pk_bf16(float lo, float hi) { unsigned r; asm volatile("v_cvt_pk_bf16_f32 %0, %1, %2" : "=v"(r) : "v"(lo), "v"(hi)); return r; }
__device__ __forceinline__ u32x4 pack8(const f32x4 a, const f32x4 b) { u32x4 w; w.x = cvt_pk_bf16(a[0], a[1]); w.y = cvt_pk_bf16(a[2], a[3]); w.z = cvt_pk_bf16(b[0], b[1]); w.w = cvt_pk_bf16(b[2], b[3]); return w; }
__device__ __forceinline__ float fast_rcp(float x) { return __builtin_amdgcn_rcpf(x); }
__device__ __forceinline__ float fast_exp2(float x) { return __builtin_amdgcn_exp2f(x); }
__device__ __forceinline__ float sigmoid_f(float x) { return fast_rcp(1.0f + fast_exp2(-1.4426950409f * x)); }
__device__ __forceinline__ float silu_f(float x) { return x * sigmoid_f(x); }
__device__ __forceinline__ float gelu_tanh_f(float v) { const float u = v + 0.044715f * v * v * v; return v * sigmoid_f(1.5957691216f * u); }
__device__ __forceinline__ float row_rs(const float* ssp, int nparts, int row) {
    const f32x4* p = (const f32x4*)(ssp + (size_t)row * 32); float s = 0.f;
#pragma unroll
    for (int i = 0; i < 4; ++i) { const f32x4 v = p[i]; s += (v[0] + v[1]) + (v[2] + v[3]); }
    if (nparts > 16) {
#pragma unroll
        for (int i = 4; i < 8; ++i) { const f32x4 v = p[i]; s += (v[0] + v[1]) + (v[2] + v[3]); } }
    return 1.0f / sqrtf(s * (1.0f / 1024.0f) + 1e-6f);
}
__device__ __forceinline__ void row_rs8(float (&rs)[8], const float* ssp, int nparts, int row0) {
#pragma unroll
    for (int h = 0; h < 2; ++h) {
#pragma unroll
        for (int i = 0; i < 4; ++i) rs[4 * h + i] = row_rs(ssp, nparts, row0 + h * HALF + i * 16);
        asm volatile("" : "+v"(rs[4 * h]), "+v"(rs[4 * h + 1]), "+v"(rs[4 * h + 2]), "+v"(rs[4 * h + 3]) :: "memory"); }
}

struct EpiSwiglu {
    static constexpr bool PERM = true, AFTER_DRAIN = false;
    bf16_t* O; int ldo; const float* ssp; int nparts;
    __device__ __forceinline__ void operator()(const f32x4 (&acc)[2][2][4][2], const Unit& u, int wr, int wc, int fr, int fq) const {
        const int row0 = u.pm * BM + wr * 64 + fr, col0 = u.pn * 128 + wc * 32 + 8 * fq;
        float rs8[8]; row_rs8(rs8, ssp, nparts, row0);
#pragma unroll
        for (int ai = 0; ai < 2; ++ai)
#pragma unroll
            for (int m = 0; m < 4; ++m) { const int row = row0 + ai * HALF + m * 16; const float rs = rs8[ai * 4 + m];
                f32x4 h[2];
#pragma unroll
                for (int n = 0; n < 2; ++n)
#pragma unroll
                    for (int t = 0; t < 4; ++t) { const float a = acc[ai][0][m][n][t] * rs, b = acc[ai][1][m][n][t] * rs; h[n][t] = silu_f(a) * b; }
                *(u32x4*)(O + (size_t)row * ldo + col0) = pack8(h[0], h[1]); }
    }
};
struct EpiResid {
    static constexpr bool PERM = true, AFTER_DRAIN = false;
    const float* xin; float* xout; bf16_t* xb; float* ssp; float alpha;
    __device__ __forceinline__ void operator()(const f32x4 (&acc)[2][2][4][2], const Unit& u, int wr, int wc, int fr, int fq) const {
        const int row0 = u.pm * BM + wr * 64 + fr, col0 = u.pn * BM + wc * 32 + 8 * fq;
#pragma unroll
        for (int ai = 0; ai < 2; ++ai)
#pragma unroll
            for (int m = 0; m < 4; ++m) { const int row = row0 + ai * HALF + m * 16; float ss = 0.f;
#pragma unroll
                for (int bj = 0; bj < 2; ++bj) { const size_t off = (size_t)row * 1024 + col0 + bj * HALF;
                    const f32x4 o0 = *(const f32x4*)(xin + off), o1 = *(const f32x4*)(xin + off + 4);
                    const f32x4 v0 = o0 + alpha * acc[ai][bj][m][0], v1 = o1 + alpha * acc[ai][bj][m][1];
                    *(f32x4*)(xout + off) = v0; *(f32x4*)(xout + off + 4) = v1; if (xb) *(u32x4*)(xb + off) = pack8(v0, v1);
                    ss += (v0[0] * v0[0] + v0[1] * v0[1]) + (v0[2] * v0[2] + v0[3] * v0[3]) + (v1[0] * v1[0] + v1[1] * v1[1]) + (v1[2] * v1[2] + v1[3] * v1[3]); }
                ss += __shfl_xor(ss, 16); ss += __shfl_xor(ss, 32);
                if (fq == 0) ssp[(size_t)row * 32 + 4 * u.pn + wc] = ss; if (m == 3) asm volatile("" ::: "memory"); }
    }
};
struct EpiGluResid {
    static constexpr bool PERM = true, AFTER_DRAIN = false;
    const float* xin; float* xout; bf16_t* xb; float* ssp;
    __device__ __forceinline__ void operator()(const f32x4 (&acc)[2][2][4][2], const Unit& u, int wr, int wc, int fr, int fq) const {
        const int row0 = u.pm * BM + wr * 64 + fr, col0 = u.pn * 128 + wc * 32 + 8 * fq;
#pragma unroll
        for (int ai = 0; ai < 2; ++ai)
#pragma unroll
            for (int m = 0; m < 4; ++m) { const int row = row0 + ai * HALF + m * 16; const size_t off = (size_t)row * 1024 + col0;
                const f32x4 o0 = *(const f32x4*)(xin + off), o1 = *(const f32x4*)(xin + off + 4); f32x4 v0, v1;
#pragma unroll
                for (int t = 0; t < 4; ++t) { v0[t] = o0[t] + acc[ai][0][m][0][t] * sigmoid_f(acc[ai][1][m][0][t]); v1[t] = o1[t] + acc[ai][0][m][1][t] * sigmoid_f(acc[ai][1][m][1][t]); }
                *(f32x4*)(xout + off) = v0; *(f32x4*)(xout + off + 4) = v1; *(u32x4*)(xb + off) = pack8(v0, v1);
                float ss = (v0[0] * v0[0] + v0[1] * v0[1]) + (v0[2] * v0[2] + v0[3] * v0[3]) + (v1[0] * v1[0] + v1[1] * v1[1]) + (v1[2] * v1[2] + v1[3] * v1[3]);
                ss += __shfl_xor(ss, 16); ss += __shfl_xor(ss, 32);
                if (fq == 0) ssp[(size_t)row * 32 + 4 * u.pn + wc] = ss; if (m == 3) asm volatile("" ::: "memory"); }
    }
};
struct EpiPlain {
    static constexpr bool PERM = true, AFTER_DRAIN = false;
    bf16_t* O; int ldo;
    __device__ __forceinline__ void operator()(const f32x4 (&acc)[2][2][4][2], const Unit& u, int wr, int wc, int fr, int fq) const {
        const int row0 = u.pm * BM + wr * 64 + fr, col0 = u.pn * BM + wc * 32 + 8 * fq;
#pragma unroll
        for (int ai = 0; ai < 2; ++ai)
#pragma unroll
            for (int m = 0; m < 4; ++m) { bf16_t* rowp = O + (size_t)(row0 + ai * HALF + m * 16) * ldo + col0;
#pragma unroll
                for (int bj = 0; bj < 2; ++bj) *(u32x4*)(rowp + bj * HALF) = pack8(acc[ai][bj][m][0], acc[ai][bj][m][1]); }
    }
};
__device__ __forceinline__ float lg_gamma(int h) { return h == 0 ? -0.04580368961312479f : h == 1 ? -0.02272007650008353f : h == 2 ? -0.011315313227834146f : -0.005646563141142063f; }
struct EpiRope {
    static constexpr bool PERM = true, AFTER_DRAIN = false;
    bf16_t* Q; bf16_t* K; const float* rope; const float* ssp; int nparts;
    __device__ __forceinline__ void operator()(const f32x4 (&acc)[2][2][4][2], const Unit& u, int wr, int wc, int fr, int fq) const {
        typedef unsigned u32x2 __attribute__((ext_vector_type(2)));
        const int row0 = u.pm * BM + wr * 64 + fr;
        const int head = 2 * (u.pn & 1) + (wc >> 1), jj0 = (wc & 1) * 32 + 8 * fq; bf16_t* dst = (u.pn < 2) ? Q : K;
        const float lg = lg_gamma(head);
        float rs8[8]; row_rs8(rs8, ssp, nparts, row0);
#pragma unroll
        for (int ai = 0; ai < 2; ++ai)
#pragma unroll
            for (int m = 0; m < 4; ++m) { const int row = row0 + ai * HALF + m * 16, pos = row & 2047; const float rs = rs8[4 * ai + m];
                const float sc = (u.pn < 2) ? rs * fast_exp2(lg * (float)(pos & 127)) : rs * rs * 0.08838834764831845f * fast_exp2(-lg * (float)(pos & 127));
                const f32x4* rp = (const f32x4*)(rope + ((size_t)pos * 64 + jj0) * 2);
                bf16_t* rowp = dst + (size_t)row * 512 + head * 128 + jj0;
#pragma unroll
                for (int n = 0; n < 2; ++n) { const f32x4 cs0 = rp[2 * n], cs1 = rp[2 * n + 1]; const f32x4 x1 = acc[ai][0][m][n] * sc, x2 = acc[ai][1][m][n] * sc; f32x4 o1, o2;
                    o1[0] = x1[0] * cs0[0] - x2[0] * cs0[1]; o2[0] = x1[0] * cs0[1] + x2[0] * cs0[0];
                    o1[1] = x1[1] * cs0[2] - x2[1] * cs0[3]; o2[1] = x1[1] * cs0[3] + x2[1] * cs0[2];
                    o1[2] = x1[2] * cs1[0] - x2[2] * cs1[1]; o2[2] = x1[2] * cs1[1] + x2[2] * cs1[0];
                    o1[3] = x1[3] * cs1[2] - x2[3] * cs1[3]; o2[3] = x1[3] * cs1[3] + x2[3] * cs1[2];
                    u32x2 w1, w2; w1.x = cvt_pk_bf16(o1[0], o1[1]); w1.y = cvt_pk_bf16(o1[2], o1[3]); w2.x = cvt_pk_bf16(o2[0], o2[1]); w2.y = cvt_pk_bf16(o2[2], o2[3]);
                    *(u32x2*)(rowp + 4 * n) = w1; *(u32x2*)(rowp + 64 + 4 * n) = w2; } if (m & 1) asm volatile("" ::: "memory"); }
    }
};
struct EpiScaled {
    static constexpr bool PERM = true, AFTER_DRAIN = false;
    bf16_t* O; int ldo; const float* ssp; int nparts;
    __device__ __forceinline__ void operator()(const f32x4 (&acc)[2][2][4][2], const Unit& u, int wr, int wc, int fr, int fq) const {
        const int row0 = u.pm * BM + wr * 64 + fr, col0 = u.pn * BM + wc * 32 + 8 * fq;
        float rs8[8]; row_rs8(rs8, ssp, nparts, row0);
#pragma unroll
        for (int ai = 0; ai < 2; ++ai)
#pragma unroll
            for (int m = 0; m < 4; ++m) { const int row = row0 + ai * HALF + m * 16; const float rs = rs8[4 * ai + m]; bf16_t* rowp = O + (size_t)row * ldo + col0;
#pragma unroll
                for (int bj = 0; bj < 2; ++bj) *(u32x4*)(rowp + bj * HALF) = pack8(acc[ai][bj][m][0] * rs, acc[ai][bj][m][1] * rs); }
    }
};

struct EpiNull {
    static constexpr bool PERM = true, AFTER_DRAIN = false;
    __device__ __forceinline__ void operator()(const f32x4 (&acc)[2][2][4][2], const Unit& u, int wr, int wc, int fr, int fq) const {
        float s = 0.f;
#pragma unroll
        for (int ai = 0; ai < 2; ++ai)
#pragma unroll
            for (int bj = 0; bj < 2; ++bj)
#pragma unroll
                for (int m = 0; m < 4; ++m) s += acc[ai][bj][m][0][0] + acc[ai][bj][m][1][3];
        asm volatile("" :: "v"(s));
    }
};
template <class Epi, class Sched, bool ALIGN_EPI = false, bool SP2 = false>
__device__ __forceinline__ void gemm_phase(PG8_LAS unsigned char* lds, const Gemm g, const Sched& S, const Epi& E, int tid_in) {
    int tid_ = tid_in; asm volatile("" : "+v"(tid_));
    const int tid = tid_, wid = __builtin_amdgcn_readfirstlane(tid >> 6), lane = tid & 63, wr = wid >> 2, wc = wid & 3, fr = lane & 15, fq = lane >> 4;
    const int K = g.K, nt = K / BK;
    unsigned voffA[2], voffB[2];
#pragma unroll
    for (int i = 0; i < 2; ++i) { int R, C; stage_rc(tid * 16 + i * 8192, R, C); const int Rb = Epi::PERM ? ((R & ~31) + perm32(R & 31)) : R;
        voffA[i] = (unsigned)(R * K + C) * 2u; voffB[i] = (unsigned)(Rb * K + C) * 2u; }
    const size_t kstep = (size_t)(BK * 2);
    const size_t hstep = (size_t)HALF * K * 2;
    const size_t tstep = 2 * hstep;
    const unsigned ldsw = (unsigned)wid * 1024u;
    const int aoff = lds_byte(wr * 64 + fr, fq * 8), boff = lds_byte(wc * 32 + fr, fq * 8);
#define PG8_SA(b, h) (((b) * 2 + (h)) * HTB)
#define PG8_SB(b, h) ((4 + (b) * 2 + (h)) * HTB)
#define PG8_STAGE(bufoff, gbase, voff) do { _Pragma("unroll") for (int _i = 0; _i < 2; ++_i) \
        __builtin_amdgcn_global_load_lds((const unsigned*)((const char*)(gbase) + (voff)[_i]), (PG8_LAS unsigned*)(lds + (bufoff) + ldsw + _i * 8192), 16, 0, 0); } while (0)
#define PG8_LDA(dst, b, h) do { _Pragma("unroll") for (int m = 0; m < 4; ++m) _Pragma("unroll") for (int k = 0; k < 2; ++k) dst[m][k] = *(const PG8_LAS bf16x8*)(lds + PG8_SA(b, h) + aoff + m * 2048 + k * 1024); } while (0)
#define PG8_LDB(dst, b, h) do { _Pragma("unroll") for (int n = 0; n < 2; ++n) _Pragma("unroll") for (int k = 0; k < 2; ++k) dst[n][k] = *(const PG8_LAS bf16x8*)(lds + PG8_SB(b, h) + boff + n * 2048 + k * 1024); } while (0)
#define PG8_MMA(ai, bj, At, Bt) do { __builtin_amdgcn_s_setprio(1); _Pragma("unroll") for (int m = 0; m < 4; ++m) _Pragma("unroll") for (int n = 0; n < 2; ++n) _Pragma("unroll") for (int k = 0; k < 2; ++k) \
        acc[ai][bj][m][n] = __builtin_amdgcn_mfma_f32_16x16x32_bf16(Bt[n][k], At[m][k], acc[ai][bj][m][n], 0, 0, 0); __builtin_amdgcn_s_setprio(0); } while (0)
#define PG8_WAIT_V(n) asm volatile("s_waitcnt vmcnt(" #n ")" ::: "memory")
#define PG8_WAIT_L(n) asm volatile("s_waitcnt lgkmcnt(" #n ")" ::: "memory")
#define PG8_BAR __builtin_amdgcn_s_barrier()
#define PG8_SCHED __builtin_amdgcn_sched_barrier(0)
    Unit cur, nxt; int ui = 0;
    if (!S.next(0, cur)) return;
    f32x4 acc[2][2][4][2];
#pragma unroll
    for (int a = 0; a < 2; ++a)
#pragma unroll
        for (int b = 0; b < 2; ++b)
#pragma unroll
            for (int m = 0; m < 4; ++m)
#pragma unroll
                for (int n = 0; n < 2; ++n) acc[a][b][m][n] = (f32x4){0.f, 0.f, 0.f, 0.f};
    bf16x8 At[4][2], B0[2][2], B1[2][2];
    const char* cA = (const char*)g.A + (size_t)cur.pm * tstep; const char* cB = (const char*)g.Bt + (size_t)cur.pn * tstep;
    S.a_ready(cur);
    if constexpr (SP2) {
        PG8_STAGE(PG8_SB(0, 0), cB, voffB); PG8_STAGE(PG8_SB(0, 1), cB + hstep, voffB); PG8_STAGE(PG8_SA(0, 0), cA, voffA); PG8_STAGE(PG8_SA(0, 1), cA + hstep, voffA);
        if (wr == 1) PG8_BAR;
        PG8_WAIT_V(2); PG8_BAR;
        PG8_STAGE(PG8_SB(1, 0), cB + kstep, voffB); PG8_STAGE(PG8_SA(1, 0), cA + kstep, voffA); PG8_STAGE(PG8_SB(1, 1), cB + hstep + kstep, voffB);
        PG8_WAIT_V(6); PG8_BAR;
    } else {
        PG8_STAGE(PG8_SB(0, 0), cB, voffB); PG8_STAGE(PG8_SA(0, 0), cA, voffA); PG8_STAGE(PG8_SB(0, 1), cB + hstep, voffB); PG8_STAGE(PG8_SA(0, 1), cA + hstep, voffA);
        if (wr == 1) PG8_BAR;
        PG8_WAIT_V(4); PG8_BAR;
        PG8_STAGE(PG8_SB(1, 0), cB + kstep, voffB); PG8_STAGE(PG8_SA(1, 0), cA + kstep, voffA); PG8_STAGE(PG8_SB(1, 1), cB + hstep + kstep, voffB);
        PG8_WAIT_V(6); PG8_BAR;
    }
    for (;;) {
        const bool has_next = S.next(ui + 1, nxt);
        const char* nA = has_next ? (const char*)g.A + (size_t)nxt.pm * tstep : cA; const char* nB = has_next ? (const char*)g.Bt + (size_t)nxt.pn * tstep : cB;
        for (int t = 0; t < nt; t += 2) {
            const bool last = (t == nt - 2);
            const char* a1 = cA + (size_t)(t + 1) * kstep;
            const char* a2 = last ? nA : cA + (size_t)(t + 2) * kstep; const char* b2 = last ? nB : cB + (size_t)(t + 2) * kstep;
            const char* a3 = a2 + kstep; const char* b3 = b2 + kstep;
            if (last && has_next) S.a_ready(nxt);
            if constexpr (SP2) {
            PG8_LDB(B0, 0, 0); PG8_LDB(B1, 0, 1); PG8_SCHED; PG8_LDA(At, 0, 0); PG8_STAGE(PG8_SA(1, 1), a1 + hstep, voffA);
            PG8_WAIT_V(8); PG8_WAIT_L(0); PG8_BAR; PG8_MMA(0, 0, At, B0); PG8_MMA(0, 1, At, B1); PG8_BAR; PG8_SCHED;
            PG8_LDA(At, 0, 1); PG8_STAGE(PG8_SB(0, 0), b2, voffB); PG8_STAGE(PG8_SB(0, 1), b2 + hstep, voffB); PG8_STAGE(PG8_SA(0, 0), a2, voffA);
            PG8_WAIT_V(8); PG8_WAIT_L(0); PG8_BAR; PG8_MMA(1, 0, At, B0); PG8_MMA(1, 1, At, B1); PG8_BAR; PG8_SCHED;
            PG8_LDB(B0, 1, 0); PG8_LDB(B1, 1, 1); PG8_SCHED; PG8_LDA(At, 1, 0); PG8_STAGE(PG8_SA(0, 1), a2 + hstep, voffA);
            PG8_WAIT_V(8); PG8_WAIT_L(0); PG8_BAR; PG8_MMA(0, 0, At, B0); PG8_MMA(0, 1, At, B1); PG8_BAR; PG8_SCHED;
            PG8_LDA(At, 1, 1); PG8_STAGE(PG8_SB(1, 0), b3, voffB); PG8_STAGE(PG8_SB(1, 1), b3 + hstep, voffB); PG8_STAGE(PG8_SA(1, 0), a3, voffA);
            PG8_WAIT_V(8); PG8_WAIT_L(0); PG8_BAR; PG8_MMA(1, 0, At, B0); PG8_MMA(1, 1, At, B1); PG8_BAR; PG8_SCHED;
            } else {
            PG8_LDB(B0, 0, 0); PG8_SCHED; PG8_LDA(At, 0, 0); PG8_STAGE(PG8_SA(1, 1), a1 + hstep, voffA);
            PG8_WAIT_L(8); PG8_BAR; PG8_WAIT_L(0); PG8_MMA(0, 0, At, B0); PG8_BAR; PG8_SCHED;
            PG8_LDB(B1, 0, 1); PG8_STAGE(PG8_SB(0, 0), b2, voffB);
            PG8_BAR; PG8_WAIT_L(0); PG8_MMA(0, 1, At, B1); PG8_BAR;
            PG8_LDA(At, 0, 1); PG8_STAGE(PG8_SA(0, 0), a2, voffA);
            PG8_BAR; PG8_WAIT_L(0); PG8_MMA(1, 0, At, B0); PG8_BAR; PG8_SCHED;
            PG8_STAGE(PG8_SB(0, 1), b2 + hstep, voffB);
            PG8_WAIT_V(6); PG8_BAR; PG8_MMA(1, 1, At, B1); PG8_BAR;
            PG8_LDB(B0, 1, 0); PG8_SCHED; PG8_LDA(At, 1, 0); PG8_STAGE(PG8_SA(0, 1), a2 + hstep, voffA);
            PG8_WAIT_L(8); PG8_BAR; PG8_WAIT_L(0); PG8_MMA(0, 0, At, B0); PG8_BAR; PG8_SCHED;
            PG8_LDB(B1, 1, 1); PG8_STAGE(PG8_SB(1, 0), b3, voffB);
            PG8_BAR; PG8_WAIT_L(0); PG8_MMA(0, 1, At, B1); PG8_BAR;
            PG8_LDA(At, 1, 1); PG8_STAGE(PG8_SA(1, 0), a3, voffA);
            PG8_BAR; PG8_WAIT_L(0); PG8_MMA(1, 0, At, B0); PG8_BAR; PG8_SCHED;
            PG8_STAGE(PG8_SB(1, 1), b3 + hstep, voffB);
            PG8_WAIT_V(6); PG8_BAR; PG8_MMA(1, 1, At, B1); PG8_BAR;
            }
        }
        if constexpr (ALIGN_EPI) { if (wr == 0) PG8_BAR; }
        if constexpr (!Epi::AFTER_DRAIN) { E(acc, cur, wr, wc, fr, fq); S.done(cur); }
        if (!has_next) break;
#pragma unroll
        for (int a = 0; a < 2; ++a)
#pragma unroll
            for (int b = 0; b < 2; ++b)
#pragma unroll
                for (int m = 0; m < 4; ++m)
#pragma unroll
                    for (int n = 0; n < 2; ++n) acc[a][b][m][n] = (f32x4){0.f, 0.f, 0.f, 0.f};
        cur = nxt; cA = nA; cB = nB; ++ui;
        if constexpr (ALIGN_EPI) { if (wr == 1) PG8_BAR; }
    }
    PG8_WAIT_V(0);
    if constexpr (!ALIGN_EPI) { if (wr == 0) PG8_BAR; }
    PG8_BAR;
    if constexpr (Epi::AFTER_DRAIN) { E.fused(acc, cur, wr, wc, fr, fq, lds, wid, lane); S.done(cur); }
#undef PG8_SA
#undef PG8_SB
#undef PG8_STAGE
#undef PG8_LDA
#undef PG8_LDB
#undef PG8_MMA
#undef PG8_WAIT_V
#undef PG8_WAIT_L
#undef PG8_BAR
#undef PG8_SCHED
}
}

#define GAS __attribute__((address_space(1)))
#define LAS __attribute__((address_space(3)))
typedef unsigned short bf16;
typedef unsigned v4u __attribute__((ext_vector_type(4)));
typedef unsigned v2u __attribute__((ext_vector_type(2)));
typedef float f32x4 __attribute__((ext_vector_type(4)));
typedef float f32x2 __attribute__((ext_vector_type(2)));
typedef float f32x16 __attribute__((ext_vector_type(16)));
typedef short bf16x8 __attribute__((ext_vector_type(8)));
#define LDS_WAIT() asm volatile("s_waitcnt lgkmcnt(0)" ::: "memory")
using pg8::cvt_pk_bf16; using pg8::pack8; using pg8::sigmoid_f; using pg8::silu_f; using pg8::gelu_tanh_f; using pg8::row_rs; using pg8::fast_exp2;

#ifndef PHM
#define PHM 255
#endif
#ifndef PROBE_NULLM
#define PROBE_NULLM 0
#endif
#ifndef PROBE_DUPM
#define PROBE_DUPM 0
#endif
#ifndef MK_PER_PHASE
#define MK_PER_PHASE 0
#endif
constexpr int NWAVES = 8;
constexpr int BATCH = 16, SEQ = 2048, D = 1024, FF = 2816, TOK = BATCH * SEQ;
constexpr int NPH = 15;
constexpr size_t MiB = 1u << 20;
constexpr size_t WS_W13 = 1 * MiB;
constexpr size_t WS_W2 = 45 * MiB;
constexpr size_t WS_WIN = 67 * MiB;
constexpr size_t WS_WV = 72 * MiB;
constexpr size_t WS_WOUT = 73 * MiB;
constexpr size_t WS_WGLU = 75 * MiB;
constexpr size_t WS_WLRU = 79 * MiB;
constexpr size_t WS_ROPE = 80 * MiB;
constexpr size_t WS_SSP = 81 * MiB;
constexpr size_t WS_XB = 96 * MiB;
constexpr size_t WS_R1 = 160 * MiB;
constexpr size_t WS_Q = WS_R1, WS_K = WS_R1 + 32 * MiB, WS_VT = WS_R1 + 64 * MiB, WS_G = WS_R1 + 97 * MiB;
constexpr int VT_LD = TOK + 64;
constexpr size_t WS_MRG = 354 * MiB;
constexpr size_t WS_END = 418 * MiB;
constexpr int LDS_BYTES = 135168;

__device__ __forceinline__ unsigned f2bf(float f) { unsigned u = __builtin_bit_cast(unsigned, f); return (u + 0x7fffu + ((u >> 16) & 1u)) >> 16; }
__device__ __forceinline__ unsigned pk2(float lo, float hi) { return f2bf(lo) | (f2bf(hi) << 16); }
__device__ __forceinline__ float bf_lo(unsigned w) { return __builtin_bit_cast(float, w << 16); }
__device__ __forceinline__ float bf_hi(unsigned w) { return __builtin_bit_cast(float, w & 0xffff0000u); }
__device__ __forceinline__ float bf1(bf16 h) { return __builtin_bit_cast(float, (unsigned)h << 16); }
__device__ __forceinline__ float wave_sum(float v) {
#pragma unroll
    for (int o = 1; o < 64; o <<= 1) v += __shfl_xor(v, o);
    return v;
}
__device__ __forceinline__ f32x4 mfma16(bf16x8 a, bf16x8 b, f32x4 c) { return __builtin_amdgcn_mfma_f32_16x16x32_bf16(a, b, c, 0, 0, 0); }

__device__ __forceinline__ void transpose_item(const float* __restrict__ W, int N, int K, const float* __restrict__ gk, bf16* WT, int dst_row, int k0, int n0, LAS float* scr, int lane) {
#pragma unroll 16
    for (int i = 0; i < 32; ++i) { const int kk = 2 * i + (lane >> 5); float v = W[(size_t)(k0 + kk) * N + n0 + (lane & 31)]; if (gk) v *= gk[k0 + kk]; scr[kk * 33 + (lane & 31)] = v; }
    LDS_WAIT(); asm volatile("" ::: "memory");
    const int c = lane & 7;
#pragma unroll
    for (int j = 0; j < 4; ++j) { const int n = (lane >> 3) + 8 * j; const LAS float* s = scr + (8 * c) * 33 + n;
        v4u o; o.x = pk2(s[0 * 33], s[1 * 33]); o.y = pk2(s[2 * 33], s[3 * 33]); o.z = pk2(s[4 * 33], s[5 * 33]); o.w = pk2(s[6 * 33], s[7 * 33]);
        *(v4u*)(WT + (size_t)(dst_row + n) * K + k0 + 8 * c) = o; }
    LDS_WAIT(); asm volatile("" ::: "memory");
}
struct Args { const float* in[27]; float* out; unsigned char* ws; int ph_lo, ph_hi; };
typedef const __attribute__((address_space(4))) Args* KArgP;

__device__ __forceinline__ void p0_prologue(KArgP ap, LAS unsigned char* lds, int gw, int NGW, int wave, int lane) {
    LAS float* scr = (LAS float*)(lds + wave * 16384);
    unsigned char* ws = ap->ws;
    constexpr int I_F = 1408, I_IN = 1536, I_OUT = 512, I_GL = 512, I_LRU = 64;
    constexpr int NITEMS = 12 * I_F + I_IN + I_OUT + 2 * I_GL + I_LRU;
    for (int it = gw; it < NITEMS; it += NGW) {
        int r = it;
        if (r < 8 * I_F) { const int w3 = r >= 4 * I_F; if (w3) r -= 4 * I_F; const int l = r / I_F; r -= l * I_F; const int kb = r / 88, nb = r % 88, n0 = 32 * nb;
            transpose_item(ap->in[w3 ? 3 : 2] + (size_t)l * D * FF, FF, D, ap->in[1] + l * D, (bf16*)(ws + WS_W13) + (size_t)l * 5632 * 1024, 256 * (n0 >> 7) + (n0 & 127) + (w3 ? 128 : 0), 64 * kb, n0, scr, lane); continue; }
        r -= 8 * I_F;
        if (r < 4 * I_F) { const int l = r / I_F; r -= l * I_F; const int kb = r / 32, nb = r % 32;
            transpose_item(ap->in[4] + (size_t)l * FF * D, D, FF, nullptr, (bf16*)(ws + WS_W2) + (size_t)l * 1024 * FF, 32 * nb, 64 * kb, 32 * nb, scr, lane); continue; }
        r -= 4 * I_F;
        if (r < I_IN) { const int kb = r / 96, nb = r % 96, n0 = 32 * nb; bf16* dst; int drow;
            if (n0 < 1024) { const int sec = n0 >> 9, nn = n0 & 511, h = nn >> 7, bj = (nn >> 6) & 1, jj0 = nn & 63; dst = (bf16*)(ws + WS_WIN); drow = 512 * sec + 256 * (h >> 1) + 128 * bj + 64 * (h & 1) + jj0; }
            else if (n0 < 1536) { dst = (bf16*)(ws + WS_WV); drow = n0 - 1024; }
            else { dst = (bf16*)(ws + WS_WIN); drow = n0 - 512; }
            transpose_item(ap->in[6], 3072, D, ap->in[5], dst, drow, 64 * kb, n0, scr, lane); continue; }
        r -= I_IN;
        if (r < I_OUT) { const int kb = r / 32, nb = r % 32; transpose_item(ap->in[7], D, D, nullptr, (bf16*)(ws + WS_WOUT), 32 * nb, 64 * kb, 32 * nb, scr, lane); continue; }
        r -= I_OUT;
        if (r < 2 * I_GL) { const int wb = r >= I_GL; if (wb) r -= I_GL; const int kb = r / 32, nb = r % 32, n0 = 32 * nb;
            transpose_item(ap->in[wb ? 25 : 24], D, D, nullptr, (bf16*)(ws + WS_WGLU), 256 * (n0 >> 7) + (n0 & 127) + (wb ? 128 : 0), 64 * kb, n0, scr, lane); continue; }
        r -= 2 * I_GL;
        { const int mat = r >> 3, g = mat >> 1, gate = mat & 1, kb = (r >> 2) & 1, nb = r & 3;
            transpose_item(ap->in[gate ? 13 : 11] + (size_t)g * 128 * 128, 128, 128, nullptr, (bf16*)(ws + WS_WLRU) + (size_t)mat * 128 * 128, 32 * nb, 64 * kb, 32 * nb, scr, lane); }
    }
    { float* rope = (float*)(ws + WS_ROPE);
      for (int i = gw * 64 + lane; i < 2048 * 64; i += NGW * 64) { const int pos = i >> 6, j = i & 63; const double inv = pow(10000.0, -(double)j / 64.0); const double ang = (double)pos * inv;
          rope[2 * i] = (float)cos(ang); rope[2 * i + 1] = (float)sin(ang); } }
    { const float* x = ap->in[0]; bf16* xb = (bf16*)(ws + WS_XB); float* ssp = (float*)(ws + WS_SSP);
      for (int m = gw; m < TOK; m += NGW) { const f32x4* xr = (const f32x4*)(x + (size_t)m * D) + lane; f32x4 v[4]; float s = 0.f;
#pragma unroll
          for (int j = 0; j < 4; ++j) { v[j] = xr[64 * j]; s += (v[j][0] * v[j][0] + v[j][1] * v[j][1]) + (v[j][2] * v[j][2] + v[j][3] * v[j][3]); }
          s = wave_sum(s);
          v2u* o8 = (v2u*)(xb + (size_t)m * D) + lane;
#pragma unroll
          for (int j = 0; j < 4; ++j) { v2u w; w.x = cvt_pk_bf16(v[j][0], v[j][1]); w.y = cvt_pk_bf16(v[j][2], v[j][3]); o8[64 * j] = w; }
          if (lane < 16) ssp[(size_t)m * 32 + lane] = lane == 0 ? s : 0.f; } }
}

__device__ __forceinline__ void ret_unit(int b, int h, int p, const bf16* Q, const bf16* Kb, const bf16* Vt, const bf16* G, const float* ret_g, bf16* MRG, LAS unsigned char* lds, int tid, int wid, int lane) {
    const int fr = lane & 15, fq = lane >> 4;
    const int cq = 2 * p + (wid >> 2), iloc0 = 32 * (wid & 3);
    const size_t tok0 = (size_t)b * SEQ + 256 * p + 32 * wid;
    const float lg = log2f(1.0f - exp2f(-5.0f - (float)h));
    bf16x8 qf[2][4];
#pragma unroll
    for (int mi = 0; mi < 2; ++mi)
#pragma unroll
        for (int kk = 0; kk < 4; ++kk) qf[mi][kk] = *(const bf16x8*)(Q + (tok0 + 16 * mi + fr) * 512 + h * 128 + 32 * kk + 8 * fq);
    f32x4 O[2][8];
#pragma unroll
    for (int mi = 0; mi < 2; ++mi)
#pragma unroll
        for (int e = 0; e < 8; ++e) O[mi][e] = (f32x4){0.f, 0.f, 0.f, 0.f};
    const int nm = 2 * p + 2;
    const int srow = 4 * wid + (lane >> 4), keyK = ((wid >> 1) & 3) * 4 + (lane >> 4), keyV = 4 * (wid & 3) + (lane >> 4);
    const bf16* kbase = Kb + ((size_t)b * SEQ + srow) * 512 + h * 128 + 8 * ((lane & 15) ^ keyK);
    const bf16* vbase = Vt + ((size_t)(h * 128 + srow)) * VT_LD + (size_t)b * SEQ + 8 * ((lane & 15) ^ keyV);
#define RET_STAGE(m_, buf_) do { _Pragma("unroll") for (int i = 0; i < 4; ++i) { \
        __builtin_amdgcn_global_load_lds((const unsigned*)(kbase + ((size_t)(128 * (m_) + 32 * i)) * 512), (LAS unsigned*)(lds + (buf_) * 65536 + (8 * i + wid) * 1024), 16, 0, 0); \
        __builtin_amdgcn_global_load_lds((const unsigned*)(vbase + (size_t)(32 * i) * VT_LD + 128 * (m_)), (LAS unsigned*)(lds + (buf_) * 65536 + 32768 + (8 * i + wid) * 1024), 16, 0, 0); } } while (0)
    RET_STAGE(0, 0);
    asm volatile("s_waitcnt vmcnt(0)" ::: "memory"); __syncthreads();
    for (int m = 0; m < nm; ++m) {
        const int buf = m & 1;
        if (m + 1 < nm) RET_STAGE(m + 1, buf ^ 1);
        if (m <= cq) {
            const LAS unsigned char* Kl = lds + buf * 65536; const LAS unsigned char* Vl = Kl + 32768;
            const float sc = fast_exp2(lg * (float)(128 * (cq - m)));
#pragma unroll
            for (int g32 = 0; g32 < 4; ++g32) {
                f32x4 S[2][2];
#pragma unroll
                for (int n = 0; n < 2; ++n) { S[0][n] = (f32x4){0.f, 0.f, 0.f, 0.f}; S[1][n] = (f32x4){0.f, 0.f, 0.f, 0.f};
                    const int krow = 32 * g32 + 8 * (fr >> 2) + 4 * n + (fr & 3);
#pragma unroll
                    for (int kk = 0; kk < 4; ++kk) { const bf16x8 kf = *(const LAS bf16x8*)(Kl + krow * 256 + (((4 * kk + fq) ^ fr) << 4));
                        S[0][n] = mfma16(kf, qf[0][kk], S[0][n]); S[1][n] = mfma16(kf, qf[1][kk], S[1][n]); } }
                bf16x8 pf[2];
#pragma unroll
                for (int mi = 0; mi < 2; ++mi) { f32x4 v0 = S[mi][0] * sc, v1 = S[mi][1] * sc;
                    if (m == cq) { const int il = iloc0 + 16 * mi + fr, jl = 32 * g32 + 8 * fq;
#pragma unroll
                        for (int t = 0; t < 4; ++t) { v0[t] = (jl + t <= il) ? v0[t] : 0.f; v1[t] = (jl + 4 + t <= il) ? v1[t] : 0.f; } }
                    const pg8::u32x4 w = pack8(v0, v1); pf[mi] = __builtin_bit_cast(bf16x8, w); }
#pragma unroll
                for (int ef = 0; ef < 8; ++ef) { const int vrow = 16 * ef + fr;
                    const bf16x8 vf = *(const LAS bf16x8*)(Vl + vrow * 256 + (((4 * g32 + fq) ^ fr) << 4));
                    O[0][ef] = mfma16(vf, pf[0], O[0][ef]); O[1][ef] = mfma16(vf, pf[1], O[1][ef]); }
            }
        }
        asm volatile("s_waitcnt vmcnt(0)" ::: "memory"); __syncthreads();
    }
#undef RET_STAGE
#pragma unroll
    for (int mi = 0; mi < 2; ++mi) { const size_t tok = tok0 + 16 * mi + fr; float s = 0.f;
#pragma unroll
        for (int ef = 0; ef < 8; ++ef) s += (O[mi][ef][0] + O[mi][ef][1]) + (O[mi][ef][2] + O[mi][ef][3]);
        s += __shfl_xor(s, 16); s += __shfl_xor(s, 32); const float mu = s * (1.0f / 128.0f); float q = 0.f;
#pragma unroll
        for (int ef = 0; ef < 8; ++ef) { const f32x4 d = O[mi][ef] - mu; q += (d[0] * d[0] + d[1] * d[1]) + (d[2] * d[2] + d[3] * d[3]); }
        q += __shfl_xor(q, 16); q += __shfl_xor(q, 32); const float rstd = 1.0f / sqrtf(q * (1.0f / 128.0f) + 1e-6f);
#pragma unroll
        for (int ef = 0; ef < 8; ++ef) { const int col = h * 128 + 16 * ef + 4 * fq; const f32x4 gn = *(const f32x4*)(ret_g + col); const v2u gr = *(const v2u*)(G + tok * 1536 + col);
            const float g0 = bf_lo(gr.x), g1 = bf_hi(gr.x), g2 = bf_lo(gr.y), g3 = bf_hi(gr.y);
            const float y0 = (O[mi][ef][0] - mu) * rstd * gn[0] * silu_f(g0), y1 = (O[mi][ef][1] - mu) * rstd * gn[1] * silu_f(g1);
            const float y2 = (O[mi][ef][2] - mu) * rstd * gn[2] * silu_f(g2), y3 = (O[mi][ef][3] - mu) * rstd * gn[3] * silu_f(g3);
            v2u w; w.x = cvt_pk_bf16(y0, y1); w.y = cvt_pk_bf16(y2, y3); *(v2u*)(MRG + tok * 1024 + col) = w; } }
}

__device__ __forceinline__ void lru_unit(int b, int g, int q, const bf16* G, const bf16* LW, const float* conv_w, const float* conv_b, const float* b_a, const float* b_i, const float* lam,
                                         bf16* MRG, LAS unsigned char* lds, int tid, int wid, int lane) {
    const int fr = lane & 15, fq = lane >> 4;
    const bf16* wbase = LW + ((size_t)(g * 2 * 128 + 32 * q + fr)) * 128 + 8 * fq;
    LAS float* A_ = (LAS float*)lds; LAS float* BX = A_ + 8192; LAS float* SEG = BX + 8192; LAS float* CAR = SEG + 1024;
    const bf16* xl = G + (size_t)b * SEQ * 1536 + 512 + 128 * g;
    f32x4 gba[2], gbi[2], gsp[2];
#pragma unroll
    for (int nfl = 0; nfl < 2; ++nfl) { const int cg0 = 128 * g + 32 * q + 16 * nfl + 4 * fq; gba[nfl] = *(const f32x4*)(b_a + cg0); gbi[nfl] = *(const f32x4*)(b_i + cg0); const f32x4 lm = *(const f32x4*)(lam + cg0);
#pragma unroll
        for (int t = 0; t < 4; ++t) gsp[nfl][t] = -8.0f * 1.4426950408889634f * log1pf(__expf(-lm[t])); }
    for (int tile = 0; tile < 8; ++tile) {
        const int s0 = 256 * tile + 32 * wid;
        f32x4 acc[2][4];
#pragma unroll
        for (int mi = 0; mi < 2; ++mi)
#pragma unroll
            for (int nf = 0; nf < 4; ++nf) acc[mi][nf] = (f32x4){0.f, 0.f, 0.f, 0.f};
#pragma unroll 1
        for (int kk = 0; kk < 4; ++kk) { const int ch0 = 32 * kk + 8 * fq, cg0 = 128 * g + ch0;
            bf16x8 wf[4];
#pragma unroll
            for (int nf = 0; nf < 4; ++nf) wf[nf] = *(const bf16x8*)(wbase + (size_t)(((nf >> 1) * 128 + 16 * (nf & 1)) * 128 + 32 * kk));
#pragma unroll
            for (int mi = 0; mi < 2; ++mi) { const int s = s0 + 16 * mi + fr; float xc[8];
                { const f32x4 c0 = *(const f32x4*)(conv_b + cg0), c1 = *(const f32x4*)(conv_b + cg0 + 4); xc[0] = c0[0]; xc[1] = c0[1]; xc[2] = c0[2]; xc[3] = c0[3]; xc[4] = c1[0]; xc[5] = c1[1]; xc[6] = c1[2]; xc[7] = c1[3]; }
#pragma unroll
                for (int tap = 0; tap < 4; ++tap) { const int sp = s - 3 + tap; if (sp >= 0) { const v4u xv = *(const v4u*)(xl + (size_t)sp * 1536 + ch0);
                        const f32x4 w0 = *(const f32x4*)(conv_w + tap * 512 + cg0), w1 = *(const f32x4*)(conv_w + tap * 512 + cg0 + 4);
                        xc[0] += w0[0] * bf_lo(xv.x); xc[1] += w0[1] * bf_hi(xv.x); xc[2] += w0[2] * bf_lo(xv.y); xc[3] += w0[3] * bf_hi(xv.y);
                        xc[4] += w1[0] * bf_lo(xv.z); xc[5] += w1[1] * bf_hi(xv.z); xc[6] += w1[2] * bf_lo(xv.w); xc[7] += w1[3] * bf_hi(xv.w); } }
                pg8::u32x4 aw; aw.x = cvt_pk_bf16(xc[0], xc[1]); aw.y = cvt_pk_bf16(xc[2], xc[3]); aw.z = cvt_pk_bf16(xc[4], xc[5]); aw.w = cvt_pk_bf16(xc[6], xc[7]);
                const bf16x8 af = __builtin_bit_cast(bf16x8, aw);
#pragma unroll
                for (int nf = 0; nf < 4; ++nf) acc[mi][nf] = mfma16(wf[nf], af, acc[mi][nf]); } }
#pragma unroll
        for (int mi = 0; mi < 2; ++mi)
#pragma unroll
            for (int nfl = 0; nfl < 2; ++nfl) { const int cl = 32 * q + 16 * nfl + 4 * fq, cg0 = 128 * g + cl, s = s0 + 16 * mi + fr;
                f32x4 xc = *(const f32x4*)(conv_b + cg0);
#pragma unroll
                for (int tap = 0; tap < 4; ++tap) { const int sp = s - 3 + tap; if (sp >= 0) { const v2u xv = *(const v2u*)(xl + (size_t)sp * 1536 + cl); const f32x4 w0 = *(const f32x4*)(conv_w + tap * 512 + cg0);
                        xc[0] += w0[0] * bf_lo(xv.x); xc[1] += w0[1] * bf_hi(xv.x); xc[2] += w0[2] * bf_lo(xv.y); xc[3] += w0[3] * bf_hi(xv.y); } }
                f32x4 av, bv;
#pragma unroll
                for (int t = 0; t < 4; ++t) { const float r = sigmoid_f(acc[mi][nfl][t] + gba[nfl][t]), ig = sigmoid_f(acc[mi][nfl + 2][t] + gbi[nfl][t]);
                    const float a_ = fast_exp2(r * gsp[nfl][t]); av[t] = a_; bv[t] = sqrtf(fmaxf(1.0f - a_ * a_, 0.f)) * ig * xc[t]; }
                const int rt = 32 * wid + 16 * mi + fr;
                *(LAS f32x4*)(A_ + rt * 32 + 16 * nfl + 4 * fq) = av; *(LAS f32x4*)(BX + rt * 32 + 16 * nfl + 4 * fq) = bv; }
        __syncthreads();
        const int c = tid & 31, seg = tid >> 5;
        float sa[16], sb[16];
#pragma unroll
        for (int k = 0; k < 16; ++k) { sa[k] = A_[(16 * seg + k) * 32 + c]; sb[k] = BX[(16 * seg + k) * 32 + c]; }
        const size_t tokb = (size_t)b * SEQ + 256 * tile + 16 * seg;
        float gl[16];
#pragma unroll
        for (int k = 0; k < 16; ++k) gl[k] = bf1(G[(tokb + k) * 1536 + 1024 + 128 * g + 32 * q + c]);
        { float P = 1.f, hl = 0.f;
#pragma unroll
          for (int k = 0; k < 16; ++k) { hl = sa[k] * hl + sb[k]; P *= sa[k]; }
          SEG[(seg * 32 + c) * 2] = P; SEG[(seg * 32 + c) * 2 + 1] = hl; }
        __syncthreads();
        float hin = tile == 0 ? 0.f : CAR[(tile & 1) * 32 + c];
        { f32x2 sg[15];
#pragma unroll
          for (int s2 = 0; s2 < 15; ++s2) sg[s2] = *(const LAS f32x2*)(SEG + (s2 * 32 + c) * 2);
#pragma unroll
          for (int s2 = 0; s2 < 15; ++s2) if (s2 < seg) hin = sg[s2][0] * hin + sg[s2][1]; }
#pragma unroll
        for (int k = 0; k < 16; ++k) { hin = sa[k] * hin + sb[k];
            MRG[(tokb + k) * 1024 + 512 + 128 * g + 32 * q + c] = (bf16)f2bf(hin * gelu_tanh_f(gl[k])); }
        if (seg == 15) CAR[((tile + 1) & 1) * 32 + c] = hin;
        __syncthreads();
    }
}

constexpr int S5_WLDS = 27648;
__device__ __forceinline__ void s5_unit(int b, int g, KArgP ap, const float* x, const float* ssp, bf16* YS, LAS unsigned char* wl, int lane) {
    const float* lam_re = ap->in[16]; const float* lam_im = ap->in[17]; const float* log_dt = ap->in[18]; const float* b_re = ap->in[19]; const float* b_im = ap->in[20];
    const float* c_re = ap->in[21]; const float* c_im = ap->in[22]; const float* dsk = ap->in[23]; const float* gmix = ap->in[5] + D;
    LAS float* BU = (LAS float*)wl; LAS unsigned char* Hh = wl + 16384; LAS float* U = (LAS float*)(wl + 16384 + 8704);
    const float dt = __expf(log_dt[g]);
    float lr, li;
    { const float re = lam_re[g * 64 + lane], im = lam_im[g * 64 + lane], mag = __expf(re * dt); lr = mag * cosf(im * dt); li = mag * sinf(im * dt); }
    bf16x8 bfr[4];
#pragma unroll
    for (int q = 0; q < 4; ++q) { const int pp = 16 * q + ((lane & 31) >> 1), comp = lane & 1, hh = lane >> 5;
        const float re = lam_re[g * 64 + pp], im = lam_im[g * 64 + pp], mag = __expf(re * dt), lbr = mag * cosf(im * dt), lbi = mag * sinf(im * dt);
        const float den = re * re + im * im, nr = lbr - 1.0f, ni = lbi, fre = (nr * re + ni * im) / den, fim = (ni * re - nr * im) / den;
        const f32x4* pr = (const f32x4*)(b_re + ((size_t)(g * 64 + pp)) * 16 + 8 * hh); const f32x4* pi = (const f32x4*)(b_im + ((size_t)(g * 64 + pp)) * 16 + 8 * hh);
        const f32x4 r0 = pr[0], r1 = pr[1], i0 = pi[0], i1 = pi[1]; f32x4 o0, o1;
#pragma unroll
        for (int t = 0; t < 4; ++t) { o0[t] = comp ? (fre * i0[t] + fim * r0[t]) : (fre * r0[t] - fim * i0[t]); o1[t] = comp ? (fre * i1[t] + fim * r1[t]) : (fre * r1[t] - fim * i1[t]); }
        const pg8::u32x4 w = pack8(o0, o1); bfr[q] = __builtin_bit_cast(bf16x8, w); }
    bf16x8 cfr[4];
#pragma unroll
    for (int kk = 0; kk < 4; ++kk) { const int c = lane & 15, kq = lane >> 4, p0 = 16 * kk + 4 * kq;
        const f32x4 cr = *(const f32x4*)(c_re + ((size_t)(g * 16 + c)) * 64 + p0), ci = *(const f32x4*)(c_im + ((size_t)(g * 16 + c)) * 64 + p0);
        pg8::u32x4 w; w.x = cvt_pk_bf16(cr[0], -ci[0]); w.y = cvt_pk_bf16(cr[1], -ci[1]); w.z = cvt_pk_bf16(cr[2], -ci[2]); w.w = cvt_pk_bf16(cr[3], -ci[3]); cfr[kk] = __builtin_bit_cast(bf16x8, w); }
    const int tr = lane & 31, hh = lane >> 5;
    const f32x4 gm0 = *(const f32x4*)(gmix + 16 * g + 8 * hh), gm1 = *(const f32x4*)(gmix + 16 * g + 8 * hh + 4);
    const float dch = dsk[16 * g + (lane & 15)];
    float hre = 0.f, him = 0.f;
    const size_t tokb = (size_t)b * SEQ;
    f32x4 nx0, nx1; float nrs;
    { const size_t tok = tokb + tr; nx0 = *(const f32x4*)(x + tok * D + 16 * g + 8 * hh); nx1 = *(const f32x4*)(x + tok * D + 16 * g + 8 * hh + 4); nrs = row_rs(ssp, 16, (int)tok); }
    for (int blk = 0; blk < 64; ++blk) {
        f32x4 u0 = nx0 * nrs * gm0, u1 = nx1 * nrs * gm1;
        if (blk + 1 < 64) { const size_t tok = tokb + 32 * (blk + 1) + tr; nx0 = *(const f32x4*)(x + tok * D + 16 * g + 8 * hh); nx1 = *(const f32x4*)(x + tok * D + 16 * g + 8 * hh + 4); nrs = row_rs(ssp, 16, (int)tok); }
        *(LAS f32x4*)(U + tr * 16 + 8 * hh) = u0; *(LAS f32x4*)(U + tr * 16 + 8 * hh + 4) = u1;
        const pg8::u32x4 uw = pack8(u0, u1); const bf16x8 uf = __builtin_bit_cast(bf16x8, uw);
#pragma unroll
        for (int q = 0; q < 4; ++q) { f32x16 d;
#pragma unroll
            for (int r = 0; r < 16; ++r) d[r] = 0.f;
            d = __builtin_amdgcn_mfma_f32_32x32x16_bf16(uf, bfr[q], d, 0, 0, 0);
#pragma unroll
            for (int r = 0; r < 16; ++r) BU[((r & 3) + 8 * (r >> 2) + 4 * hh) * 128 + 32 * q + tr] = d[r]; }
        LDS_WAIT(); asm volatile("" ::: "memory");
        { f32x2 bu[32];
#pragma unroll
          for (int t = 0; t < 32; ++t) bu[t] = *(const LAS f32x2*)(BU + t * 128 + 2 * lane);
          LDS_WAIT(); asm volatile("" ::: "memory");
#pragma unroll
          for (int t = 0; t < 32; ++t) { const float nr = lr * hre - li * him + bu[t][0], ni = lr * him + li * hre + bu[t][1]; hre = nr; him = ni;
              *(LAS unsigned*)(Hh + t * 272 + 4 * lane) = cvt_pk_bf16(nr, ni); } }
        LDS_WAIT(); asm volatile("" ::: "memory");
        const int c = lane & 15, kq = lane >> 4;
#pragma unroll
        for (int tf = 0; tf < 2; ++tf) { f32x4 y = (f32x4){0.f, 0.f, 0.f, 0.f};
#pragma unroll
            for (int kk = 0; kk < 4; ++kk) { const bf16x8 hf = *(const LAS bf16x8*)(Hh + (16 * tf + c) * 272 + (32 * kk + 8 * kq) * 2); y = mfma16(hf, cfr[kk], y); }
#pragma unroll
            for (int r = 0; r < 4; ++r) { const int t = 16 * tf + 4 * kq + r; const float uu = U[t * 16 + c]; const float yv = y[r] + dch * uu;
                YS[(tokb + 32 * blk + t) * 1024 + 16 * g + c] = (bf16)f2bf(gelu_tanh_f(yv)); } }
        LDS_WAIT(); asm volatile("" ::: "memory");
    }
}

#define XB_TMO      128
#define XB_XCNT(j)  (256  + 64 * (j))
#define XB_XSUB(j)  (1280 + 64 * (j))
#define XB_XGEN(j)  (2304 + 64 * (j))
#define XB_TOP      3328
#define XB_TOPGEN   3392
#define XCD_BAR_WORDS 3456
#define XB_SPIN_CAP (1u << 18)

__device__ __forceinline__ unsigned xb_ld(unsigned* p)              { return __hip_atomic_load(p, __ATOMIC_RELAXED, __HIP_MEMORY_SCOPE_AGENT); }
__device__ __forceinline__ unsigned xb_add(unsigned* p, unsigned v) { return __hip_atomic_fetch_add(p, v, __ATOMIC_RELAXED, __HIP_MEMORY_SCOPE_AGENT); }
__device__ __forceinline__ unsigned xb_xcc_id() { return (unsigned)__builtin_amdgcn_s_getreg((3 << 11) | 20) & 0xFu; }
#define XB_SPIN(cond, bar) do { unsigned _sp = 0; while (cond) { __builtin_amdgcn_s_sleep(1); \
    if ((++_sp & 255u) == 0u) { if (xb_ld(&(bar)[XB_TMO])) break; if (_sp > XB_SPIN_CAP) { atomicAdd(&(bar)[XB_TMO], 1u); break; } } } } while (0)

struct XcdBarrier {
    unsigned* bar; unsigned x;
    volatile LAS unsigned* st;
};

__device__ __forceinline__ XcdBarrier xcd_barrier_post(unsigned* bar, volatile LAS unsigned* st, int tid) {
    XcdBarrier b; b.bar = bar; b.x = xb_xcc_id(); b.st = st;
    if (tid == 0) (void)xb_add(&bar[XB_XCNT(b.x)], 1u);
    return b;
}
__device__ __forceinline__ void xcd_barrier_complete(unsigned* bar, unsigned x, unsigned& nloc, unsigned& nx) {
    const unsigned G = gridDim.x * gridDim.y * gridDim.z;
    unsigned sum, cnt, mine, sp = 0u;
    for (;;) {
        sum = 0u; cnt = 0u; mine = 0u;
#pragma unroll
        for (unsigned j = 0; j < 16; ++j) { const unsigned c = xb_ld(&bar[XB_XCNT(j)]); sum += c; cnt += (c > 0u) ? 1u : 0u; mine = (j == x) ? c : mine; }
        if (sum == G) break;
        __builtin_amdgcn_s_sleep(1);
        if ((++sp & 255u) == 0u) { if (xb_ld(&bar[XB_TMO])) break; if (sp > XB_SPIN_CAP) { atomicAdd(&bar[XB_TMO], 1u); break; } }
    }
    nloc = mine > 0u ? mine : 1u; nx = cnt > 0u ? cnt : 1u;
}

__device__ __forceinline__ void xcd_barrier(const XcdBarrier& b, int tid) {
    asm volatile("s_waitcnt vmcnt(0)" ::: "memory");
    __syncthreads();
    if (tid == 0) {
        unsigned* bar = b.bar;
        __builtin_amdgcn_s_waitcnt(0);
        unsigned nloc = b.st[0], nx = b.st[1];
        if (nloc == 0u) { xcd_barrier_complete(bar, b.x, nloc, nx); b.st[0] = nloc; b.st[1] = nx; }
        const unsigned old = xb_add(&bar[XB_XSUB(b.x)], 1u);
        const unsigned gen = old / nloc;
        if (old + 1u == (gen + 1u) * nloc) {
            __builtin_amdgcn_fence(__ATOMIC_RELEASE, "agent");
            asm volatile("s_waitcnt vmcnt(0)" ::: "memory");
            const unsigned og = xb_add(&bar[XB_TOP], 1u);
            const unsigned tg = og / nx;
            if (og + 1u == (tg + 1u) * nx) xb_add(&bar[XB_TOPGEN], 1u);
            else XB_SPIN(xb_ld(&bar[XB_TOPGEN]) == tg, bar);
            __builtin_amdgcn_fence(__ATOMIC_ACQUIRE, "agent");
            xb_add(&bar[XB_XGEN(b.x)], 1u);
            asm volatile("s_waitcnt vmcnt(0)" ::: "memory");
        } else {
            XB_SPIN(xb_ld(&bar[XB_XGEN(b.x)]) == gen, bar);
            __builtin_amdgcn_fence(__ATOMIC_ACQUIRE, "agent");
            asm volatile("s_waitcnt vmcnt(0)" ::: "memory");
        }
    }
    __syncthreads();
}

__device__ __forceinline__ int lane_id() { return (int)__builtin_amdgcn_mbcnt_hi(~0u, __builtin_amdgcn_mbcnt_lo(~0u, 0u)); }
struct HotOrder {
    int c;
    __device__ bool next(int i, pg8::Unit& u) const { if (i >= 11) return false; u.pm = c & 3; u.pn = (c >> 2) & 1; return true; }
    __device__ __forceinline__ void a_ready(const pg8::Unit&) const {}
    __device__ __forceinline__ void done(const pg8::Unit&) const {}
};
template <int ph> __device__ __forceinline__ void phase_body(LAS unsigned char* lds, int wave) {
    int lane_ = lane_id(); asm volatile("" : "+v"(lane_));
    const int lane = lane_, tid = wave * 64 + lane;
    const int G_ = gridDim.x, bx = blockIdx.x;
    const int gw = bx * NWAVES + wave, NGW = G_ * NWAVES;
    KArgP ap = (KArgP)__builtin_amdgcn_kernarg_segment_ptr(); asm volatile("" : "+s"(ap));
    unsigned char* ws = ap->ws;
    float* X = ap->out;
    bf16* XB = (bf16*)(ws + WS_XB); float* SSP = (float*)(ws + WS_SSP); bf16* HID = (bf16*)(ws + WS_R1); bf16* MRG = (bf16*)(ws + WS_MRG);
    (void)gw; (void)NGW; (void)lane; (void)X; (void)XB; (void)SSP; (void)HID; (void)MRG;
        if constexpr (ph == 0 && (PHM & 1)) { p0_prologue(ap, lds, gw, NGW, wave, lane); }
        else if constexpr ((PHM & 2) && (ph == 1 || ph == 6 || ph == 8 || ph == 12)) {
            const int l = ph == 1 ? 0 : ph == 6 ? 1 : ph == 8 ? 2 : 3;
            if constexpr (ph == 1 && (PROBE_NULLM & 4)) { pg8::Gemm g{XB, (const bf16*)(ws + WS_W13), TOK, 5632, D}; HotOrder S; S.c = bx; pg8::EpiNull E; pg8::gemm_phase<pg8::EpiNull, HotOrder, true, true>(lds, g, S, E, tid); }
            if constexpr (ph == 1 && (PROBE_NULLM & 1)) { pg8::Gemm g{XB, (const bf16*)(ws + WS_W13), TOK, 5632, D}; pg8::StaticOrder S; S.init(TOK, 5632, G_, bx); pg8::EpiNull E; pg8::gemm_phase<pg8::EpiNull, pg8::StaticOrder, true, true>(lds, g, S, E, tid); }
            pg8::Gemm g{XB, (const bf16*)(ws + WS_W13) + (size_t)l * 5632 * 1024, TOK, 5632, D}; pg8::StaticOrder S; S.init(TOK, 5632, G_, bx);
            pg8::EpiSwiglu E{HID, FF, SSP, ph == 12 ? 32 : 16};
            pg8::gemm_phase<pg8::EpiSwiglu, pg8::StaticOrder, true, true>(lds, g, S, E, tid);
        }
        else if constexpr ((PHM & 4) && (ph == 2 || ph == 7 || ph == 9 || ph == 13 || ph == 5)) {
            const int l = ph == 2 ? 0 : ph == 7 ? 1 : ph == 9 ? 2 : 3;
            pg8::Gemm g; g.M = TOK; g.N = D;
            if (ph == 5) { g.A = MRG; g.Bt = (const bf16*)(ws + WS_WOUT); g.K = D; } else { g.A = HID; g.Bt = (const bf16*)(ws + WS_W2) + (size_t)l * 1024 * FF; g.K = FF; }
            pg8::StaticOrder S; S.init(TOK, D, G_, bx);
            if constexpr (ph == 7 && (PROBE_NULLM & 2)) { pg8::EpiNull E0; pg8::gemm_phase<pg8::EpiNull, pg8::StaticOrder, true, true>(lds, g, S, E0, tid); }
            pg8::EpiResid E{ph == 2 ? ap->in[0] : X, X, (ph == 9 || ph == 13) ? nullptr : XB, SSP, ph == 5 ? 1.0f : 0.5f};
            pg8::gemm_phase<pg8::EpiResid, pg8::StaticOrder, true, true>(lds, g, S, E, tid);
        }
        else if constexpr ((PHM & 8) && ph == 3) {
            { pg8::Gemm g{XB, (const bf16*)(ws + WS_WIN), TOK, 1024, D}; pg8::StaticOrder S; S.init(TOK, 1024, G_, bx);
              pg8::EpiRope E{(bf16*)(ws + WS_Q), (bf16*)(ws + WS_K), (const float*)(ws + WS_ROPE), SSP, 16};
              pg8::gemm_phase<pg8::EpiRope, pg8::StaticOrder, true, true>(lds, g, S, E, tid); }
            { pg8::Gemm g{XB, (const bf16*)(ws + WS_WIN) + (size_t)1024 * 1024, TOK, 1536, D}; pg8::StaticOrder S; S.init(TOK, 1536, G_, bx);
              pg8::EpiScaled E{(bf16*)(ws + WS_G), 1536, SSP, 16};
              pg8::gemm_phase<pg8::EpiScaled, pg8::StaticOrder, true, true>(lds, g, S, E, tid); }
            { pg8::Gemm g{(const bf16*)(ws + WS_WV), XB, 512, TOK, D}; pg8::StaticOrder S; S.init(512, TOK, G_, bx);
              pg8::EpiPlain E{(bf16*)(ws + WS_VT), VT_LD};
              pg8::gemm_phase<pg8::EpiPlain, pg8::StaticOrder, true, true>(lds, g, S, E, tid); }
        }
        else if constexpr ((PHM & 16) && ph == 4) {
#ifndef NO_RET
            for (int i = 0; i < 2; ++i) { const int bh = bx >> 2, pp = bx & 3, p = i == 0 ? pp : 7 - pp;
                ret_unit(bh >> 2, bh & 3, p, (const bf16*)(ws + WS_Q), (const bf16*)(ws + WS_K), (const bf16*)(ws + WS_VT), (const bf16*)(ws + WS_G), ap->in[8], MRG, lds, tid, wave, lane); }
#endif
#ifndef NO_LRU
            lru_unit(bx >> 4, (bx >> 2) & 3, bx & 3, (const bf16*)(ws + WS_G), (const bf16*)(ws + WS_WLRU), ap->in[9], ap->in[10], ap->in[12], ap->in[14], ap->in[15], MRG, lds, tid, wave, lane);
#endif
        }
        else if constexpr ((PHM & 32) && ph == 10) {
            if (wave < 4) { const int unit = bx * 4 + wave; s5_unit(unit >> 6, unit & 63, ap, X, SSP, MRG, lds + wave * S5_WLDS, lane); }
        }
        else if constexpr ((PHM & 64) && ph == 11) {
            pg8::Gemm g{MRG, (const bf16*)(ws + WS_WGLU), TOK, 2048, D}; pg8::StaticOrder S; S.init(TOK, 2048, G_, bx);
            pg8::EpiGluResid E{X, X, XB, SSP};
            pg8::gemm_phase<pg8::EpiGluResid, pg8::StaticOrder, true, true>(lds, g, S, E, tid);
        }
        else if constexpr ((PHM & 128) && ph == 14) {
            const float* gf = ap->in[26];
            for (int m = gw; m < TOK; m += NGW) { const float rs = row_rs(SSP, 16, m); f32x4* xr = (f32x4*)(X + (size_t)m * D) + lane; const f32x4* gr = (const f32x4*)gf + lane;
#pragma unroll
                for (int j = 0; j < 4; ++j) xr[64 * j] = xr[64 * j] * rs * gr[64 * j]; }
        }
}
__global__ void __launch_bounds__(NWAVES * 64, 2) mega_fwd(Args a_) {
    extern __shared__ __attribute__((aligned(16))) unsigned char lds_raw[];
    LAS unsigned char* lds = (LAS unsigned char*)lds_raw;
    cg::grid_group grid = cg::this_grid();
    const int ph_lo = a_.ph_lo, ph_hi = a_.ph_hi;
    const int wave = __builtin_amdgcn_readfirstlane((int)(threadIdx.x >> 6));
    volatile LAS unsigned* bst = (volatile LAS unsigned*)(lds + 131072 + 4000);
    { const int t0 = wave * 64 + lane_id(); if (t0 < 2) bst[t0] = 0u; }
    __syncthreads();
    XcdBarrier bar = xcd_barrier_post((unsigned*)a_.ws, bst, wave * 64 + lane_id());
    if (ph_hi - ph_lo > 1) grid.sync();
#define SEAM(k) xcd_barrier(bar, wave * 64 + lane_id())
#define PHASE(k) if (ph_lo <= (k) && (k) < ph_hi) { if ((PROBE_DUPM >> (k)) & 1) { phase_body<k>(lds, wave); xcd_barrier(bar, wave * 64 + lane_id()); } phase_body<k>(lds, wave); if ((k) + 1 < ph_hi) SEAM(k); }
    PHASE(0) PHASE(1) PHASE(2) PHASE(3) PHASE(4) PHASE(5) PHASE(6) PHASE(7) PHASE(8) PHASE(9) PHASE(10) PHASE(11) PHASE(12) PHASE(13) PHASE(14)
#undef PHASE
#undef SEAM
}

extern "C" void kernel_launch(void* const* d_in, const int* in_sizes, int n_in, void* d_out, int out_size, void* d_ws, size_t ws_size, hipStream_t stream) {
    static int grid = 0;
    if (grid == 0) {
        if (n_in != 27 || in_sizes[0] != TOK * D || out_size != TOK * D || ws_size < WS_END) { fprintf(stderr, "kernel_launch: unexpected shapes (n_in %d, in0 %d, out %d, ws %zu)\n", n_in, n_in > 0 ? in_sizes[0] : -1, out_size, ws_size); grid = -1; return; }
        int dev = 0, cus = 0, per_cu = 0;
        (void)hipGetDevice(&dev); (void)hipDeviceGetAttribute(&cus, hipDeviceAttributeMultiprocessorCount, dev);
        if (hipFuncSetAttribute((const void*)mega_fwd, hipFuncAttributeMaxDynamicSharedMemorySize, LDS_BYTES) != hipSuccess) { fprintf(stderr, "kernel_launch: hipFuncSetAttribute failed\n"); grid = -1; return; }
        if (hipOccupancyMaxActiveBlocksPerMultiprocessor(&per_cu, (const void*)mega_fwd, NWAVES * 64, LDS_BYTES) != hipSuccess || per_cu < 1) { fprintf(stderr, "kernel_launch: occupancy query says %d blocks per CU\n", per_cu); per_cu = 1; }
        (void)hipGetLastError();
        grid = cus * 1;
    }
    if (grid < 0) return;
    (void)hipMemsetAsync(d_ws, 0, 16384, stream);
    Args a{};
    for (int i = 0; i < 27; ++i) a.in[i] = (const float*)d_in[i];
    a.out = (float*)d_out; a.ws = (unsigned char*)d_ws;
#if MK_PER_PHASE
    for (int ph = 0; ph < NPH; ++ph) { a.ph_lo = ph; a.ph_hi = ph + 1; hipLaunchKernelGGL(mega_fwd, dim3(grid), dim3(NWAVES * 64), LDS_BYTES, stream, a); }
#else
    a.ph_lo = 0; a.ph_hi = NPH;
    void* params[] = {&a};
    const hipError_t e = hipLaunchCooperativeKernel((const void*)mega_fwd, dim3(grid), dim3(NWAVES * 64), params, LDS_BYTES, stream);
    if (e != hipSuccess) fprintf(stderr, "kernel_launch: cooperative launch failed: %s (grid %d)\n", hipGetErrorString(e), grid);
#endif
}
```

```cpp
#include <hip/hip_runtime.h>
#include <hip/hip_cooperative_groups.h>
#include <cstdio>
#include <cstdint>
#include <cmath>
namespace cg = cooperative_groups;
namespace pg8 {
#define PG8_LAS __attribute__((address_space(3)))
typedef unsigned short bf16_t;
typedef short bf16x8 __attribute__((ext_vector_type(8)));
typedef float f32x4 __attribute__((ext_vector_type(4)));
typedef unsigned u32x4 __attribute__((ext_vector_type(4)));
constexpr int BM = 256, BK = 64, HALF = 128, HTB = HALF * BK * 2  , STAGE_BYTES = 8 * HTB, NXCD = 8, WGM = 8;

__host__ __device__ __forceinline__ int lds_byte(int r, int c) { const int st = (r >> 4) * 2 + (c >> 5), rr = r & 15, cc = c & 31, ob = rr * 64 + cc * 2; return st * 1024 + (ob ^ (((ob >> 9) & 1) << 5)); }
__host__ __device__ __forceinline__ void stage_rc(int b, int& R, int& C) { const int st = b / 1024, sb = b % 1024, swz = sb ^ (((sb >> 9) & 1) << 5); R = (st >> 1) * 16 + swz / 64; C = (st & 1) * 32 + (swz % 64) / 2; }
__host__ __device__ __forceinline__ int perm32(int rho) { const int n = rho >> 4, i = rho & 15; return 8 * (i >> 2) + 4 * n + (i & 3); }

struct Unit { int pm, pn; };
struct Gemm { const bf16_t* A; const bf16_t* Bt; int M, N, K; };

struct StaticOrder {
    int nM, nN, nwg, G, c, nx;
    __host__ __device__ void init(int M, int N, int G_, int c_, int nx_ = NXCD) { nM = M / BM; nN = N / BM; nwg = nM * nN; G = G_; c = c_; nx = nx_; }
    __host__ __device__ bool next(int i, Unit& u) const {
        const long L = (long)i * G + c; if (L >= nwg) return false;
        int wgid = (int)L; { const int q = nwg / nx, r = nwg % nx, xcd = wgid % nx, off = wgid / nx; wgid = (xcd < r ? xcd * (q + 1) : r * (q + 1) + (xcd - r) * q) + off; }
        const int nig = WGM * nN, gid = wgid / nig, fm = gid * WGM, gsz = (nM - fm) < WGM ? (nM - fm) : WGM;
        u.pm = fm + ((wgid % nig) % gsz); u.pn = (wgid % nig) / gsz; return true;
    }
    __device__ __forceinline__ void a_ready(const Unit&) const {}
    __device__ __forceinline__ void done(const Unit&) const {}
};

__device__ __forceinline__ unsigned cvt_pk_bf16(float lo, float hi) { unsigned r; asm volatile("v_cvt_pk_bf16_f32 %0, %1, %2" : "=v"(r) : "v"(lo), "v"(hi)); return r; }
__device__ __forceinline__ u32x4 pack8(const f32x4 a, const f32x4 b) { u32x4 w; w.x = cvt_pk_bf16(a[0], a[1]); w.y = cvt_pk_bf16(a[2], a[3]); w.z = cvt_pk_bf16(b[0], b[1]); w.w = cvt_pk_bf16(b[2], b[3]); return w; }
__device__ __forceinline__ float fast_rcp(float x) { return __builtin_amdgcn_rcpf(x); }
__device__ __forceinline__ float fast_exp2(float x) { return __builtin_amdgcn_exp2f(x); }
__device__ __forceinline__ float sigmoid_f(float x) { return fast_rcp(1.0f + fast_exp2(-1.4426950409f * x)); }
__device__ __forceinline__ float silu_f(float x) { return x * sigmoid_f(x); }
__device__ __forceinline__ float gelu_tanh_f(float v) { const float u = v + 0.044715f * v * v * v; return v * sigmoid_f(1.5957691216f * u); }
__device__ __forceinline__ float row_rs(const float* ssp, int nparts, int row) {
    const f32x4* p = (const f32x4*)(ssp + (size_t)row * 32); float s = 0.f;
#pragma unroll
    for (int i = 0; i < 4; ++i) { const f32x4 v = p[i]; s += (v[0] + v[1]) + (v[2] + v[3]); }
    if (nparts > 16) {
#pragma unroll
        for (int i = 4; i < 8; ++i) { const f32x4 v = p[i]; s += (v[0] + v[1]) + (v[2] + v[3]); } }
    return 1.0f / sqrtf(s * (1.0f / 1024.0f) + 1e-6f);
}
__device__ __forceinline__ void row_rs8(float (&rs)[8], const float* ssp, int nparts, int row0) {
#pragma unroll
    for (int h = 0; h < 2; ++h) {
#pragma unroll
        for (int i = 0; i < 4; ++i) rs[4 * h + i] = row_rs(ssp, nparts, row0 + h * HALF + i * 16);
        asm volatile("" : "+v"(rs[4 * h]), "+v"(rs[4 * h + 1]), "+v"(rs[4 * h + 2]), "+v"(rs[4 * h + 3]) :: "memory"); }
}

typedef float f32x2 __attribute__((ext_vector_type(2)));
__device__ __forceinline__ f32x2 swiglu_pk(f32x2 a, f32x2 b) {
    const f32x2 s = a * -1.4426950409f; f32x2 e; e.x = fast_exp2(s.x); e.y = fast_exp2(s.y);
    const f32x2 d = e + 1.0f; f32x2 r; r.x = fast_rcp(d.x); r.y = fast_rcp(d.y);
    return (a * r) * b;
}
struct EpiSwiglu {
    static constexpr bool PERM = true, AFTER_DRAIN = false;
    bf16_t* O; int ldo; const PG8_LAS float* rs_tab; int pmA, pmB;
    __device__ __forceinline__ void operator()(const f32x4 (&acc)[2][2][4][2], const Unit& u, int wr, int wc, int fr, int fq) const {
        const int row0 = u.pm * BM + wr * 64 + fr, col0 = u.pn * 128 + wc * 32 + 8 * fq;
        const PG8_LAS float* rt = rs_tab + (u.pm == pmA ? 0 : (u.pm == pmB ? 256 : 512)) + wr * 64 + fr;
#pragma unroll
        for (int ai = 0; ai < 2; ++ai)
#pragma unroll
            for (int m = 0; m < 4; ++m) { const int row = row0 + ai * HALF + m * 16; const float rs = rt[ai * HALF + m * 16];
                f32x4 h[2];
#pragma unroll
                for (int n = 0; n < 2; ++n) { const f32x4 a4 = acc[ai][0][m][n] * rs, b4 = acc[ai][1][m][n] * rs;
                    const f32x2 h0 = swiglu_pk((f32x2){a4[0], a4[1]}, (f32x2){b4[0], b4[1]}), h1 = swiglu_pk((f32x2){a4[2], a4[3]}, (f32x2){b4[2], b4[3]});
                    h[n] = (f32x4){h0.x, h0.y, h1.x, h1.y}; }
                *(u32x4*)(O + (size_t)row * ldo + col0) = pack8(h[0], h[1]); }
    }
};
__device__ __forceinline__ f32x4 up_lo(unsigned a, unsigned b) { f32x4 r; r[0] = __builtin_bit_cast(float, a << 16); r[1] = __builtin_bit_cast(float, a & 0xffff0000u); r[2] = __builtin_bit_cast(float, b << 16); r[3] = __builtin_bit_cast(float, b & 0xffff0000u); return r; }
#ifndef RESID_LO
#define RESID_LO 0
#endif
__device__ __forceinline__ void split_store(bf16_t* xhi, bf16_t* xlo, size_t off, const f32x4 v0, const f32x4 v1) {
    const u32x4 hw = pack8(v0, v1); *(u32x4*)(xhi + off) = hw;
    if (RESID_LO) { const f32x4 r0 = v0 - up_lo(hw.x, hw.y), r1 = v1 - up_lo(hw.z, hw.w); *(u32x4*)(xlo + off) = pack8(r0, r1); }
}
__device__ __forceinline__ void split_load(const bf16_t* xhi, const bf16_t* xlo, size_t off, f32x4& o0, f32x4& o1) {
    const u32x4 h = *(const u32x4*)(xhi + off); o0 = up_lo(h.x, h.y); o1 = up_lo(h.z, h.w);
    if (RESID_LO) { const u32x4 l = *(const u32x4*)(xlo + off); o0 += up_lo(l.x, l.y); o1 += up_lo(l.z, l.w); }
}
struct EpiResid {
    static constexpr bool PERM = true, AFTER_DRAIN = false;
    const float* xin_f32; bf16_t* xhi; bf16_t* xlo; float* ssp; float alpha;
    __device__ __forceinline__ void operator()(const f32x4 (&acc)[2][2][4][2], const Unit& u, int wr, int wc, int fr, int fq) const {
        const int row0 = u.pm * BM + wr * 64 + fr, col0 = u.pn * BM + wc * 32 + 8 * fq;
#pragma unroll
        for (int ai = 0; ai < 2; ++ai)
#pragma unroll
            for (int m = 0; m < 4; ++m) { const int row = row0 + ai * HALF + m * 16; float ss = 0.f;
#pragma unroll
                for (int bj = 0; bj < 2; ++bj) { const size_t off = (size_t)row * 1024 + col0 + bj * HALF; f32x4 o0, o1;
                    if (xin_f32) { o0 = *(const f32x4*)(xin_f32 + off); o1 = *(const f32x4*)(xin_f32 + off + 4); }
                    else split_load(xhi, xlo, off, o0, o1);
                    const f32x4 v0 = o0 + alpha * acc[ai][bj][m][0], v1 = o1 + alpha * acc[ai][bj][m][1];
                    split_store(xhi, xlo, off, v0, v1);
                    ss += (v0[0] * v0[0] + v0[1] * v0[1]) + (v0[2] * v0[2] + v0[3] * v0[3]) + (v1[0] * v1[0] + v1[1] * v1[1]) + (v1[2] * v1[2] + v1[3] * v1[3]); }
                ss += __shfl_xor(ss, 16); ss += __shfl_xor(ss, 32);
                if (fq == 0) ssp[(size_t)row * 32 + 4 * u.pn + wc] = ss; }
    }
};
struct EpiGluResid {
    static constexpr bool PERM = true, AFTER_DRAIN = false;
    bf16_t* xhi; bf16_t* xlo; float* ssp;
    __device__ __forceinline__ void operator()(const f32x4 (&acc)[2][2][4][2], const Unit& u, int wr, int wc, int fr, int fq) const {
        const int row0 = u.pm * BM + wr * 64 + fr, col0 = u.pn * 128 + wc * 32 + 8 * fq;
#pragma unroll
        for (int ai = 0; ai < 2; ++ai)
#pragma unroll
            for (int m = 0; m < 4; ++m) { const int row = row0 + ai * HALF + m * 16; const size_t off = (size_t)row * 1024 + col0;
                f32x4 o0, o1; split_load(xhi, xlo, off, o0, o1); f32x4 v0, v1;
#pragma unroll
                for (int t = 0; t < 4; ++t) { v0[t] = o0[t] + acc[ai][0][m][0][t] * sigmoid_f(acc[ai][1][m][0][t]); v1[t] = o1[t] + acc[ai][0][m][1][t] * sigmoid_f(acc[ai][1][m][1][t]); }
                split_store(xhi, xlo, off, v0, v1);
                float ss = (v0[0] * v0[0] + v0[1] * v0[1]) + (v0[2] * v0[2] + v0[3] * v0[3]) + (v1[0] * v1[0] + v1[1] * v1[1]) + (v1[2] * v1[2] + v1[3] * v1[3]);
                ss += __shfl_xor(ss, 16); ss += __shfl_xor(ss, 32);
                if (fq == 0) ssp[(size_t)row * 32 + 4 * u.pn + wc] = ss; }
    }
};
struct EpiPlain {
    static constexpr bool PERM = true, AFTER_DRAIN = false;
    bf16_t* O; int ldo;
    __device__ __forceinline__ void operator()(const f32x4 (&acc)[2][2][4][2], const Unit& u, int wr, int wc, int fr, int fq) const {
        const int row0 = u.pm * BM + wr * 64 + fr, col0 = u.pn * BM + wc * 32 + 8 * fq;
#pragma unroll
        for (int ai = 0; ai < 2; ++ai)
#pragma unroll
            for (int m = 0; m < 4; ++m) { bf16_t* rowp = O + (size_t)(row0 + ai * HALF + m * 16) * ldo + col0;
#pragma unroll
                for (int bj = 0; bj < 2; ++bj) *(u32x4*)(rowp + bj * HALF) = pack8(acc[ai][bj][m][0], acc[ai][bj][m][1]); }
    }
};
__device__ __forceinline__ float lg_gamma(int h) { return h == 0 ? -0.04580368961312479f : h == 1 ? -0.02272007650008353f : h == 2 ? -0.011315313227834146f : -0.005646563141142063f; }
struct EpiRope {
    static constexpr bool PERM = true, AFTER_DRAIN = false;
    bf16_t* Q; bf16_t* K; const float* rope; const float* ssp; int nparts; PG8_LAS f32x4* rs_lds; mutable int last_pm;
    __device__ __forceinline__ void operator()(const f32x4 (&acc)[2][2][4][2], const Unit& u, int wr, int wc, int fr, int fq) const {
        typedef unsigned u32x2 __attribute__((ext_vector_type(2)));
        const int row0 = u.pm * BM + wr * 64 + fr;
        const int head = 2 * (u.pn & 1) + (wc >> 1), jj0 = (wc & 1) * 32 + 8 * fq; bf16_t* dst = (u.pn < 2) ? Q : K;
        const float lg = lg_gamma(head);
        float rs8[8];
        if (u.pm != last_pm) { row_rs8(rs8, ssp, nparts, row0); rs_lds[0] = (f32x4){rs8[0], rs8[1], rs8[2], rs8[3]}; rs_lds[1] = (f32x4){rs8[4], rs8[5], rs8[6], rs8[7]}; last_pm = u.pm; }
        else { const f32x4 r0 = rs_lds[0], r1 = rs_lds[1]; rs8[0] = r0[0]; rs8[1] = r0[1]; rs8[2] = r0[2]; rs8[3] = r0[3]; rs8[4] = r1[0]; rs8[5] = r1[1]; rs8[6] = r1[2]; rs8[7] = r1[3]; }
#pragma unroll
        for (int ai = 0; ai < 2; ++ai)
#pragma unroll
            for (int m = 0; m < 4; ++m) { const int row = row0 + ai * HALF + m * 16, pos = row & 2047; const float rs = rs8[4 * ai + m];
                const float sc = (u.pn < 2) ? rs * fast_exp2(lg * (float)(pos & 127)) : rs * rs * 0.08838834764831845f * fast_exp2(-lg * (float)(pos & 127));
                const f32x4* rp = (const f32x4*)(rope + ((size_t)pos * 64 + jj0) * 2);
                bf16_t* rowp = dst + (size_t)row * 512 + head * 128 + jj0;
#pragma unroll
                for (int n = 0; n < 2; ++n) { const f32x4 cs0 = rp[2 * n], cs1 = rp[2 * n + 1]; const f32x4 x1 = acc[ai][0][m][n] * sc, x2 = acc[ai][1][m][n] * sc; f32x4 o1, o2;
                    o1[0] = x1[0] * cs0[0] - x2[0] * cs0[1]; o2[0] = x1[0] * cs0[1] + x2[0] * cs0[0];
                    o1[1] = x1[1] * cs0[2] - x2[1] * cs0[3]; o2[1] = x1[1] * cs0[3] + x2[1] * cs0[2];
                    o1[2] = x1[2] * cs1[0] - x2[2] * cs1[1]; o2[2] = x1[2] * cs1[1] + x2[2] * cs1[0];
                    o1[3] = x1[3] * cs1[2] - x2[3] * cs1[3]; o2[3] = x1[3] * cs1[3] + x2[3] * cs1[2];
                    u32x2 w1, w2; w1.x = cvt_pk_bf16(o1[0], o1[1]); w1.y = cvt_pk_bf16(o1[2], o1[3]); w2.x = cvt_pk_bf16(o2[0], o2[1]); w2.y = cvt_pk_bf16(o2[2], o2[3]);
                    *(u32x2*)(rowp + 4 * n) = w1; *(u32x2*)(rowp + 64 + 4 * n) = w2; } if (m == 3) asm volatile("" ::: "memory"); }
    }
};
struct EpiScaled {
    static constexpr bool PERM = true, AFTER_DRAIN = false;
    bf16_t* O; int ldo; const float* ssp; int nparts; PG8_LAS f32x4* rs_lds; mutable int last_pm;
    __device__ __forceinline__ void operator()(const f32x4 (&acc)[2][2][4][2], const Unit& u, int wr, int wc, int fr, int fq) const {
        const int row0 = u.pm * BM + wr * 64 + fr, col0 = u.pn * BM + wc * 32 + 8 * fq;
        float rs8[8];
        if (u.pm != last_pm) { row_rs8(rs8, ssp, nparts, row0); rs_lds[0] = (f32x4){rs8[0], rs8[1], rs8[2], rs8[3]}; rs_lds[1] = (f32x4){rs8[4], rs8[5], rs8[6], rs8[7]}; last_pm = u.pm; }
        else { const f32x4 r0 = rs_lds[0], r1 = rs_lds[1]; rs8[0] = r0[0]; rs8[1] = r0[1]; rs8[2] = r0[2]; rs8[3] = r0[3]; rs8[4] = r1[0]; rs8[5] = r1[1]; rs8[6] = r1[2]; rs8[7] = r1[3]; }
#pragma unroll
        for (int ai = 0; ai < 2; ++ai)
#pragma unroll
            for (int m = 0; m < 4; ++m) { const int row = row0 + ai * HALF + m * 16; const float rs = rs8[4 * ai + m]; bf16_t* rowp = O + (size_t)row * ldo + col0;
#pragma unroll
                for (int bj = 0; bj < 2; ++bj) *(u32x4*)(rowp + bj * HALF) = pack8(acc[ai][bj][m][0] * rs, acc[ai][bj][m][1] * rs); }
    }
};

struct EpiNull {
    static constexpr bool PERM = true, AFTER_DRAIN = false;
    __device__ __forceinline__ void operator()(const f32x4 (&acc)[2][2][4][2], const Unit& u, int wr, int wc, int fr, int fq) const {
        float s = 0.f;
#pragma unroll
        for (int ai = 0; ai < 2; ++ai)
#pragma unroll
            for (int bj = 0; bj < 2; ++bj)
#pragma unroll
                for (int m = 0; m < 4; ++m) s += acc[ai][bj][m][0][0] + acc[ai][bj][m][1][3];
        asm volatile("" :: "v"(s));
    }
};

template <class Epi, class Sched, bool ALIGN_EPI = false, bool SP2 = false>
__device__ __forceinline__ void gemm_phase(PG8_LAS unsigned char* lds, const Gemm g, const Sched& S, const Epi& E, int tid_in) {
    int tid_ = tid_in; asm volatile("" : "+v"(tid_));
    const int tid = tid_, wid = __builtin_amdgcn_readfirstlane(tid >> 6), lane = tid & 63, wr = wid >> 2, wc = wid & 3, fr = lane & 15, fq = lane >> 4;
    const int K = g.K, nt = K / BK;
    unsigned voffA[2], voffB[2];
#pragma unroll
    for (int i = 0; i < 2; ++i) { int R, C; stage_rc(tid * 16 + i * 8192, R, C); const int Rb = Epi::PERM ? ((R & ~31) + perm32(R & 31)) : R;
        voffA[i] = (unsigned)(R * K + C) * 2u; voffB[i] = (unsigned)(Rb * K + C) * 2u; }
    const size_t kstep = (size_t)(BK * 2);
    const size_t hstep = (size_t)HALF * K * 2;
    const size_t tstep = 2 * hstep;
    const unsigned ldsw = (unsigned)wid * 1024u;
    const int aoff = lds_byte(wr * 64 + fr, fq * 8), boff = lds_byte(wc * 32 + fr, fq * 8);
#define PG8_SA(b, h) (((b) * 2 + (h)) * HTB)
#define PG8_SB(b, h) ((4 + (b) * 2 + (h)) * HTB)
#define PG8_STAGE(bufoff, gbase, voff) do { _Pragma("unroll") for (int _i = 0; _i < 2; ++_i) \
        __builtin_amdgcn_global_load_lds((const unsigned*)((const char*)(gbase) + (voff)[_i]), (PG8_LAS unsigned*)(lds + (bufoff) + ldsw + _i * 8192), 16, 0, 0); } while (0)
#define PG8_LDA(dst, b, h) do { _Pragma("unroll") for (int m = 0; m < 4; ++m) _Pragma("unroll") for (int k = 0; k < 2; ++k) dst[m][k] = *(const PG8_LAS bf16x8*)(lds + PG8_SA(b, h) + aoff + m * 2048 + k * 1024); } while (0)
#define PG8_LDB(dst, b, h) do { _Pragma("unroll") for (int n = 0; n < 2; ++n) _Pragma("unroll") for (int k = 0; k < 2; ++k) dst[n][k] = *(const PG8_LAS bf16x8*)(lds + PG8_SB(b, h) + boff + n * 2048 + k * 1024); } while (0)
#define PG8_MMA(ai, bj, At, Bt) do { __builtin_amdgcn_s_setprio(1); _Pragma("unroll") for (int m = 0; m < 4; ++m) _Pragma("unroll") for (int n = 0; n < 2; ++n) _Pragma("unroll") for (int k = 0; k < 2; ++k) \
        acc[ai][bj][m][n] = __builtin_amdgcn_mfma_f32_16x16x32_bf16(Bt[n][k], At[m][k], acc[ai][bj][m][n], 0, 0, 0); __builtin_amdgcn_s_setprio(0); } while (0)
#define PG8_WAIT_V(n) asm volatile("s_waitcnt vmcnt(" #n ")" ::: "memory")
#define PG8_WAIT_L(n) asm volatile("s_waitcnt lgkmcnt(" #n ")" ::: "memory")
#define PG8_BAR __builtin_amdgcn_s_barrier()
#define PG8_SCHED __builtin_amdgcn_sched_barrier(0)
    Unit cur, nxt; int ui = 0;
    if (!S.next(0, cur)) return;
    f32x4 acc[2][2][4][2];
#pragma unroll
    for (int a = 0; a < 2; ++a)
#pragma unroll
        for (int b = 0; b < 2; ++b)
#pragma unroll
            for (int m = 0; m < 4; ++m)
#pragma unroll
                for (int n = 0; n < 2; ++n) acc[a][b][m][n] = (f32x4){0.f, 0.f, 0.f, 0.f};
    bf16x8 At[4][2], B0[2][2], B1[2][2];
    const char* cA = (const char*)g.A + (size_t)cur.pm * tstep; const char* cB = (const char*)g.Bt + (size_t)cur.pn * tstep;
    S.a_ready(cur);
    if constexpr (SP2) {
        PG8_STAGE(PG8_SB(0, 0), cB, voffB); PG8_STAGE(PG8_SB(0, 1), cB + hstep, voffB); PG8_STAGE(PG8_SA(0, 0), cA, voffA); PG8_STAGE(PG8_SA(0, 1), cA + hstep, voffA);
        if (wr == 1) PG8_BAR;
        PG8_WAIT_V(2); PG8_BAR;
        PG8_STAGE(PG8_SB(1, 0), cB + kstep, voffB); PG8_STAGE(PG8_SA(1, 0), cA + kstep, voffA); PG8_STAGE(PG8_SB(1, 1), cB + hstep + kstep, voffB);
        PG8_WAIT_V(6); PG8_BAR;
    } else {
        PG8_STAGE(PG8_SB(0, 0), cB, voffB); PG8_STAGE(PG8_SA(0, 0), cA, voffA); PG8_STAGE(PG8_SB(0, 1), cB + hstep, voffB); PG8_STAGE(PG8_SA(0, 1), cA + hstep, voffA);
        if (wr == 1) PG8_BAR;
        PG8_WAIT_V(4); PG8_BAR;
        PG8_STAGE(PG8_SB(1, 0), cB + kstep, voffB); PG8_STAGE(PG8_SA(1, 0), cA + kstep, voffA); PG8_STAGE(PG8_SB(1, 1), cB + hstep + kstep, voffB);
        PG8_WAIT_V(6); PG8_BAR;
    }
    for (;;) {
        const bool has_next = S.next(ui + 1, nxt);
        const char* nA = has_next ? (const char*)g.A + (size_t)nxt.pm * tstep : cA; const char* nB = has_next ? (const char*)g.Bt + (size_t)nxt.pn * tstep : cB;
        for (int t = 0; t < nt; t += 2) {
            const bool last = (t == nt - 2);
            const char* a1 = cA + (size_t)(t + 1) * kstep;
            const char* a2 = last ? nA : cA + (size_t)(t + 2) * kstep; const char* b2 = last ? nB : cB + (size_t)(t + 2) * kstep;
            const char* a3 = a2 + kstep; const char* b3 = b2 + kstep;
            if (last && has_next) S.a_ready(nxt);
            if constexpr (SP2) {
            PG8_LDB(B0, 0, 0); PG8_LDB(B1, 0, 1); PG8_SCHED; PG8_LDA(At, 0, 0); PG8_STAGE(PG8_SA(1, 1), a1 + hstep, voffA);
            PG8_WAIT_V(8); PG8_WAIT_L(0); PG8_BAR; PG8_MMA(0, 0, At, B0); PG8_MMA(0, 1, At, B1); PG8_BAR; PG8_SCHED;
            PG8_LDA(At, 0, 1); PG8_STAGE(PG8_SB(0, 0), b2, voffB); PG8_STAGE(PG8_SB(0, 1), b2 + hstep, voffB); PG8_STAGE(PG8_SA(0, 0), a2, voffA);
            PG8_WAIT_V(8); PG8_WAIT_L(0); PG8_BAR; PG8_MMA(1, 0, At, B0); PG8_MMA(1, 1, At, B1); PG8_BAR; PG8_SCHED;
            PG8_LDB(B0, 1, 0); PG8_LDB(B1, 1, 1); PG8_SCHED; PG8_LDA(At, 1, 0); PG8_STAGE(PG8_SA(0, 1), a2 + hstep, voffA);
            PG8_WAIT_V(8); PG8_WAIT_L(0); PG8_BAR; PG8_MMA(0, 0, At, B0); PG8_MMA(0, 1, At, B1); PG8_BAR; PG8_SCHED;
            PG8_LDA(At, 1, 1); PG8_STAGE(PG8_SB(1, 0), b3, voffB); PG8_STAGE(PG8_SB(1, 1), b3 + hstep, voffB); PG8_STAGE(PG8_SA(1, 0), a3, voffA);
            PG8_WAIT_V(8); PG8_WAIT_L(0); PG8_BAR; PG8_MMA(1, 0, At, B0); PG8_MMA(1, 1, At, B1); PG8_BAR; PG8_SCHED;
            } else {
            PG8_LDB(B0, 0, 0); PG8_SCHED; PG8_LDA(At, 0, 0); PG8_STAGE(PG8_SA(1, 1), a1 + hstep, voffA);
            PG8_WAIT_L(8); PG8_BAR; PG8_WAIT_L(0); PG8_MMA(0, 0, At, B0); PG8_BAR; PG8_SCHED;
            PG8_LDB(B1, 0, 1); PG8_STAGE(PG8_SB(0, 0), b2, voffB);
            PG8_BAR; PG8_WAIT_L(0); PG8_MMA(0, 1, At, B1); PG8_BAR;
            PG8_LDA(At, 0, 1); PG8_STAGE(PG8_SA(0, 0), a2, voffA);
            PG8_BAR; PG8_WAIT_L(0); PG8_MMA(1, 0, At, B0); PG8_BAR; PG8_SCHED;
            PG8_STAGE(PG8_SB(0, 1), b2 + hstep, voffB);
            PG8_WAIT_V(6); PG8_BAR; PG8_MMA(1, 1, At, B1); PG8_BAR;
            PG8_LDB(B0, 1, 0); PG8_SCHED; PG8_LDA(At, 1, 0); PG8_STAGE(PG8_SA(0, 1), a2 + hstep, voffA);
            PG8_WAIT_L(8); PG8_BAR; PG8_WAIT_L(0); PG8_MMA(0, 0, At, B0); PG8_BAR; PG8_SCHED;
            PG8_LDB(B1, 1, 1); PG8_STAGE(PG8_SB(1, 0), b3, voffB);
            PG8_BAR; PG8_WAIT_L(0); PG8_MMA(0, 1, At, B1); PG8_BAR;
            PG8_LDA(At, 1, 1); PG8_STAGE(PG8_SA(1, 0), a3, voffA);
            PG8_BAR; PG8_WAIT_L(0); PG8_MMA(1, 0, At, B0); PG8_BAR; PG8_SCHED;
            PG8_STAGE(PG8_SB(1, 1), b3 + hstep, voffB);
            PG8_WAIT_V(6); PG8_BAR; PG8_MMA(1, 1, At, B1); PG8_BAR;
            }
        }
        if constexpr (ALIGN_EPI) { if (wr == 0) PG8_BAR; }
        if constexpr (!Epi::AFTER_DRAIN) { E(acc, cur, wr, wc, fr, fq); S.done(cur); }
        if (!has_next) break;
#pragma unroll
        for (int a = 0; a < 2; ++a)
#pragma unroll
            for (int b = 0; b < 2; ++b)
#pragma unroll
                for (int m = 0; m < 4; ++m)
#pragma unroll
                    for (int n = 0; n < 2; ++n) acc[a][b][m][n] = (f32x4){0.f, 0.f, 0.f, 0.f};
        cur = nxt; cA = nA; cB = nB; ++ui;
        if constexpr (ALIGN_EPI) { if (wr == 1) PG8_BAR; }
    }
    PG8_WAIT_V(0);
    if constexpr (!ALIGN_EPI) { if (wr == 0) PG8_BAR; }
    PG8_BAR;
    if constexpr (Epi::AFTER_DRAIN) { E.fused(acc, cur, wr, wc, fr, fq, lds, wid, lane); S.done(cur); }
#undef PG8_SA
#undef PG8_SB
#undef PG8_STAGE
#undef PG8_LDA
#undef PG8_LDB
#undef PG8_MMA
#undef PG8_WAIT_V
#undef PG8_WAIT_L
#undef PG8_BAR
#undef PG8_SCHED
}
}

#define GAS __attribute__((address_space(1)))
#define LAS __attribute__((address_space(3)))
typedef unsigned short bf16;
typedef unsigned v4u __attribute__((ext_vector_type(4)));
typedef unsigned v2u __attribute__((ext_vector_type(2)));
typedef float f32x4 __attribute__((ext_vector_type(4)));
typedef float f32x2 __attribute__((ext_vector_type(2)));
typedef float f32x16 __attribute__((ext_vector_type(16)));
typedef short bf16x8 __attribute__((ext_vector_type(8)));
#define LDS_WAIT() asm volatile("s_waitcnt lgkmcnt(0)" ::: "memory")
using pg8::cvt_pk_bf16; using pg8::pack8; using pg8::sigmoid_f; using pg8::silu_f; using pg8::gelu_tanh_f; using pg8::row_rs; using pg8::fast_exp2;

#ifndef PHM
#define PHM 255
#endif
#ifndef PROBE_NULLM
#define PROBE_NULLM 0
#endif
#ifndef PROBE_MIXM
#define PROBE_MIXM 0
#endif
#ifndef SKEW_TICKS
#define SKEW_TICKS 0ull
#endif
#ifndef LATE_IN_S5
#define LATE_IN_S5 0
#endif
#ifndef PROBE_DUPM
#define PROBE_DUPM 0
#endif
#ifndef MK_PER_PHASE
#define MK_PER_PHASE 0
#endif
constexpr int NWAVES = 8;
constexpr int BATCH = 16, SEQ = 2048, D = 1024, FF = 2816, TOK = BATCH * SEQ;
constexpr int NPH = 15;
constexpr size_t MiB = 1u << 20;
constexpr size_t WS_W13 = 1 * MiB;
constexpr size_t WS_W2 = 45 * MiB;
constexpr size_t WS_WIN = 67 * MiB;
constexpr size_t WS_WV = 72 * MiB;
constexpr size_t WS_WOUT = 73 * MiB;
constexpr size_t WS_WGLU = 75 * MiB;
constexpr size_t WS_WLRU = 79 * MiB;
constexpr size_t WS_ROPE = 80 * MiB;
constexpr size_t WS_SSP = 81 * MiB;
constexpr size_t WS_XB = 96 * MiB;
constexpr size_t WS_R1 = 160 * MiB;
constexpr size_t WS_Q = WS_R1, WS_K = WS_R1 + 32 * MiB, WS_VT = WS_R1 + 64 * MiB, WS_G = WS_R1 + 97 * MiB;
constexpr int VT_LD = TOK + 64;
constexpr size_t WS_MRG = 354 * MiB;
constexpr size_t WS_XLO = 418 * MiB;
constexpr size_t WS_END = 482 * MiB;
constexpr int LDS_BYTES = 163840;

__device__ __forceinline__ unsigned f2bf(float f) { unsigned u = __builtin_bit_cast(unsigned, f); return (u + 0x7fffu + ((u >> 16) & 1u)) >> 16; }
__device__ __forceinline__ unsigned pk2(float lo, float hi) { return f2bf(lo) | (f2bf(hi) << 16); }
__device__ __forceinline__ float bf_lo(unsigned w) { return __builtin_bit_cast(float, w << 16); }
__device__ __forceinline__ float bf_hi(unsigned w) { return __builtin_bit_cast(float, w & 0xffff0000u); }
__device__ __forceinline__ float bf1(bf16 h) { return __builtin_bit_cast(float, (unsigned)h << 16); }
__device__ __forceinline__ float wave_sum(float v) {
#pragma unroll
    for (int o = 1; o < 64; o <<= 1) v += __shfl_xor(v, o);
    return v;
}
__device__ __forceinline__ f32x4 mfma16(bf16x8 a, bf16x8 b, f32x4 c) { return __builtin_amdgcn_mfma_f32_16x16x32_bf16(a, b, c, 0, 0, 0); }

__device__ __forceinline__ void transpose_item(const float* __restrict__ W, int N, int K, const float* __restrict__ gk, bf16* WT, int dst_row, int k0, int n0, LAS float* scr, int lane) {
    { float v[32];
#pragma unroll
      for (int i = 0; i < 32; ++i) v[i] = W[(size_t)(k0 + 2 * i + (lane >> 5)) * N + n0 + (lane & 31)];
      if (gk) { const float gl = gk[k0 + lane];
#pragma unroll
          for (int i = 0; i < 32; ++i) v[i] *= __shfl(gl, 2 * i + (lane >> 5)); }
#pragma unroll
      for (int i = 0; i < 32; ++i) scr[(2 * i + (lane >> 5)) * 33 + (lane & 31)] = v[i]; }
    LDS_WAIT(); asm volatile("" ::: "memory");
    const int c = lane & 7;
#pragma unroll
    for (int j = 0; j < 4; ++j) { const int n = (lane >> 3) + 8 * j; const LAS float* s = scr + (8 * c) * 33 + n;
        v4u o; o.x = pk2(s[0 * 33], s[1 * 33]); o.y = pk2(s[2 * 33], s[3 * 33]); o.z = pk2(s[4 * 33], s[5 * 33]); o.w = pk2(s[6 * 33], s[7 * 33]);
        *(v4u*)(WT + (size_t)(dst_row + n) * K + k0 + 8 * c) = o; }
    LDS_WAIT(); asm volatile("" ::: "memory");
}
struct Args { const float* in[27]; float* out; unsigned char* ws; int ph_lo, ph_hi; };
typedef const __attribute__((address_space(4))) Args* KArgP;

template <bool LATE> __device__ __forceinline__ void p0_weights(KArgP ap, LAS float* scr, int gw, int NGW, int lane) {
    unsigned char* ws = ap->ws;
    constexpr int I_F = 1408, I_IN = 1536, I_OUT = 512, I_GL = 512, I_LRU = 64;
    constexpr int NITEMS = 12 * I_F + I_IN + I_OUT + 2 * I_GL + I_LRU;
    for (int it = gw; it < NITEMS; it += NGW) {
        int r = it;
        if (r < 8 * I_F) { const int w3 = r >= 4 * I_F; if (w3) r -= 4 * I_F; const int l = r / I_F; r -= l * I_F; if ((l == 3) != LATE) continue; const int kb = r / 88, nb = r % 88, n0 = 32 * nb;
            transpose_item(ap->in[w3 ? 3 : 2] + (size_t)l * D * FF, FF, D, ap->in[1] + l * D, (bf16*)(ws + WS_W13) + (size_t)l * 5632 * 1024, 256 * (n0 >> 7) + (n0 & 127) + (w3 ? 128 : 0), 64 * kb, n0, scr, lane); continue; }
        r -= 8 * I_F;
        if (r < 4 * I_F) { const int l = r / I_F; r -= l * I_F; if ((l == 3) != LATE) continue; const int kb = r / 32, nb = r % 32;
            transpose_item(ap->in[4] + (size_t)l * FF * D, D, FF, nullptr, (bf16*)(ws + WS_W2) + (size_t)l * 1024 * FF, 32 * nb, 64 * kb, 32 * nb, scr, lane); continue; }
        r -= 4 * I_F;
        if (r < I_IN) { if (LATE) continue; const int kb = r / 96, nb = r % 96, n0 = 32 * nb; bf16* dst; int drow;
            if (n0 < 1024) { const int sec = n0 >> 9, nn = n0 & 511, h = nn >> 7, bj = (nn >> 6) & 1, jj0 = nn & 63; dst = (bf16*)(ws + WS_WIN); drow = 512 * sec + 256 * (h >> 1) + 128 * bj + 64 * (h & 1) + jj0; }
            else if (n0 < 1536) { dst = (bf16*)(ws + WS_WV); drow = n0 - 1024; }
            else { dst = (bf16*)(ws + WS_WIN); drow = n0 - 512; }
            transpose_item(ap->in[6], 3072, D, ap->in[5], dst, drow, 64 * kb, n0, scr, lane); continue; }
        r -= I_IN;
        if (r < I_OUT) { if (LATE) continue; const int kb = r / 32, nb = r % 32; transpose_item(ap->in[7], D, D, nullptr, (bf16*)(ws + WS_WOUT), 32 * nb, 64 * kb, 32 * nb, scr, lane); continue; }
        r -= I_OUT;
        if (r < 2 * I_GL) { if (!LATE) continue; const int wb = r >= I_GL; if (wb) r -= I_GL; const int kb = r / 32, nb = r % 32, n0 = 32 * nb;
            transpose_item(ap->in[wb ? 25 : 24], D, D, nullptr, (bf16*)(ws + WS_WGLU), 256 * (n0 >> 7) + (n0 & 127) + (wb ? 128 : 0), 64 * kb, n0, scr, lane); continue; }
        r -= 2 * I_GL;
        if (LATE) continue;
        { const int mat = r >> 3, g = mat >> 1, gate = mat & 1, kb = (r >> 2) & 1, nb = r & 3;
            transpose_item(ap->in[gate ? 13 : 11] + (size_t)g * 128 * 128, 128, 128, nullptr, (bf16*)(ws + WS_WLRU) + (size_t)mat * 128 * 128, 32 * nb, 64 * kb, 32 * nb, scr, lane); }
    }
}
__device__ __forceinline__ void p0_prologue(KArgP ap, LAS unsigned char* lds, int gw, int NGW, int wave, int lane) {
    unsigned char* ws = ap->ws;
    p0_weights<false>(ap, (LAS float*)(lds + wave * 16384), gw, NGW, lane);
    if (!LATE_IN_S5) p0_weights<true>(ap, (LAS float*)(lds + wave * 16384), gw, NGW, lane);
    { float* rope = (float*)(ws + WS_ROPE);
      for (int i = gw * 64 + lane; i < 2048 * 64; i += NGW * 64) { const int pos = i >> 6, j = i & 63; const double inv = pow(10000.0, -(double)j / 64.0); const double ang = (double)pos * inv;
          rope[2 * i] = (float)cos(ang); rope[2 * i + 1] = (float)sin(ang); } }
    { const float* x = ap->in[0]; bf16* xb = (bf16*)(ws + WS_XB); float* ssp = (float*)(ws + WS_SSP);
      for (int m0 = 2 * gw; m0 < TOK; m0 += 2 * NGW) { f32x4 v[2][4]; float s[2];
#pragma unroll
          for (int h = 0; h < 2; ++h) { const f32x4* xr = (const f32x4*)(x + (size_t)(m0 + h) * D) + lane;
#pragma unroll
              for (int j = 0; j < 4; ++j) v[h][j] = xr[64 * j]; }
#pragma unroll
          for (int h = 0; h < 2; ++h) { float t = 0.f;
#pragma unroll
              for (int j = 0; j < 4; ++j) t += (v[h][j][0] * v[h][j][0] + v[h][j][1] * v[h][j][1]) + (v[h][j][2] * v[h][j][2] + v[h][j][3] * v[h][j][3]);
              s[h] = wave_sum(t);
              v2u* o8 = (v2u*)(xb + (size_t)(m0 + h) * D) + lane;
#pragma unroll
              for (int j = 0; j < 4; ++j) { v2u w; w.x = cvt_pk_bf16(v[h][j][0], v[h][j][1]); w.y = cvt_pk_bf16(v[h][j][2], v[h][j][3]); o8[64 * j] = w; }
              if (lane < 16) ssp[(size_t)(m0 + h) * 32 + lane] = lane == 0 ? s[h] : 0.f; } } }
}

__device__ __forceinline__ void ret_unit(int b, int h, int p, const bf16* Q, const bf16* Kb, const bf16* Vt, const bf16* G, const float* ret_g, bf16* MRG, LAS unsigned char* lds, int tid, int wid, int lane) {
    const int fr = lane & 15, fq = lane >> 4;
    const int cq = 2 * p + (wid >> 2), iloc0 = 32 * (wid & 3);
    const size_t tok0 = (size_t)b * SEQ + 256 * p + 32 * wid;
    const float lg = log2f(1.0f - exp2f(-5.0f - (float)h));
    bf16x8 qf[2][4];
#pragma unroll
    for (int mi = 0; mi < 2; ++mi)
#pragma unroll
        for (int kk = 0; kk < 4; ++kk) qf[mi][kk] = *(const bf16x8*)(Q + (tok0 + 16 * mi + fr) * 512 + h * 128 + 32 * kk + 8 * fq);
    f32x4 O[2][8];
#pragma unroll
    for (int mi = 0; mi < 2; ++mi)
#pragma unroll
        for (int e = 0; e < 8; ++e) O[mi][e] = (f32x4){0.f, 0.f, 0.f, 0.f};
    const int nm = 2 * p + 2;
    const int srow = 4 * wid + (lane >> 4), keyK = ((wid >> 1) & 3) * 4 + (lane >> 4), keyV = 4 * (wid & 3) + (lane >> 4);
    const bf16* kbase = Kb + ((size_t)b * SEQ + srow) * 512 + h * 128 + 8 * ((lane & 15) ^ keyK);
    const bf16* vbase = Vt + ((size_t)(h * 128 + srow)) * VT_LD + (size_t)b * SEQ + 8 * ((lane & 15) ^ keyV);
#define RET_STAGE(m_, buf_) do { _Pragma("unroll") for (int i = 0; i < 4; ++i) { \
        __builtin_amdgcn_global_load_lds((const unsigned*)(kbase + ((size_t)(128 * (m_) + 32 * i)) * 512), (LAS unsigned*)(lds + (buf_) * 65536 + (8 * i + wid) * 1024), 16, 0, 0); \
        __builtin_amdgcn_global_load_lds((const unsigned*)(vbase + (size_t)(32 * i) * VT_LD + 128 * (m_)), (LAS unsigned*)(lds + (buf_) * 65536 + 32768 + (8 * i + wid) * 1024), 16, 0, 0); } } while (0)
    RET_STAGE(0, 0);
    asm volatile("s_waitcnt vmcnt(0)" ::: "memory"); __syncthreads();
    for (int m = 0; m < nm; ++m) {
        const int buf = m & 1;
        if (m + 1 < nm) RET_STAGE(m + 1, buf ^ 1);
        if (m <= cq) {
            const LAS unsigned char* Kl = lds + buf * 65536; const LAS unsigned char* Vl = Kl + 32768;
            const float sc = fast_exp2(lg * (float)(128 * (cq - m)));
#pragma unroll
            for (int g32 = 0; g32 < 4; ++g32) {
                f32x4 S[2][2];
#pragma unroll
                for (int n = 0; n < 2; ++n) { S[0][n] = (f32x4){0.f, 0.f, 0.f, 0.f}; S[1][n] = (f32x4){0.f, 0.f, 0.f, 0.f};
                    const int krow = 32 * g32 + 8 * (fr >> 2) + 4 * n + (fr & 3);
#pragma unroll
                    for (int kk = 0; kk < 4; ++kk) { const bf16x8 kf = *(const LAS bf16x8*)(Kl + krow * 256 + (((4 * kk + fq) ^ fr) << 4));
                        S[0][n] = mfma16(kf, qf[0][kk], S[0][n]); S[1][n] = mfma16(kf, qf[1][kk], S[1][n]); } }
                bf16x8 pf[2];
#pragma unroll
                for (int mi = 0; mi < 2; ++mi) { f32x4 v0 = S[mi][0] * sc, v1 = S[mi][1] * sc;
                    if (m == cq) { const int il = iloc0 + 16 * mi + fr, jl = 32 * g32 + 8 * fq;
#pragma unroll
                        for (int t = 0; t < 4; ++t) { v0[t] = (jl + t <= il) ? v0[t] : 0.f; v1[t] = (jl + 4 + t <= il) ? v1[t] : 0.f; } }
                    const pg8::u32x4 w = pack8(v0, v1); pf[mi] = __builtin_bit_cast(bf16x8, w); }
#pragma unroll
                for (int ef = 0; ef < 8; ++ef) { const int vrow = 16 * ef + fr;
                    const bf16x8 vf = *(const LAS bf16x8*)(Vl + vrow * 256 + (((4 * g32 + fq) ^ fr) << 4));
                    O[0][ef] = mfma16(vf, pf[0], O[0][ef]); O[1][ef] = mfma16(vf, pf[1], O[1][ef]); }
            }
        }
        asm volatile("s_waitcnt vmcnt(0)" ::: "memory"); __syncthreads();
    }
#undef RET_STAGE
#pragma unroll
    for (int mi = 0; mi < 2; ++mi) { const size_t tok = tok0 + 16 * mi + fr; float s = 0.f;
#pragma unroll
        for (int ef = 0; ef < 8; ++ef) s += (O[mi][ef][0] + O[mi][ef][1]) + (O[mi][ef][2] + O[mi][ef][3]);
        s += __shfl_xor(s, 16); s += __shfl_xor(s, 32); const float mu = s * (1.0f / 128.0f); float q = 0.f;
#pragma unroll
        for (int ef = 0; ef < 8; ++ef) { const f32x4 d = O[mi][ef] - mu; q += (d[0] * d[0] + d[1] * d[1]) + (d[2] * d[2] + d[3] * d[3]); }
        q += __shfl_xor(q, 16); q += __shfl_xor(q, 32); const float rstd = 1.0f / sqrtf(q * (1.0f / 128.0f) + 1e-6f);
#pragma unroll
        for (int ef = 0; ef < 8; ++ef) { const int col = h * 128 + 16 * ef + 4 * fq; const f32x4 gn = *(const f32x4*)(ret_g + col); const v2u gr = *(const v2u*)(G + tok * 1536 + col);
            const float g0 = bf_lo(gr.x), g1 = bf_hi(gr.x), g2 = bf_lo(gr.y), g3 = bf_hi(gr.y);
            const float y0 = (O[mi][ef][0] - mu) * rstd * gn[0] * silu_f(g0), y1 = (O[mi][ef][1] - mu) * rstd * gn[1] * silu_f(g1);
            const float y2 = (O[mi][ef][2] - mu) * rstd * gn[2] * silu_f(g2), y3 = (O[mi][ef][3] - mu) * rstd * gn[3] * silu_f(g3);
            v2u w; w.x = cvt_pk_bf16(y0, y1); w.y = cvt_pk_bf16(y2, y3); *(v2u*)(MRG + tok * 1024 + col) = w; } }
}

constexpr int LRU_XT = 0, LRU_A = 66560, LRU_BX = 99328, LRU_WF = 132096, LRU_CW = 148480, LRU_CB = 150528, LRU_SEG = 151040, LRU_CAR = 155136;
__device__ __forceinline__ void lru_unit(int b, int g, int q, const bf16* G, const bf16* LW, const float* conv_w, const float* conv_b, const float* b_a, const float* b_i, const float* lam,
                                         bf16* MRG, LAS unsigned char* lds, int tid, int wid, int lane) {
    const int fr = lane & 15, fq = lane >> 4;
    LAS unsigned char* XT = lds + LRU_XT; LAS float* A_ = (LAS float*)(lds + LRU_A); LAS float* BX = (LAS float*)(lds + LRU_BX); LAS unsigned char* WF = lds + LRU_WF;
    LAS float* CW = (LAS float*)(lds + LRU_CW); LAS float* CB = (LAS float*)(lds + LRU_CB); LAS float* SEG = (LAS float*)(lds + LRU_SEG); LAS float* CAR = (LAS float*)(lds + LRU_CAR);
    const bf16* xl = G + (size_t)b * SEQ * 1536 + 512 + 128 * g;
    {
      for (int i = tid; i < 64 * 16; i += 512) { const int r = i >> 4, c = i & 15; const v4u w = *(const v4u*)(LW + ((size_t)((g * 2 + (r >> 5)) * 128 + 32 * q + (r & 31))) * 128 + 8 * c); *(LAS v4u*)(WF + r * 256 + ((c ^ (r & 15)) << 4)) = w; }
      CW[tid] = conv_w[(tid >> 7) * 512 + 128 * g + (tid & 127)]; if (tid < 128) CB[tid] = conv_b[128 * g + tid]; }
    f32x4 gba[2], gbi[2], gsp[2];
#pragma unroll
    for (int nfl = 0; nfl < 2; ++nfl) { const int cg0 = 128 * g + 32 * q + 16 * nfl + 4 * fq; gba[nfl] = *(const f32x4*)(b_a + cg0); gbi[nfl] = *(const f32x4*)(b_i + cg0); const f32x4 lm = *(const f32x4*)(lam + cg0);
#pragma unroll
        for (int t = 0; t < 4; ++t) gsp[nfl][t] = -8.0f * 1.4426950408889634f * log1pf(__expf(-lm[t])); }
    for (int tile = 0; tile < 8; ++tile) {
        { v4u xs[9];
#pragma unroll
          for (int k9 = 0; k9 < 9; ++k9) { const int i = tid + 512 * k9, j = (i >> 4) < 258 ? (i >> 4) : 258, c = i & 15, sp = 256 * tile - 3 + j;
              xs[k9] = *(const v4u*)(xl + (size_t)(sp < 0 ? 0 : sp) * 1536 + 8 * c); if (sp < 0) xs[k9] = (v4u){0u, 0u, 0u, 0u}; }
#pragma unroll
          for (int k9 = 0; k9 < 9; ++k9) { const int i = tid + 512 * k9, j = i >> 4, c = i & 15; if (i < 259 * 16) *(LAS v4u*)(XT + j * 256 + ((c ^ (j & 15)) << 4)) = xs[k9]; } }
        __syncthreads();
        const int r0 = 32 * wid;
        f32x4 acc[2][4];
#pragma unroll
        for (int mi = 0; mi < 2; ++mi)
#pragma unroll
            for (int nf = 0; nf < 4; ++nf) acc[mi][nf] = (f32x4){0.f, 0.f, 0.f, 0.f};
#pragma unroll 1
        for (int kk = 0; kk < 4; ++kk) { const int c16 = 4 * kk + fq, ch0 = 8 * c16;
            bf16x8 wf[4];
#pragma unroll
            for (int nf = 0; nf < 4; ++nf) { const int r = 32 * (nf >> 1) + 16 * (nf & 1) + fr; wf[nf] = *(const LAS bf16x8*)(WF + r * 256 + ((c16 ^ (r & 15)) << 4)); }
            f32x4 cw[4][2], cb[2];
            cb[0] = *(const LAS f32x4*)(CB + ch0); cb[1] = *(const LAS f32x4*)(CB + ch0 + 4);
#pragma unroll
            for (int tap = 0; tap < 4; ++tap) { cw[tap][0] = *(const LAS f32x4*)(CW + tap * 128 + ch0); cw[tap][1] = *(const LAS f32x4*)(CW + tap * 128 + ch0 + 4); }
#pragma unroll
            for (int mi = 0; mi < 2; ++mi) { float xc[8];
                xc[0] = cb[0][0]; xc[1] = cb[0][1]; xc[2] = cb[0][2]; xc[3] = cb[0][3]; xc[4] = cb[1][0]; xc[5] = cb[1][1]; xc[6] = cb[1][2]; xc[7] = cb[1][3];
#pragma unroll
                for (int tap = 0; tap < 4; ++tap) { const int j = r0 + 16 * mi + fr + tap; const v4u x4 = *(const LAS v4u*)(XT + j * 256 + ((c16 ^ (j & 15)) << 4)); const f32x4 w0 = cw[tap][0], w1 = cw[tap][1];
                    xc[0] += w0[0] * bf_lo(x4.x); xc[1] += w0[1] * bf_hi(x4.x); xc[2] += w0[2] * bf_lo(x4.y); xc[3] += w0[3] * bf_hi(x4.y);
                    xc[4] += w1[0] * bf_lo(x4.z); xc[5] += w1[1] * bf_hi(x4.z); xc[6] += w1[2] * bf_lo(x4.w); xc[7] += w1[3] * bf_hi(x4.w); }
                pg8::u32x4 aw; aw.x = cvt_pk_bf16(xc[0], xc[1]); aw.y = cvt_pk_bf16(xc[2], xc[3]); aw.z = cvt_pk_bf16(xc[4], xc[5]); aw.w = cvt_pk_bf16(xc[6], xc[7]);
                const bf16x8 af = __builtin_bit_cast(bf16x8, aw);
#pragma unroll
                for (int nf = 0; nf < 4; ++nf) acc[mi][nf] = mfma16(wf[nf], af, acc[mi][nf]); } }
#pragma unroll
        for (int nfl = 0; nfl < 2; ++nfl) { const int cl_ = 32 * q + 16 * nfl + 4 * fq, c16 = cl_ >> 3, sub = (cl_ & 7) * 2;
            f32x4 gcw[4]; const f32x4 gcb = *(const LAS f32x4*)(CB + cl_);
#pragma unroll
            for (int tap = 0; tap < 4; ++tap) gcw[tap] = *(const LAS f32x4*)(CW + tap * 128 + cl_);
#pragma unroll
            for (int mi = 0; mi < 2; ++mi) { f32x4 xc = gcb;
#pragma unroll
                for (int tap = 0; tap < 4; ++tap) { const int j = r0 + 16 * mi + fr + tap; const v2u xv = *(const LAS v2u*)(XT + j * 256 + ((c16 ^ (j & 15)) << 4) + sub); const f32x4 w0 = gcw[tap];
                    xc[0] += w0[0] * bf_lo(xv.x); xc[1] += w0[1] * bf_hi(xv.x); xc[2] += w0[2] * bf_lo(xv.y); xc[3] += w0[3] * bf_hi(xv.y); }
                f32x4 av, bv;
#pragma unroll
                for (int t = 0; t < 4; ++t) { const float r = sigmoid_f(acc[mi][nfl][t] + gba[nfl][t]), ig = sigmoid_f(acc[mi][nfl + 2][t] + gbi[nfl][t]);
                    const float a_ = fast_exp2(r * gsp[nfl][t]); av[t] = a_; bv[t] = sqrtf(fmaxf(1.0f - a_ * a_, 0.f)) * ig * xc[t]; }
                const int rt = r0 + 16 * mi + fr;
                *(LAS f32x4*)(A_ + rt * 32 + 16 * nfl + 4 * fq) = av; *(LAS f32x4*)(BX + rt * 32 + 16 * nfl + 4 * fq) = bv; } }
        __syncthreads();
        const int c = tid & 31, seg = tid >> 5;
        float sa[16], sb[16];
#pragma unroll
        for (int k = 0; k < 16; ++k) { sa[k] = A_[(16 * seg + k) * 32 + c]; sb[k] = BX[(16 * seg + k) * 32 + c]; }
        const size_t tokb = (size_t)b * SEQ + 256 * tile + 16 * seg;
        float gl[16];
#pragma unroll
        for (int k = 0; k < 16; ++k) gl[k] = bf1(G[(tokb + k) * 1536 + 1024 + 128 * g + 32 * q + c]);
        { float P = 1.f, hl = 0.f;
#pragma unroll
          for (int k = 0; k < 16; ++k) { hl = sa[k] * hl + sb[k]; P *= sa[k]; }
          SEG[(seg * 32 + c) * 2] = P; SEG[(seg * 32 + c) * 2 + 1] = hl; }
        __syncthreads();
        float hin = tile == 0 ? 0.f : CAR[(tile & 1) * 32 + c];
        { f32x2 sg[15];
#pragma unroll
          for (int s2 = 0; s2 < 15; ++s2) sg[s2] = *(const LAS f32x2*)(SEG + (s2 * 32 + c) * 2);
#pragma unroll
          for (int s2 = 0; s2 < 15; ++s2) if (s2 < seg) hin = sg[s2][0] * hin + sg[s2][1]; }
#pragma unroll
        for (int k = 0; k < 16; ++k) { hin = sa[k] * hin + sb[k];
            MRG[(tokb + k) * 1024 + 512 + 128 * g + 32 * q + c] = (bf16)f2bf(hin * gelu_tanh_f(gl[k])); }
        if (seg == 15) CAR[((tile + 1) & 1) * 32 + c] = hin;
        __syncthreads();
    }
}

constexpr int S5_WLDS = 28672, S5_NB = SEQ / 16;
__device__ __forceinline__ void s5_pair(int b, int g, bool helper, KArgP ap, const bf16* xh, const LAS float* rsl, bf16* YS, LAS unsigned char* wl, int lane) {
    const float* lam_re = ap->in[16]; const float* lam_im = ap->in[17]; const float* log_dt = ap->in[18]; const float* b_re = ap->in[19]; const float* b_im = ap->in[20];
    const float* c_re = ap->in[21]; const float* c_im = ap->in[22]; const float* dsk = ap->in[23]; const float* gmix = ap->in[5] + D;
    LAS float* BU = (LAS float*)wl; LAS unsigned char* Hh = wl + 16384; LAS float* U = (LAS float*)(wl + 16384 + 8704);
    const float dt = __expf(log_dt[g]);
    const int c16 = lane & 15, kq = lane >> 4, kh = kq & 1;
    const size_t tokb = (size_t)b * SEQ;
#define S5_BAR() do { LDS_WAIT(); asm volatile("" ::: "memory"); __builtin_amdgcn_s_barrier(); asm volatile("" ::: "memory"); } while (0)
    if (helper) {
        bf16x8 bfr[8];
#pragma unroll
        for (int j = 0; j < 8; ++j) { const int pp = 16 * (j & 3) + c16, comp = j >> 2;
            const float re = lam_re[g * 64 + pp], im = lam_im[g * 64 + pp], mag = __expf(re * dt), lbr = mag * cosf(im * dt), lbi = mag * sinf(im * dt);
            const float den = re * re + im * im, nr = lbr - 1.0f, ni = lbi, fre = (nr * re + ni * im) / den, fim = (ni * re - nr * im) / den;
            const f32x4* pr = (const f32x4*)(b_re + ((size_t)(g * 64 + pp)) * 16 + 8 * kh); const f32x4* pi = (const f32x4*)(b_im + ((size_t)(g * 64 + pp)) * 16 + 8 * kh);
            const f32x4 r0 = pr[0], r1 = pr[1], i0 = pi[0], i1 = pi[1]; f32x4 o0, o1;
#pragma unroll
            for (int t = 0; t < 4; ++t) { o0[t] = comp ? (fre * i0[t] + fim * r0[t]) : (fre * r0[t] - fim * i0[t]); o1[t] = comp ? (fre * i1[t] + fim * r1[t]) : (fre * r1[t] - fim * i1[t]); }
            pg8::u32x4 w = pack8(o0, o1); if (kq >= 2) w = (pg8::u32x4){0u, 0u, 0u, 0u}; bfr[j] = __builtin_bit_cast(bf16x8, w); }
        const f32x4 gm0 = *(const f32x4*)(gmix + 16 * g + 8 * kh), gm1 = *(const f32x4*)(gmix + 16 * g + 8 * kh + 4);
        const bf16* xrow = xh + (tokb + c16) * D + 16 * g + 8 * kh;
        v4u xq[2]; xq[0] = *(const v4u*)(xrow); xq[1] = *(const v4u*)(xrow + (size_t)16 * D);
#define S5_A(kb_, xq_) do { const int kb__ = (kb_); const float rs_ = rsl[16 * kb__ + c16]; \
            f32x4 u0_ = pg8::up_lo((xq_).x, (xq_).y) * rs_ * gm0, u1_ = pg8::up_lo((xq_).z, (xq_).w) * rs_ * gm1; \
            { const int nb_ = kb__ + 2 < S5_NB ? kb__ + 2 : S5_NB - 1; (xq_) = *(const v4u*)(xrow + (size_t)(16 * nb_) * D); } \
            *(LAS f32x4*)(U + (kb__ % 3) * 256 + c16 * 16 + 8 * kh + 4 * (kq >> 1)) = (kq & 2) ? u1_ : u0_; \
            pg8::u32x4 uw_ = pack8(u0_, u1_); if (kq >= 2) uw_ = (pg8::u32x4){0u, 0u, 0u, 0u}; const bf16x8 uf_ = __builtin_bit_cast(bf16x8, uw_); \
            _Pragma("unroll") for (int j = 0; j < 4; ++j) { const f32x4 z_ = (f32x4){0.f, 0.f, 0.f, 0.f}; const f32x4 dr_ = mfma16(uf_, bfr[j], z_), di_ = mfma16(uf_, bfr[j + 4], z_); \
                _Pragma("unroll") for (int r = 0; r < 4; ++r) *(LAS f32x2*)(BU + (kb__ & 1) * 2048 + (4 * kq + r) * 128 + 2 * (16 * j + c16)) = (f32x2){dr_[r], di_[r]}; } } while (0)
        S5_A(0, xq[0]); S5_BAR();
        S5_A(1, xq[1]); S5_BAR();
        for (int k = 1; k < S5_NB - 1; k += 2) { S5_A(k + 1, xq[0]); S5_BAR(); if (k + 2 < S5_NB) S5_A(k + 2, xq[1]); S5_BAR(); }
#undef S5_A
    } else {
        float lr, li;
        { const float re = lam_re[g * 64 + lane], im = lam_im[g * 64 + lane], mag = __expf(re * dt); lr = mag * cosf(im * dt); li = mag * sinf(im * dt); }
        bf16x8 cfr[4];
#pragma unroll
        for (int kk = 0; kk < 4; ++kk) { const int p0 = 16 * kk + 4 * kq;
            const f32x4 cr = *(const f32x4*)(c_re + ((size_t)(g * 16 + c16)) * 64 + p0), ci = *(const f32x4*)(c_im + ((size_t)(g * 16 + c16)) * 64 + p0);
            pg8::u32x4 w; w.x = cvt_pk_bf16(cr[0], -ci[0]); w.y = cvt_pk_bf16(cr[1], -ci[1]); w.z = cvt_pk_bf16(cr[2], -ci[2]); w.w = cvt_pk_bf16(cr[3], -ci[3]); cfr[kk] = __builtin_bit_cast(bf16x8, w); }
        const f32x4 dch4 = *(const f32x4*)(dsk + 16 * g + 4 * kq);
        float hre = 0.f, him = 0.f;
#define S5_B(kb_) do { const int bf_ = (kb_) & 1; f32x2 bu_[16]; \
            _Pragma("unroll") for (int t = 0; t < 16; ++t) bu_[t] = *(const LAS f32x2*)(BU + bf_ * 2048 + t * 128 + 2 * lane); \
            _Pragma("unroll") for (int t = 0; t < 16; ++t) { const float nr_ = lr * hre - li * him + bu_[t][0], ni_ = lr * him + li * hre + bu_[t][1]; hre = nr_; him = ni_; \
                *(LAS unsigned*)(Hh + bf_ * 4352 + t * 272 + 4 * lane) = cvt_pk_bf16(nr_, ni_); } } while (0)
#define S5_C(kb_) do { const int kb__ = (kb_), bf_ = kb__ & 1; f32x4 y_ = (f32x4){0.f, 0.f, 0.f, 0.f}; \
            _Pragma("unroll") for (int kk = 0; kk < 4; ++kk) { const bf16x8 hf_ = *(const LAS bf16x8*)(Hh + bf_ * 4352 + c16 * 272 + (32 * kk + 8 * kq) * 2); y_ = mfma16(cfr[kk], hf_, y_); } \
            const f32x4 uu_ = *(const LAS f32x4*)(U + (kb__ % 3) * 256 + c16 * 16 + 4 * kq); const f32x4 yv_ = y_ + dch4 * uu_; \
            v2u w_; w_.x = cvt_pk_bf16(gelu_tanh_f(yv_[0]), gelu_tanh_f(yv_[1])); w_.y = cvt_pk_bf16(gelu_tanh_f(yv_[2]), gelu_tanh_f(yv_[3])); \
            *(v2u*)(YS + (tokb + 16 * kb__ + c16) * 1024 + 16 * g + 4 * kq) = w_; } while (0)
        S5_BAR();
        S5_B(0); S5_BAR();
        for (int k = 1; k < S5_NB - 1; k += 2) { S5_C(k - 1); S5_B(k); S5_BAR(); S5_C(k); S5_B(k + 1); S5_BAR(); }
        S5_C(S5_NB - 2); S5_B(S5_NB - 1);
        LDS_WAIT(); asm volatile("" ::: "memory");
        S5_C(S5_NB - 1);
#undef S5_B
#undef S5_C
    }
#undef S5_BAR
}

#define XB_TMO      128
#define XB_XCNT(j)  (256  + 64 * (j))
#define XB_XSUB(j)  (1280 + 64 * (j))
#define XB_XGEN(j)  (2304 + 64 * (j))
#define XB_TOP      3328
#define XB_TOPGEN   3392
#define XCD_BAR_WORDS 3456
#define XB_SPIN_CAP (1u << 18)

__device__ __forceinline__ unsigned xb_ld(unsigned* p)              { return __hip_atomic_load(p, __ATOMIC_RELAXED, __HIP_MEMORY_SCOPE_AGENT); }
__device__ __forceinline__ unsigned xb_add(unsigned* p, unsigned v) { return __hip_atomic_fetch_add(p, v, __ATOMIC_RELAXED, __HIP_MEMORY_SCOPE_AGENT); }
__device__ __forceinline__ unsigned xb_xcc_id() { return (unsigned)__builtin_amdgcn_s_getreg((3 << 11) | 20) & 0xFu; }
#define XB_SPIN(cond, bar) do { unsigned _sp = 0; while (cond) { __builtin_amdgcn_s_sleep(1); \
    if ((++_sp & 255u) == 0u) { if (xb_ld(&(bar)[XB_TMO])) break; if (_sp > XB_SPIN_CAP) { atomicAdd(&(bar)[XB_TMO], 1u); break; } } } } while (0)

struct XcdBarrier {
    unsigned* bar; unsigned x; unsigned G;
    volatile LAS unsigned* st;
};

__device__ __forceinline__ XcdBarrier xcd_barrier_post(unsigned* bar, volatile LAS unsigned* st, int tid, unsigned G) {
    XcdBarrier b; b.bar = bar; b.x = xb_xcc_id(); b.st = st; b.G = G;
    if (tid == 0) (void)xb_add(&bar[XB_XCNT(b.x)], 1u);
    return b;
}
__device__ __forceinline__ void xcd_barrier_complete(unsigned* bar, unsigned x, unsigned G, unsigned& nloc, unsigned& nx) {
    unsigned sum, cnt, mine, sp = 0u;
    for (;;) {
        sum = 0u; cnt = 0u; mine = 0u;
#pragma unroll
        for (unsigned j = 0; j < 16; ++j) { const unsigned c = xb_ld(&bar[XB_XCNT(j)]); sum += c; cnt += (c > 0u) ? 1u : 0u; mine = (j == x) ? c : mine; }
        if (sum == G) break;
        __builtin_amdgcn_s_sleep(1);
        if ((++sp & 255u) == 0u) { if (xb_ld(&bar[XB_TMO])) break; if (sp > XB_SPIN_CAP) { atomicAdd(&bar[XB_TMO], 1u); break; } }
    }
    nloc = mine > 0u ? mine : 1u; nx = cnt > 0u ? cnt : 1u;
}

__device__ __forceinline__ void xcd_barrier(const XcdBarrier& b, int tid) {
    asm volatile("s_waitcnt vmcnt(0)" ::: "memory");
    __syncthreads();
    if (tid == 0) {
        unsigned* bar = b.bar;
        __builtin_amdgcn_s_waitcnt(0);
        unsigned nloc = b.st[0], nx = b.st[1];
        if (nloc == 0u) { xcd_barrier_complete(bar, b.x, b.G, nloc, nx); b.st[0] = nloc; b.st[1] = nx; }
        const unsigned old = xb_add(&bar[XB_XSUB(b.x)], 1u);
        const unsigned gen = old / nloc;
        if (old + 1u == (gen + 1u) * nloc) {
            __builtin_amdgcn_fence(__ATOMIC_RELEASE, "agent");
            asm volatile("s_waitcnt vmcnt(0)" ::: "memory");
            const unsigned og = xb_add(&bar[XB_TOP], 1u);
            const unsigned tg = og / nx;
            if (og + 1u == (tg + 1u) * nx) xb_add(&bar[XB_TOPGEN], 1u);
            else XB_SPIN(xb_ld(&bar[XB_TOPGEN]) == tg, bar);
            __builtin_amdgcn_fence(__ATOMIC_ACQUIRE, "agent");
            xb_add(&bar[XB_XGEN(b.x)], 1u);
            asm volatile("s_waitcnt vmcnt(0)" ::: "memory");
        } else {
            XB_SPIN(xb_ld(&bar[XB_XGEN(b.x)]) == gen, bar);
            __builtin_amdgcn_fence(__ATOMIC_ACQUIRE, "agent");
            asm volatile("s_waitcnt vmcnt(0)" ::: "memory");
        }
    }
    __syncthreads();
}

__device__ __forceinline__ int lane_id() { return (int)__builtin_amdgcn_mbcnt_hi(~0u, __builtin_amdgcn_mbcnt_lo(~0u, 0u)); }
struct HotOrder {
    int c;
    __device__ bool next(int i, pg8::Unit& u) const { if (i >= 11) return false; u.pm = c & 3; u.pn = (c >> 2) & 1; return true; }
    __device__ __forceinline__ void a_ready(const pg8::Unit&) const {}
    __device__ __forceinline__ void done(const pg8::Unit&) const {}
};
template <int ph> __device__ __forceinline__ void phase_body(LAS unsigned char* lds, int wave) {
    int lane_ = lane_id(); asm volatile("" : "+v"(lane_));
    const int lane = lane_, tid = wave * 64 + lane;
    const int G_ = gridDim.x, bx = blockIdx.x;
    const int gw = bx * NWAVES + wave, NGW = G_ * NWAVES;
      const int grp = bx & 1, cl = (bx >> 3) * 4 + ((bx & 7) >> 1), GL = G_ >> 1; constexpr int TOKH = TOK / 2; const size_t R0 = (size_t)grp * TOKH;
    (void)GL; (void)cl; (void)R0;
    KArgP ap = (KArgP)__builtin_amdgcn_kernarg_segment_ptr(); asm volatile("" : "+s"(ap));
    unsigned char* ws = ap->ws;
    float* X = ap->out;
    bf16* XB = (bf16*)(ws + WS_XB); bf16* XLO = (bf16*)(ws + WS_XLO); float* SSP = (float*)(ws + WS_SSP); bf16* HID = (bf16*)(ws + WS_R1); bf16* MRG = (bf16*)(ws + WS_MRG);
    (void)gw; (void)NGW; (void)lane; (void)X; (void)XB; (void)XLO; (void)SSP; (void)HID; (void)MRG;
        if constexpr (ph == 0 && (PHM & 1)) { p0_prologue(ap, lds, gw, NGW, wave, lane); }
        else if constexpr ((PHM & 2) && (ph == 1 || ph == 6 || ph == 8 || ph == 12)) {
            const int l = ph == 1 ? 0 : ph == 6 ? 1 : ph == 8 ? 2 : 3;
            pg8::Gemm g{XB + R0 * D, (const bf16*)(ws + WS_W13) + (size_t)l * 5632 * 1024, TOKH, 5632, D}; pg8::StaticOrder S; S.init(TOKH, 5632, GL, cl, 4);
            LAS float* rs_tab = (LAS float*)(lds + 131072 + 16384);
            int pmA = -1, pmB = -1, pmC = -1; { pg8::Unit u0; for (int i = 0; S.next(i, u0); ++i) { if (pmA < 0) pmA = u0.pm; else if (u0.pm != pmA && pmB < 0) pmB = u0.pm; else if (u0.pm != pmA && u0.pm != pmB && pmB >= 0 && pmC < 0) pmC = u0.pm; } }
            if (pmB < 0) pmB = pmA; if (pmC < 0) pmC = pmB;
            { const float* sp = SSP + R0 * 32; const int np = (ph == 12 ? 32 : 16);
#pragma unroll
              for (int s3 = 0; s3 < 3; ++s3) { const int p = s3 == 0 ? pmA : (s3 == 1 ? pmB : pmC); const int row = 256 * p + (tid >> 1); const float rs = row_rs(sp, np, row); if ((tid & 1) == 0) rs_tab[s3 * 256 + (tid >> 1)] = rs; } }
            __syncthreads();
            pg8::EpiSwiglu E{HID + R0 * FF, FF, rs_tab, pmA, pmB};
            pg8::gemm_phase<pg8::EpiSwiglu, pg8::StaticOrder, true, true>(lds, g, S, E, tid);
        }
        else if constexpr ((PHM & 4) && (ph == 2 || ph == 7 || ph == 9 || ph == 13 || ph == 5)) {
            const int l = ph == 2 ? 0 : ph == 7 ? 1 : ph == 9 ? 2 : 3;
            pg8::Gemm g; g.M = TOKH; g.N = D;
            if (ph == 5) { g.A = MRG + R0 * D; g.Bt = (const bf16*)(ws + WS_WOUT); g.K = D; } else { g.A = HID + R0 * FF; g.Bt = (const bf16*)(ws + WS_W2) + (size_t)l * 1024 * FF; g.K = FF; }
            pg8::StaticOrder S; S.init(TOKH, D, GL, cl, 4);
            pg8::EpiResid E{ph == 2 ? ap->in[0] + R0 * D : nullptr, XB + R0 * D, XLO + R0 * D, SSP + R0 * 32, ph == 5 ? 1.0f : 0.5f};
            pg8::gemm_phase<pg8::EpiResid, pg8::StaticOrder, true, true>(lds, g, S, E, tid);
        }
        else if constexpr ((PHM & 8) && ph == 3) {
            { pg8::Gemm g{XB + R0 * D, (const bf16*)(ws + WS_WIN), TOKH, 1024, D}; pg8::StaticOrder S; S.init(TOKH, 1024, GL, cl, 4);
              pg8::EpiRope E{(bf16*)(ws + WS_Q) + R0 * 512, (bf16*)(ws + WS_K) + R0 * 512, (const float*)(ws + WS_ROPE), SSP + R0 * 32, 16, (LAS f32x4*)(lds + 131072) + 2 * tid, -1};
              pg8::gemm_phase<pg8::EpiRope, pg8::StaticOrder, true, true>(lds, g, S, E, tid); }
            { pg8::Gemm g{XB + R0 * D, (const bf16*)(ws + WS_WIN) + (size_t)1024 * 1024, TOKH, 1536, D}; pg8::StaticOrder S; S.init(TOKH, 1536, GL, cl, 4);
              pg8::EpiScaled E{(bf16*)(ws + WS_G) + R0 * 1536, 1536, SSP + R0 * 32, 16, (LAS f32x4*)(lds + 131072) + 2 * tid, -1};
              pg8::gemm_phase<pg8::EpiScaled, pg8::StaticOrder, true, true>(lds, g, S, E, tid); }
            { pg8::Gemm g{(const bf16*)(ws + WS_WV), XB + R0 * D, 512, TOKH, D}; pg8::StaticOrder S; S.init(512, TOKH, GL, cl, 4);
              pg8::EpiPlain E{(bf16*)(ws + WS_VT) + R0, VT_LD};
              pg8::gemm_phase<pg8::EpiPlain, pg8::StaticOrder, true, true>(lds, g, S, E, tid); }
        }
        else if constexpr ((PHM & 16) && ph == 4) {
#ifndef NO_RET
            for (int i = 0; i < ((PROBE_MIXM & 1) ? 4 : 2); ++i) { const int bh = cl >> 2, pp = cl & 3, p = (i & 1) == 0 ? pp : 7 - pp;
                ret_unit(8 * grp + (bh >> 2), bh & 3, p, (const bf16*)(ws + WS_Q), (const bf16*)(ws + WS_K), (const bf16*)(ws + WS_VT), (const bf16*)(ws + WS_G), ap->in[8], MRG, lds, tid, wave, lane); }
#endif
#ifndef NO_LRU
            for (int rep = 0; rep < ((PROBE_MIXM & 2) ? 2 : 1); ++rep)
            lru_unit(8 * grp + (cl >> 4), (cl >> 2) & 3, cl & 3, (const bf16*)(ws + WS_G), (const bf16*)(ws + WS_WLRU), ap->in[9], ap->in[10], ap->in[12], ap->in[14], ap->in[15], MRG, lds, tid, wave, lane);
#endif
        }
        else if constexpr ((PHM & 32) && ph == 10) {
            LAS float* rsl = (LAS float*)(lds + 4 * S5_WLDS);
            { const int bb = 8 * grp + ((cl * 4) >> 6); float r4[4];
#pragma unroll
              for (int i = 0; i < 4; ++i) r4[i] = row_rs(SSP, 16, bb * SEQ + 4 * tid + i);
              *(LAS f32x4*)(rsl + 4 * tid) = (f32x4){r4[0], r4[1], r4[2], r4[3]}; }
            __syncthreads();
            { const int unit = cl * 4 + (wave & 3); s5_pair(8 * grp + (unit >> 6), unit & 63, wave >= 4, ap, XB, rsl, MRG, lds + (wave & 3) * S5_WLDS, lane); }
            if (LATE_IN_S5) { __syncthreads(); p0_weights<true>(ap, (LAS float*)(lds + wave * 8448), cl * 8 + wave, GL * 8, lane); }
        }
        else if constexpr ((PHM & 64) && ph == 11) {
            pg8::Gemm g{MRG + R0 * D, (const bf16*)(ws + WS_WGLU), TOKH, 2048, D}; pg8::StaticOrder S; S.init(TOKH, 2048, GL, cl, 4);
            pg8::EpiGluResid E{XB + R0 * D, XLO + R0 * D, SSP + R0 * 32};
            pg8::gemm_phase<pg8::EpiGluResid, pg8::StaticOrder, true, true>(lds, g, S, E, tid);
        }
        else if constexpr ((PHM & 128) && ph == 14) {
            const float* gf = ap->in[26];
            static_assert(RESID_LO == 0, "the final norm reads the bf16 residual stream only");
            const f32x4* gr = (const f32x4*)gf + lane; f32x4 gg[4];
#pragma unroll
            for (int j = 0; j < 4; ++j) gg[j] = gr[64 * j];
            for (int m0 = (int)R0 + 2 * (cl * NWAVES + wave); m0 < (int)R0 + TOKH; m0 += 2 * GL * NWAVES) {
                v2u h2[2][4]; float rs[2];
#pragma unroll
                for (int h = 0; h < 2; ++h) { const v2u* hr = (const v2u*)(XB + (size_t)(m0 + h) * D) + lane;
#pragma unroll
                    for (int j = 0; j < 4; ++j) h2[h][j] = hr[64 * j];
                    rs[h] = row_rs(SSP, 16, m0 + h); }
#pragma unroll
                for (int h = 0; h < 2; ++h) { f32x4* orow = (f32x4*)(X + (size_t)(m0 + h) * D) + lane;
#pragma unroll
                    for (int j = 0; j < 4; ++j) orow[64 * j] = pg8::up_lo(h2[h][j].x, h2[h][j].y) * rs[h] * gg[j]; } }
        }
}
__global__ void __launch_bounds__(NWAVES * 64, 2) mega_fwd(Args a_) {
    extern __shared__ __attribute__((aligned(16))) unsigned char lds_raw[];
    LAS unsigned char* lds = (LAS unsigned char*)lds_raw;
    cg::grid_group grid = cg::this_grid();
    const int ph_lo = a_.ph_lo, ph_hi = a_.ph_hi;
    const int wave = __builtin_amdgcn_readfirstlane((int)(threadIdx.x >> 6));
    volatile LAS unsigned* bst = (volatile LAS unsigned*)(lds + LDS_BYTES - 32);
    { const int t0 = wave * 64 + lane_id(); if (t0 < 4) bst[t0] = 0u; }
    __syncthreads();
    const int grp_ = (int)blockIdx.x & 1;
    XcdBarrier barG = xcd_barrier_post((unsigned*)a_.ws + 4096 * (1 + grp_), bst + 2, wave * 64 + lane_id(), gridDim.x >> 1);
#define SEAM(k) do { if ((k) == 0) { grid.sync(); if (SKEW_TICKS && grp_) { const unsigned long long t0 = __builtin_amdgcn_s_memrealtime(); while (__builtin_amdgcn_s_memrealtime() - t0 < SKEW_TICKS) __builtin_amdgcn_s_sleep(32); } } \
                     else xcd_barrier(barG, wave * 64 + lane_id()); } while (0)
#define PHASE(k) if (ph_lo <= (k) && (k) < ph_hi) { if ((PROBE_DUPM >> (k)) & 1) { phase_body<k>(lds, wave); if ((k) == 0) grid.sync(); else xcd_barrier(barG, wave * 64 + lane_id()); } phase_body<k>(lds, wave); if ((k) + 1 < ph_hi) SEAM(k); }
    PHASE(0) PHASE(1) PHASE(2) PHASE(3) PHASE(4) PHASE(5) PHASE(6) PHASE(7) PHASE(8) PHASE(9) PHASE(10) PHASE(11) PHASE(12) PHASE(13) PHASE(14)
#undef PHASE
#undef SEAM
}

extern "C" void kernel_launch(void* const* d_in, const int* in_sizes, int n_in, void* d_out, int out_size, void* d_ws, size_t ws_size, hipStream_t stream) {
    static int grid = 0;
    if (grid == 0) {
        if (n_in != 27 || in_sizes[0] != TOK * D || out_size != TOK * D || ws_size < WS_END) { fprintf(stderr, "kernel_launch: unexpected shapes (n_in %d, in0 %d, out %d, ws %zu)\n", n_in, n_in > 0 ? in_sizes[0] : -1, out_size, ws_size); grid = -1; return; }
        int dev = 0, cus = 0, per_cu = 0;
        (void)hipGetDevice(&dev); (void)hipDeviceGetAttribute(&cus, hipDeviceAttributeMultiprocessorCount, dev);
        if (hipFuncSetAttribute((const void*)mega_fwd, hipFuncAttributeMaxDynamicSharedMemorySize, LDS_BYTES) != hipSuccess) { fprintf(stderr, "kernel_launch: hipFuncSetAttribute failed\n"); grid = -1; return; }
        if (hipOccupancyMaxActiveBlocksPerMultiprocessor(&per_cu, (const void*)mega_fwd, NWAVES * 64, LDS_BYTES) != hipSuccess || per_cu < 1) { fprintf(stderr, "kernel_launch: occupancy query says %d blocks per CU\n", per_cu); per_cu = 1; }
        (void)hipGetLastError();
        grid = cus * 1;
    }
    if (grid < 0) return;
    (void)hipMemsetAsync(d_ws, 0, 65536, stream);
    Args a{};
    for (int i = 0; i < 27; ++i) a.in[i] = (const float*)d_in[i];
    a.out = (float*)d_out; a.ws = (unsigned char*)d_ws;
#if MK_PER_PHASE
    for (int ph = 0; ph < NPH; ++ph) { a.ph_lo = ph; a.ph_hi = ph + 1; hipLaunchKernelGGL(mega_fwd, dim3(grid), dim3(NWAVES * 64), LDS_BYTES, stream, a); }
#else
    a.ph_lo = 0; a.ph_hi = NPH;
    void* params[] = {&a};
    const hipError_t e = hipLaunchCooperativeKernel((const void*)mega_fwd, dim3(grid), dim3(NWAVES * 64), params, LDS_BYTES, stream);
    if (e != hipSuccess) fprintf(stderr, "kernel_launch: cooperative launch failed: %s (grid %d)\n", hipGetErrorString(e), grid);
#endif
}
```

```cpp
#include <hip/hip_runtime.h>
#include <hip/hip_cooperative_groups.h>
#include <cstdio>
#include <cstdint>
#include <cmath>
namespace cg = cooperative_groups;
namespace pg8 {
#define PG8_LAS __attribute__((address_space(3)))
typedef unsigned short bf16_t;
typedef short bf16x8 __attribute__((ext_vector_type(8)));
typedef float f32x4 __attribute__((ext_vector_type(4)));
typedef unsigned u32x4 __attribute__((ext_vector_type(4)));
constexpr int BM = 256, BK = 64, HALF = 128, HTB = HALF * BK * 2  , STAGE_BYTES = 8 * HTB, NXCD = 8, WGM = 8;

__host__ __device__ __forceinline__ int lds_byte(int r, int c) { const int st = (r >> 4) * 2 + (c >> 5), rr = r & 15, cc = c & 31, ob = rr * 64 + cc * 2; return st * 1024 + (ob ^ (((ob >> 9) & 1) << 5)); }
__host__ __device__ __forceinline__ void stage_rc(int b, int& R, int& C) { const int st = b / 1024, sb = b % 1024, swz = sb ^ (((sb >> 9) & 1) << 5); R = (st >> 1) * 16 + swz / 64; C = (st & 1) * 32 + (swz % 64) / 2; }
__host__ __device__ __forceinline__ int perm32(int rho) { const int n = rho >> 4, i = rho & 15; return 8 * (i >> 2) + 4 * n + (i & 3); }

struct Unit { int pm, pn; };
struct Gemm { const bf16_t* A; const bf16_t* Bt; int M, N, K; };

struct StaticOrder {
    int nM, nN, nwg, G, c, nx;
    __host__ __device__ void init(int M, int N, int G_, int c_, int nx_ = NXCD) { nM = M / BM; nN = N / BM; nwg = nM * nN; G = G_; c = c_; nx = nx_; }
    __host__ __device__ bool next(int i, Unit& u) const {
        const long L = (long)i * G + c; if (L >= nwg) return false;
        int wgid = (int)L; { const int q = nwg / nx, r = nwg % nx, xcd = wgid % nx, off = wgid / nx; wgid = (xcd < r ? xcd * (q + 1) : r * (q + 1) + (xcd - r) * q) + off; }
        const int nig = WGM * nN, gid = wgid / nig, fm = gid * WGM, gsz = (nM - fm) < WGM ? (nM - fm) : WGM;
        u.pm = fm + ((wgid % nig) % gsz); u.pn = (wgid % nig) / gsz; return true;
    }
    __device__ __forceinline__ void a_ready(const Unit&) const {}
    __device__ __forceinline__ void done(const Unit&) const {}
};

__device__ __forceinline__ unsigned cvt_pk_bf16(float lo, float hi) { unsigned r; asm("v_cvt_pk_bf16_f32 %0, %1, %2" : "=v"(r) : "v"(lo), "v"(hi)); return r; }
__device__ __forceinline__ u32x4 pack8(const f32x4 a, const f32x4 b) { u32x4 w; w.x = cvt_pk_bf16(a[0], a[1]); w.y = cvt_pk_bf16(a[2], a[3]); w.z = cvt_pk_bf16(b[0], b[1]); w.w = cvt_pk_bf16(b[2], b[3]); return w; }
__device__ __forceinline__ float fast_rcp(float x) { return __builtin_amdgcn_rcpf(x); }
__device__ __forceinline__ float fast_exp2(float x) { return __builtin_amdgcn_exp2f(x); }
__device__ __forceinline__ float sigmoid_f(float x) { return fast_rcp(1.0f + fast_exp2(-1.4426950409f * x)); }
__device__ __forceinline__ float silu_f(float x) { return x * sigmoid_f(x); }
__device__ __forceinline__ float gelu_tanh_f(float v) { const float u = v + 0.044715f * v * v * v; return v * sigmoid_f(1.5957691216f * u); }
__device__ __forceinline__ float row_rs(const float* ssp, int nparts, int row) {
    const f32x4* p = (const f32x4*)(ssp + (size_t)row * 32); float s = 0.f;
#pragma unroll
    for (int i = 0; i < 4; ++i) { const f32x4 v = p[i]; s += (v[0] + v[1]) + (v[2] + v[3]); }
    if (nparts > 16) {
#pragma unroll
        for (int i = 4; i < 8; ++i) { const f32x4 v = p[i]; s += (v[0] + v[1]) + (v[2] + v[3]); } }
    return 1.0f / sqrtf(s * (1.0f / 1024.0f) + 1e-6f);
}
__device__ __forceinline__ void row_rs8(float (&rs)[8], const float* ssp, int nparts, int row0) {
#pragma unroll
    for (int h = 0; h < 2; ++h) {
#pragma unroll
        for (int i = 0; i < 4; ++i) rs[4 * h + i] = row_rs(ssp, nparts, row0 + h * HALF + i * 16);
        asm volatile("" : "+v"(rs[4 * h]), "+v"(rs[4 * h + 1]), "+v"(rs[4 * h + 2]), "+v"(rs[4 * h + 3]) :: "memory"); }
}

typedef float f32x2 __attribute__((ext_vector_type(2)));
__device__ __forceinline__ f32x2 swiglu_pk(f32x2 a, f32x2 b) {
    const f32x2 s = a * -1.4426950409f; f32x2 e; e.x = fast_exp2(s.x); e.y = fast_exp2(s.y);
    const f32x2 d = e + 1.0f; f32x2 r; r.x = fast_rcp(d.x); r.y = fast_rcp(d.y);
    return (a * r) * b;
}
struct EpiSwiglu {
    static constexpr bool PERM = true, AFTER_DRAIN = false;
    bf16_t* O; int ldo; const PG8_LAS float* rs_tab; int pmA, pmB;
    __device__ __forceinline__ void operator()(const f32x4 (&acc)[2][2][4][2], const Unit& u, int wr, int wc, int fr, int fq) const {
        const int row0 = u.pm * BM + wr * 64 + fr, col0 = u.pn * 128 + wc * 32 + 8 * fq;
        const PG8_LAS float* rt = rs_tab + (u.pm == pmA ? 0 : (u.pm == pmB ? 256 : 512)) + wr * 64 + fr;
#pragma unroll
        for (int ai = 0; ai < 2; ++ai)
#pragma unroll
            for (int m = 0; m < 4; ++m) { const int row = row0 + ai * HALF + m * 16; const float rs = rt[ai * HALF + m * 16];
                f32x4 h[2];
#pragma unroll
                for (int n = 0; n < 2; ++n) { const f32x4 a4 = acc[ai][0][m][n] * rs, b4 = acc[ai][1][m][n] * rs;
                    const f32x2 h0 = swiglu_pk((f32x2){a4[0], a4[1]}, (f32x2){b4[0], b4[1]}), h1 = swiglu_pk((f32x2){a4[2], a4[3]}, (f32x2){b4[2], b4[3]});
                    h[n] = (f32x4){h0.x, h0.y, h1.x, h1.y}; }
                *(u32x4*)(O + (size_t)row * ldo + col0) = pack8(h[0], h[1]); }
    }
};
__device__ __forceinline__ f32x4 up_lo(unsigned a, unsigned b) { f32x4 r; r[0] = __builtin_bit_cast(float, a << 16); r[1] = __builtin_bit_cast(float, a & 0xffff0000u); r[2] = __builtin_bit_cast(float, b << 16); r[3] = __builtin_bit_cast(float, b & 0xffff0000u); return r; }
#ifndef RESID_LO
#define RESID_LO 0
#endif
__device__ __forceinline__ void split_store(bf16_t* xhi, bf16_t* xlo, size_t off, const f32x4 v0, const f32x4 v1) {
    const u32x4 hw = pack8(v0, v1); *(u32x4*)(xhi + off) = hw;
    if (RESID_LO) { const f32x4 r0 = v0 - up_lo(hw.x, hw.y), r1 = v1 - up_lo(hw.z, hw.w); *(u32x4*)(xlo + off) = pack8(r0, r1); }
}
__device__ __forceinline__ void split_load(const bf16_t* xhi, const bf16_t* xlo, size_t off, f32x4& o0, f32x4& o1) {
    const u32x4 h = *(const u32x4*)(xhi + off); o0 = up_lo(h.x, h.y); o1 = up_lo(h.z, h.w);
    if (RESID_LO) { const u32x4 l = *(const u32x4*)(xlo + off); o0 += up_lo(l.x, l.y); o1 += up_lo(l.z, l.w); }
}
struct EpiResid {
    static constexpr bool PERM = true, AFTER_DRAIN = false;
    const float* xin_f32; bf16_t* xhi; bf16_t* xlo; float* ssp; float alpha;
    __device__ __forceinline__ void operator()(const f32x4 (&acc)[2][2][4][2], const Unit& u, int wr, int wc, int fr, int fq) const {
        const int row0 = u.pm * BM + wr * 64 + fr, col0 = u.pn * BM + wc * 32 + 8 * fq;
#pragma unroll
        for (int ai = 0; ai < 2; ++ai)
#pragma unroll
            for (int m = 0; m < 4; ++m) { const int row = row0 + ai * HALF + m * 16; float ss = 0.f;
#pragma unroll
                for (int bj = 0; bj < 2; ++bj) { const size_t off = (size_t)row * 1024 + col0 + bj * HALF; f32x4 o0, o1;
                    if (xin_f32) { o0 = *(const f32x4*)(xin_f32 + off); o1 = *(const f32x4*)(xin_f32 + off + 4); }
                    else split_load(xhi, xlo, off, o0, o1);
                    const f32x4 v0 = o0 + alpha * acc[ai][bj][m][0], v1 = o1 + alpha * acc[ai][bj][m][1];
                    split_store(xhi, xlo, off, v0, v1);
                    ss += (v0[0] * v0[0] + v0[1] * v0[1]) + (v0[2] * v0[2] + v0[3] * v0[3]) + (v1[0] * v1[0] + v1[1] * v1[1]) + (v1[2] * v1[2] + v1[3] * v1[3]); }
                ss += __shfl_xor(ss, 16); ss += __shfl_xor(ss, 32);
                if (fq == 0) ssp[(size_t)row * 32 + 4 * u.pn + wc] = ss; }
    }
};
struct EpiGluResid {
    static constexpr bool PERM = true, AFTER_DRAIN = false;
    bf16_t* xhi; bf16_t* xlo; float* ssp;
    __device__ __forceinline__ void operator()(const f32x4 (&acc)[2][2][4][2], const Unit& u, int wr, int wc, int fr, int fq) const {
        const int row0 = u.pm * BM + wr * 64 + fr, col0 = u.pn * 128 + wc * 32 + 8 * fq;
#pragma unroll
        for (int ai = 0; ai < 2; ++ai)
#pragma unroll
            for (int m = 0; m < 4; ++m) { const int row = row0 + ai * HALF + m * 16; const size_t off = (size_t)row * 1024 + col0;
                f32x4 o0, o1; split_load(xhi, xlo, off, o0, o1); f32x4 v0, v1;
#pragma unroll
                for (int t = 0; t < 4; ++t) { v0[t] = o0[t] + acc[ai][0][m][0][t] * sigmoid_f(acc[ai][1][m][0][t]); v1[t] = o1[t] + acc[ai][0][m][1][t] * sigmoid_f(acc[ai][1][m][1][t]); }
                split_store(xhi, xlo, off, v0, v1);
                float ss = (v0[0] * v0[0] + v0[1] * v0[1]) + (v0[2] * v0[2] + v0[3] * v0[3]) + (v1[0] * v1[0] + v1[1] * v1[1]) + (v1[2] * v1[2] + v1[3] * v1[3]);
                ss += __shfl_xor(ss, 16); ss += __shfl_xor(ss, 32);
                if (fq == 0) ssp[(size_t)row * 32 + 4 * u.pn + wc] = ss; }
    }
};
struct EpiPlain {
    static constexpr bool PERM = true, AFTER_DRAIN = false;
    bf16_t* O; int ldo;
    __device__ __forceinline__ void operator()(const f32x4 (&acc)[2][2][4][2], const Unit& u, int wr, int wc, int fr, int fq) const {
        const int row0 = u.pm * BM + wr * 64 + fr, col0 = u.pn * BM + wc * 32 + 8 * fq;
#pragma unroll
        for (int ai = 0; ai < 2; ++ai)
#pragma unroll
            for (int m = 0; m < 4; ++m) { bf16_t* rowp = O + (size_t)(row0 + ai * HALF + m * 16) * ldo + col0;
#pragma unroll
                for (int bj = 0; bj < 2; ++bj) *(u32x4*)(rowp + bj * HALF) = pack8(acc[ai][bj][m][0], acc[ai][bj][m][1]); }
    }
};
__device__ __forceinline__ float lg_gamma(int h) { return h == 0 ? -0.04580368961312479f : h == 1 ? -0.02272007650008353f : h == 2 ? -0.011315313227834146f : -0.005646563141142063f; }
struct EpiRope {
    static constexpr bool PERM = true, AFTER_DRAIN = false;
    bf16_t* Q; bf16_t* K; const float* rope; const float* ssp; int nparts; PG8_LAS f32x4* rs_lds; mutable int last_pm;
    __device__ __forceinline__ void operator()(const f32x4 (&acc)[2][2][4][2], const Unit& u, int wr, int wc, int fr, int fq) const {
        typedef unsigned u32x2 __attribute__((ext_vector_type(2)));
        const int row0 = u.pm * BM + wr * 64 + fr;
        const int head = 2 * (u.pn & 1) + (wc >> 1), jj0 = (wc & 1) * 32 + 8 * fq; bf16_t* dst = (u.pn < 2) ? Q : K;
        const float lg = lg_gamma(head);
        float rs8[8];
        if (u.pm != last_pm) { row_rs8(rs8, ssp, nparts, row0); rs_lds[0] = (f32x4){rs8[0], rs8[1], rs8[2], rs8[3]}; rs_lds[1] = (f32x4){rs8[4], rs8[5], rs8[6], rs8[7]}; last_pm = u.pm; }
        else { const f32x4 r0 = rs_lds[0], r1 = rs_lds[1]; rs8[0] = r0[0]; rs8[1] = r0[1]; rs8[2] = r0[2]; rs8[3] = r0[3]; rs8[4] = r1[0]; rs8[5] = r1[1]; rs8[6] = r1[2]; rs8[7] = r1[3]; }
#pragma unroll
        for (int ai = 0; ai < 2; ++ai)
#pragma unroll
            for (int m = 0; m < 4; ++m) { const int row = row0 + ai * HALF + m * 16, pos = row & 2047; const float rs = rs8[4 * ai + m];
                const float sc = (u.pn < 2) ? rs * fast_exp2(lg * (float)(pos & 127)) : rs * rs * 0.08838834764831845f * fast_exp2(-lg * (float)(pos & 127));
                const f32x4* rp = (const f32x4*)(rope + ((size_t)pos * 64 + jj0) * 2);
                bf16_t* rowp = dst + (size_t)row * 512 + head * 128 + jj0;
#pragma unroll
                for (int n = 0; n < 2; ++n) { const f32x4 cs0 = rp[2 * n], cs1 = rp[2 * n + 1]; const f32x4 x1 = acc[ai][0][m][n] * sc, x2 = acc[ai][1][m][n] * sc; f32x4 o1, o2;
                    o1[0] = x1[0] * cs0[0] - x2[0] * cs0[1]; o2[0] = x1[0] * cs0[1] + x2[0] * cs0[0];
                    o1[1] = x1[1] * cs0[2] - x2[1] * cs0[3]; o2[1] = x1[1] * cs0[3] + x2[1] * cs0[2];
                    o1[2] = x1[2] * cs1[0] - x2[2] * cs1[1]; o2[2] = x1[2] * cs1[1] + x2[2] * cs1[0];
                    o1[3] = x1[3] * cs1[2] - x2[3] * cs1[3]; o2[3] = x1[3] * cs1[3] + x2[3] * cs1[2];
                    u32x2 w1, w2; w1.x = cvt_pk_bf16(o1[0], o1[1]); w1.y = cvt_pk_bf16(o1[2], o1[3]); w2.x = cvt_pk_bf16(o2[0], o2[1]); w2.y = cvt_pk_bf16(o2[2], o2[3]);
                    *(u32x2*)(rowp + 4 * n) = w1; *(u32x2*)(rowp + 64 + 4 * n) = w2; } if (m == 3) asm volatile("" ::: "memory"); }
    }
};
struct EpiScaled {
    static constexpr bool PERM = true, AFTER_DRAIN = false;
    bf16_t* O; int ldo; const float* ssp; int nparts; PG8_LAS f32x4* rs_lds; mutable int last_pm;
    __device__ __forceinline__ void operator()(const f32x4 (&acc)[2][2][4][2], const Unit& u, int wr, int wc, int fr, int fq) const {
        const int row0 = u.pm * BM + wr * 64 + fr, col0 = u.pn * BM + wc * 32 + 8 * fq;
        float rs8[8];
        if (u.pm != last_pm) { row_rs8(rs8, ssp, nparts, row0); rs_lds[0] = (f32x4){rs8[0], rs8[1], rs8[2], rs8[3]}; rs_lds[1] = (f32x4){rs8[4], rs8[5], rs8[6], rs8[7]}; last_pm = u.pm; }
        else { const f32x4 r0 = rs_lds[0], r1 = rs_lds[1]; rs8[0] = r0[0]; rs8[1] = r0[1]; rs8[2] = r0[2]; rs8[3] = r0[3]; rs8[4] = r1[0]; rs8[5] = r1[1]; rs8[6] = r1[2]; rs8[7] = r1[3]; }
#pragma unroll
        for (int ai = 0; ai < 2; ++ai)
#pragma unroll
            for (int m = 0; m < 4; ++m) { const int row = row0 + ai * HALF + m * 16; const float rs = rs8[4 * ai + m]; bf16_t* rowp = O + (size_t)row * ldo + col0;
#pragma unroll
                for (int bj = 0; bj < 2; ++bj) *(u32x4*)(rowp + bj * HALF) = pack8(acc[ai][bj][m][0] * rs, acc[ai][bj][m][1] * rs); }
    }
};

struct EpiNull {
    static constexpr bool PERM = true, AFTER_DRAIN = false;
    __device__ __forceinline__ void operator()(const f32x4 (&acc)[2][2][4][2], const Unit& u, int wr, int wc, int fr, int fq) const {
        float s = 0.f;
#pragma unroll
        for (int ai = 0; ai < 2; ++ai)
#pragma unroll
            for (int bj = 0; bj < 2; ++bj)
#pragma unroll
                for (int m = 0; m < 4; ++m) s += acc[ai][bj][m][0][0] + acc[ai][bj][m][1][3];
        asm volatile("" :: "v"(s));
    }
};

template <class Epi, class Sched, bool ALIGN_EPI = false, bool SP2 = false>
__device__ __forceinline__ void gemm_phase(PG8_LAS unsigned char* lds, const Gemm g, const Sched& S, const Epi& E, int tid_in) {
    int tid_ = tid_in; asm volatile("" : "+v"(tid_));
    const int tid = tid_, wid = __builtin_amdgcn_readfirstlane(tid >> 6), lane = tid & 63, wr = wid >> 2, wc = wid & 3, fr = lane & 15, fq = lane >> 4;
    const int K = g.K, nt = K / BK;
    unsigned voffA[2], voffB[2];
#pragma unroll
    for (int i = 0; i < 2; ++i) { int R, C; stage_rc(tid * 16 + i * 8192, R, C); const int Rb = Epi::PERM ? ((R & ~31) + perm32(R & 31)) : R;
        voffA[i] = (unsigned)(R * K + C) * 2u; voffB[i] = (unsigned)(Rb * K + C) * 2u; }
    const size_t kstep = (size_t)(BK * 2);
    const size_t hstep = (size_t)HALF * K * 2;
    const size_t tstep = 2 * hstep;
    const unsigned ldsw = (unsigned)wid * 1024u;
    const int aoff = lds_byte(wr * 64 + fr, fq * 8), boff = lds_byte(wc * 32 + fr, fq * 8);
#define PG8_SA(b, h) (((b) * 2 + (h)) * HTB)
#define PG8_SB(b, h) ((4 + (b) * 2 + (h)) * HTB)
#define PG8_STAGE(bufoff, gbase, voff) do { _Pragma("unroll") for (int _i = 0; _i < 2; ++_i) \
        __builtin_amdgcn_global_load_lds((const unsigned*)((const char*)(gbase) + (voff)[_i]), (PG8_LAS unsigned*)(lds + (bufoff) + ldsw + _i * 8192), 16, 0, 0); } while (0)
#define PG8_LDA(dst, b, h) do { _Pragma("unroll") for (int m = 0; m < 4; ++m) _Pragma("unroll") for (int k = 0; k < 2; ++k) dst[m][k] = *(const PG8_LAS bf16x8*)(lds + PG8_SA(b, h) + aoff + m * 2048 + k * 1024); } while (0)
#define PG8_LDB(dst, b, h) do { _Pragma("unroll") for (int n = 0; n < 2; ++n) _Pragma("unroll") for (int k = 0; k < 2; ++k) dst[n][k] = *(const PG8_LAS bf16x8*)(lds + PG8_SB(b, h) + boff + n * 2048 + k * 1024); } while (0)
#define PG8_MMA(ai, bj, At, Bt) do { __builtin_amdgcn_s_setprio(1); _Pragma("unroll") for (int m = 0; m < 4; ++m) _Pragma("unroll") for (int n = 0; n < 2; ++n) _Pragma("unroll") for (int k = 0; k < 2; ++k) \
        acc[ai][bj][m][n] = __builtin_amdgcn_mfma_f32_16x16x32_bf16(Bt[n][k], At[m][k], acc[ai][bj][m][n], 0, 0, 0); __builtin_amdgcn_s_setprio(0); } while (0)
#define PG8_WAIT_V(n) asm volatile("s_waitcnt vmcnt(" #n ")" ::: "memory")
#define PG8_WAIT_L(n) asm volatile("s_waitcnt lgkmcnt(" #n ")" ::: "memory")
#define PG8_BAR __builtin_amdgcn_s_barrier()
#define PG8_SCHED __builtin_amdgcn_sched_barrier(0)
    Unit cur, nxt; int ui = 0;
    if (!S.next(0, cur)) return;
    f32x4 acc[2][2][4][2];
#pragma unroll
    for (int a = 0; a < 2; ++a)
#pragma unroll
        for (int b = 0; b < 2; ++b)
#pragma unroll
            for (int m = 0; m < 4; ++m)
#pragma unroll
                for (int n = 0; n < 2; ++n) acc[a][b][m][n] = (f32x4){0.f, 0.f, 0.f, 0.f};
    bf16x8 At[4][2], B0[2][2], B1[2][2];
    const char* cA = (const char*)g.A + (size_t)cur.pm * tstep; const char* cB = (const char*)g.Bt + (size_t)cur.pn * tstep;
    S.a_ready(cur);
    if constexpr (SP2) {
        PG8_STAGE(PG8_SB(0, 0), cB, voffB); PG8_STAGE(PG8_SB(0, 1), cB + hstep, voffB); PG8_STAGE(PG8_SA(0, 0), cA, voffA); PG8_STAGE(PG8_SA(0, 1), cA + hstep, voffA);
        if (wr == 1) PG8_BAR;
        PG8_WAIT_V(2); PG8_BAR;
        PG8_STAGE(PG8_SB(1, 0), cB + kstep, voffB); PG8_STAGE(PG8_SA(1, 0), cA + kstep, voffA); PG8_STAGE(PG8_SB(1, 1), cB + hstep + kstep, voffB);
        PG8_WAIT_V(6); PG8_BAR;
    } else {
        PG8_STAGE(PG8_SB(0, 0), cB, voffB); PG8_STAGE(PG8_SA(0, 0), cA, voffA); PG8_STAGE(PG8_SB(0, 1), cB + hstep, voffB); PG8_STAGE(PG8_SA(0, 1), cA + hstep, voffA);
        if (wr == 1) PG8_BAR;
        PG8_WAIT_V(4); PG8_BAR;
        PG8_STAGE(PG8_SB(1, 0), cB + kstep, voffB); PG8_STAGE(PG8_SA(1, 0), cA + kstep, voffA); PG8_STAGE(PG8_SB(1, 1), cB + hstep + kstep, voffB);
        PG8_WAIT_V(6); PG8_BAR;
    }
    for (;;) {
        const bool has_next = S.next(ui + 1, nxt);
        const char* nA = has_next ? (const char*)g.A + (size_t)nxt.pm * tstep : cA; const char* nB = has_next ? (const char*)g.Bt + (size_t)nxt.pn * tstep : cB;
        for (int t = 0; t < nt; t += 2) {
            const bool last = (t == nt - 2);
            const char* a1 = cA + (size_t)(t + 1) * kstep;
            const char* a2 = last ? nA : cA + (size_t)(t + 2) * kstep; const char* b2 = last ? nB : cB + (size_t)(t + 2) * kstep;
            const char* a3 = a2 + kstep; const char* b3 = b2 + kstep;
            if (last && has_next) S.a_ready(nxt);
            if constexpr (SP2) {
            PG8_LDB(B0, 0, 0); PG8_LDB(B1, 0, 1); PG8_SCHED; PG8_LDA(At, 0, 0); PG8_STAGE(PG8_SA(1, 1), a1 + hstep, voffA);
            PG8_WAIT_V(8); PG8_WAIT_L(0); PG8_BAR; PG8_MMA(0, 0, At, B0); PG8_MMA(0, 1, At, B1); PG8_BAR; PG8_SCHED;
            PG8_LDA(At, 0, 1); PG8_STAGE(PG8_SB(0, 0), b2, voffB); PG8_STAGE(PG8_SB(0, 1), b2 + hstep, voffB); PG8_STAGE(PG8_SA(0, 0), a2, voffA);
            PG8_WAIT_V(8); PG8_WAIT_L(0); PG8_BAR; PG8_MMA(1, 0, At, B0); PG8_MMA(1, 1, At, B1); PG8_BAR; PG8_SCHED;
            PG8_LDB(B0, 1, 0); PG8_LDB(B1, 1, 1); PG8_SCHED; PG8_LDA(At, 1, 0); PG8_STAGE(PG8_SA(0, 1), a2 + hstep, voffA);
            PG8_WAIT_V(8); PG8_WAIT_L(0); PG8_BAR; PG8_MMA(0, 0, At, B0); PG8_MMA(0, 1, At, B1); PG8_BAR; PG8_SCHED;
            PG8_LDA(At, 1, 1); PG8_STAGE(PG8_SB(1, 0), b3, voffB); PG8_STAGE(PG8_SB(1, 1), b3 + hstep, voffB); PG8_STAGE(PG8_SA(1, 0), a3, voffA);
            PG8_WAIT_V(8); PG8_WAIT_L(0); PG8_BAR; PG8_MMA(1, 0, At, B0); PG8_MMA(1, 1, At, B1); PG8_BAR; PG8_SCHED;
            } else {
            PG8_LDB(B0, 0, 0); PG8_SCHED; PG8_LDA(At, 0, 0); PG8_STAGE(PG8_SA(1, 1), a1 + hstep, voffA);
            PG8_WAIT_L(8); PG8_BAR; PG8_WAIT_L(0); PG8_MMA(0, 0, At, B0); PG8_BAR; PG8_SCHED;
            PG8_LDB(B1, 0, 1); PG8_STAGE(PG8_SB(0, 0), b2, voffB);
            PG8_BAR; PG8_WAIT_L(0); PG8_MMA(0, 1, At, B1); PG8_BAR;
            PG8_LDA(At, 0, 1); PG8_STAGE(PG8_SA(0, 0), a2, voffA);
            PG8_BAR; PG8_WAIT_L(0); PG8_MMA(1, 0, At, B0); PG8_BAR; PG8_SCHED;
            PG8_STAGE(PG8_SB(0, 1), b2 + hstep, voffB);
            PG8_WAIT_V(6); PG8_BAR; PG8_MMA(1, 1, At, B1); PG8_BAR;
            PG8_LDB(B0, 1, 0); PG8_SCHED; PG8_LDA(At, 1, 0); PG8_STAGE(PG8_SA(0, 1), a2 + hstep, voffA);
            PG8_WAIT_L(8); PG8_BAR; PG8_WAIT_L(0); PG8_MMA(0, 0, At, B0); PG8_BAR; PG8_SCHED;
            PG8_LDB(B1, 1, 1); PG8_STAGE(PG8_SB(1, 0), b3, voffB);
            PG8_BAR; PG8_WAIT_L(0); PG8_MMA(0, 1, At, B1); PG8_BAR;
            PG8_LDA(At, 1, 1); PG8_STAGE(PG8_SA(1, 0), a3, voffA);
            PG8_BAR; PG8_WAIT_L(0); PG8_MMA(1, 0, At, B0); PG8_BAR; PG8_SCHED;
            PG8_STAGE(PG8_SB(1, 1), b3 + hstep, voffB);
            PG8_WAIT_V(6); PG8_BAR; PG8_MMA(1, 1, At, B1); PG8_BAR;
            }
        }
        if constexpr (ALIGN_EPI) { if (wr == 0) PG8_BAR; }
        if constexpr (!Epi::AFTER_DRAIN) { E(acc, cur, wr, wc, fr, fq); S.done(cur); }
        if (!has_next) break;
#pragma unroll
        for (int a = 0; a < 2; ++a)
#pragma unroll
            for (int b = 0; b < 2; ++b)
#pragma unroll
                for (int m = 0; m < 4; ++m)
#pragma unroll
                    for (int n = 0; n < 2; ++n) acc[a][b][m][n] = (f32x4){0.f, 0.f, 0.f, 0.f};
        cur = nxt; cA = nA; cB = nB; ++ui;
        if constexpr (ALIGN_EPI) { if (wr == 1) PG8_BAR; }
    }
    PG8_WAIT_V(0);
    if constexpr (!ALIGN_EPI) { if (wr == 0) PG8_BAR; }
    PG8_BAR;
    if constexpr (Epi::AFTER_DRAIN) { E.fused(acc, cur, wr, wc, fr, fq, lds, wid, lane); S.done(cur); }
#undef PG8_SA
#undef PG8_SB
#undef PG8_STAGE
#undef PG8_LDA
#undef PG8_LDB
#undef PG8_MMA
#undef PG8_WAIT_V
#undef PG8_WAIT_L
#undef PG8_BAR
#undef PG8_SCHED
}
}

#define GAS __attribute__((address_space(1)))
#define LAS __attribute__((address_space(3)))
typedef unsigned short bf16;
typedef unsigned v4u __attribute__((ext_vector_type(4)));
typedef unsigned v2u __attribute__((ext_vector_type(2)));
typedef float f32x4 __attribute__((ext_vector_type(4)));
typedef float f32x2 __attribute__((ext_vector_type(2)));
typedef float f32x16 __attribute__((ext_vector_type(16)));
typedef short bf16x8 __attribute__((ext_vector_type(8)));
#define LDS_WAIT() asm volatile("s_waitcnt lgkmcnt(0)" ::: "memory")
using pg8::cvt_pk_bf16; using pg8::pack8; using pg8::sigmoid_f; using pg8::silu_f; using pg8::gelu_tanh_f; using pg8::row_rs; using pg8::fast_exp2;

#ifndef PHM
#define PHM 255
#endif
#ifndef PROBE_NULLM
#define PROBE_NULLM 0
#endif
#ifndef PROBE_MIXM
#define PROBE_MIXM 0
#endif
#ifndef SKEW_TICKS
#define SKEW_TICKS 0ull
#endif
#ifndef LATE_IN_S5
#define LATE_IN_S5 0
#endif
#ifndef PROBE_DUPM
#define PROBE_DUPM 0
#endif
#ifndef MK_PER_PHASE
#define MK_PER_PHASE 0
#endif
constexpr int NWAVES = 8;
constexpr int BATCH = 16, SEQ = 2048, D = 1024, FF = 2816, TOK = BATCH * SEQ;
constexpr int NPH = 15;
constexpr size_t MiB = 1u << 20;
constexpr size_t WS_W13 = 1 * MiB;
constexpr size_t WS_W2 = 45 * MiB;
constexpr size_t WS_WIN = 67 * MiB;
constexpr size_t WS_WV = 72 * MiB;
constexpr size_t WS_WOUT = 73 * MiB;
constexpr size_t WS_WGLU = 75 * MiB;
constexpr size_t WS_WLRU = 79 * MiB;
constexpr size_t WS_ROPE = 80 * MiB;
constexpr size_t WS_SSP = 81 * MiB;
constexpr size_t WS_XB = 96 * MiB;
constexpr size_t WS_R1 = 160 * MiB;
constexpr size_t WS_Q = WS_R1, WS_K = WS_R1 + 32 * MiB, WS_VT = WS_R1 + 64 * MiB, WS_G = WS_R1 + 97 * MiB;
constexpr int VT_LD = TOK + 64;
constexpr size_t WS_MRG = 354 * MiB;
constexpr size_t WS_XLO = 418 * MiB;
constexpr size_t WS_END = 482 * MiB;
constexpr int LDS_BYTES = 163840;

__device__ __forceinline__ unsigned f2bf(float f) { unsigned u = __builtin_bit_cast(unsigned, f); return (u + 0x7fffu + ((u >> 16) & 1u)) >> 16; }
__device__ __forceinline__ unsigned pk2(float lo, float hi) { return f2bf(lo) | (f2bf(hi) << 16); }
__device__ __forceinline__ float bf_lo(unsigned w) { return __builtin_bit_cast(float, w << 16); }
__device__ __forceinline__ float bf_hi(unsigned w) { return __builtin_bit_cast(float, w & 0xffff0000u); }
__device__ __forceinline__ float bf1(bf16 h) { return __builtin_bit_cast(float, (unsigned)h << 16); }
__device__ __forceinline__ float wave_sum(float v) {
#pragma unroll
    for (int o = 1; o < 64; o <<= 1) v += __shfl_xor(v, o);
    return v;
}
__device__ __forceinline__ f32x4 mfma16(bf16x8 a, bf16x8 b, f32x4 c) { return __builtin_amdgcn_mfma_f32_16x16x32_bf16(a, b, c, 0, 0, 0); }

__device__ __forceinline__ void transpose_item(const float* __restrict__ W, int N, int K, const float* __restrict__ gk, bf16* WT, int dst_row, int k0, int n0, LAS float* scr, int lane) {
    { float v[32];
#pragma unroll
      for (int i = 0; i < 32; ++i) v[i] = W[(size_t)(k0 + 2 * i + (lane >> 5)) * N + n0 + (lane & 31)];
      if (gk) { const float gl = gk[k0 + lane];
#pragma unroll
          for (int i = 0; i < 32; ++i) v[i] *= __shfl(gl, 2 * i + (lane >> 5)); }
#pragma unroll
      for (int i = 0; i < 32; ++i) scr[(2 * i + (lane >> 5)) * 33 + (lane & 31)] = v[i]; }
    LDS_WAIT(); asm volatile("" ::: "memory");
    const int c = lane & 7;
#pragma unroll
    for (int j = 0; j < 4; ++j) { const int n = (lane >> 3) + 8 * j; const LAS float* s = scr + (8 * c) * 33 + n;
        v4u o; o.x = pk2(s[0 * 33], s[1 * 33]); o.y = pk2(s[2 * 33], s[3 * 33]); o.z = pk2(s[4 * 33], s[5 * 33]); o.w = pk2(s[6 * 33], s[7 * 33]);
        *(v4u*)(WT + (size_t)(dst_row + n) * K + k0 + 8 * c) = o; }
    LDS_WAIT(); asm volatile("" ::: "memory");
}
struct Args { const float* in[27]; float* out; unsigned char* ws; int ph_lo, ph_hi; };
typedef const __attribute__((address_space(4))) Args* KArgP;

template <bool LATE> __device__ __forceinline__ void p0_weights(KArgP ap, LAS float* scr, int gw, int NGW, int lane) {
    unsigned char* ws = ap->ws;
    constexpr int I_F = 1408, I_IN = 1536, I_OUT = 512, I_GL = 512, I_LRU = 64;
    constexpr int NITEMS = 12 * I_F + I_IN + I_OUT + 2 * I_GL + I_LRU;
    for (int it = gw; it < NITEMS; it += NGW) {
        int r = it;
        if (r < 8 * I_F) { const int w3 = r >= 4 * I_F; if (w3) r -= 4 * I_F; const int l = r / I_F; r -= l * I_F; if ((l == 3) != LATE) continue; const int kb = r / 88, nb = r % 88, n0 = 32 * nb;
            transpose_item(ap->in[w3 ? 3 : 2] + (size_t)l * D * FF, FF, D, ap->in[1] + l * D, (bf16*)(ws + WS_W13) + (size_t)l * 5632 * 1024, 256 * (n0 >> 7) + (n0 & 127) + (w3 ? 128 : 0), 64 * kb, n0, scr, lane); continue; }
        r -= 8 * I_F;
        if (r < 4 * I_F) { const int l = r / I_F; r -= l * I_F; if ((l == 3) != LATE) continue; const int kb = r / 32, nb = r % 32;
            transpose_item(ap->in[4] + (size_t)l * FF * D, D, FF, nullptr, (bf16*)(ws + WS_W2) + (size_t)l * 1024 * FF, 32 * nb, 64 * kb, 32 * nb, scr, lane); continue; }
        r -= 4 * I_F;
        if (r < I_IN) { if (LATE) continue; const int kb = r / 96, nb = r % 96, n0 = 32 * nb; bf16* dst; int drow;
            if (n0 < 1024) { const int sec = n0 >> 9, nn = n0 & 511, h = nn >> 7, bj = (nn >> 6) & 1, jj0 = nn & 63; dst = (bf16*)(ws + WS_WIN); drow = 512 * sec + 256 * (h >> 1) + 128 * bj + 64 * (h & 1) + jj0; }
            else if (n0 < 1536) { dst = (bf16*)(ws + WS_WV); drow = n0 - 1024; }
            else { dst = (bf16*)(ws + WS_WIN); drow = n0 - 512; }
            transpose_item(ap->in[6], 3072, D, ap->in[5], dst, drow, 64 * kb, n0, scr, lane); continue; }
        r -= I_IN;
        if (r < I_OUT) { if (LATE) continue; const int kb = r / 32, nb = r % 32; transpose_item(ap->in[7], D, D, nullptr, (bf16*)(ws + WS_WOUT), 32 * nb, 64 * kb, 32 * nb, scr, lane); continue; }
        r -= I_OUT;
        if (r < 2 * I_GL) { if (!LATE) continue; const int wb = r >= I_GL; if (wb) r -= I_GL; const int kb = r / 32, nb = r % 32, n0 = 32 * nb;
            transpose_item(ap->in[wb ? 25 : 24], D, D, nullptr, (bf16*)(ws + WS_WGLU), 256 * (n0 >> 7) + (n0 & 127) + (wb ? 128 : 0), 64 * kb, n0, scr, lane); continue; }
        r -= 2 * I_GL;
        if (LATE) continue;
        { const int mat = r >> 3, g = mat >> 1, gate = mat & 1, kb = (r >> 2) & 1, nb = r & 3;
            transpose_item(ap->in[gate ? 13 : 11] + (size_t)g * 128 * 128, 128, 128, nullptr, (bf16*)(ws + WS_WLRU) + (size_t)mat * 128 * 128, 32 * nb, 64 * kb, 32 * nb, scr, lane); }
    }
}
__device__ __forceinline__ void p0_prologue(KArgP ap, LAS unsigned char* lds, int gw, int NGW, int wave, int lane) {
    unsigned char* ws = ap->ws;
    p0_weights<false>(ap, (LAS float*)(lds + wave * 16384), gw, NGW, lane);
    if (!LATE_IN_S5) p0_weights<true>(ap, (LAS float*)(lds + wave * 16384), gw, NGW, lane);
    { float* rope = (float*)(ws + WS_ROPE);
      for (int i = gw * 64 + lane; i < 2048 * 64; i += NGW * 64) { const int pos = i >> 6, j = i & 63; const double inv = pow(10000.0, -(double)j / 64.0); const double ang = (double)pos * inv;
          rope[2 * i] = (float)cos(ang); rope[2 * i + 1] = (float)sin(ang); } }
    { const float* x = ap->in[0]; bf16* xb = (bf16*)(ws + WS_XB); float* ssp = (float*)(ws + WS_SSP);
      for (int m0 = 2 * gw; m0 < TOK; m0 += 2 * NGW) { f32x4 v[2][4]; float s[2];
#pragma unroll
          for (int h = 0; h < 2; ++h) { const f32x4* xr = (const f32x4*)(x + (size_t)(m0 + h) * D) + lane;
#pragma unroll
              for (int j = 0; j < 4; ++j) v[h][j] = xr[64 * j]; }
#pragma unroll
          for (int h = 0; h < 2; ++h) { float t = 0.f;
#pragma unroll
              for (int j = 0; j < 4; ++j) t += (v[h][j][0] * v[h][j][0] + v[h][j][1] * v[h][j][1]) + (v[h][j][2] * v[h][j][2] + v[h][j][3] * v[h][j][3]);
              s[h] = wave_sum(t);
              v2u* o8 = (v2u*)(xb + (size_t)(m0 + h) * D) + lane;
#pragma unroll
              for (int j = 0; j < 4; ++j) { v2u w; w.x = cvt_pk_bf16(v[h][j][0], v[h][j][1]); w.y = cvt_pk_bf16(v[h][j][2], v[h][j][3]); o8[64 * j] = w; }
              if (lane < 16) ssp[(size_t)(m0 + h) * 32 + lane] = lane == 0 ? s[h] : 0.f; } } }
}

__device__ __forceinline__ void ret_unit(int b, int h, int p, const bf16* Q, const bf16* Kb, const bf16* Vt, const bf16* G, const float* ret_g, bf16* MRG, LAS unsigned char* lds, int tid, int wid, int lane) {
    const int fr = lane & 15, fq = lane >> 4;
    const int cq = 2 * p + (wid >> 2), iloc0 = 32 * (wid & 3);
    const size_t tok0 = (size_t)b * SEQ + 256 * p + 32 * wid;
    const float lg = log2f(1.0f - exp2f(-5.0f - (float)h));
    bf16x8 qf[2][4];
#pragma unroll
    for (int mi = 0; mi < 2; ++mi)
#pragma unroll
        for (int kk = 0; kk < 4; ++kk) qf[mi][kk] = *(const bf16x8*)(Q + (tok0 + 16 * mi + fr) * 512 + h * 128 + 32 * kk + 8 * fq);
    f32x4 O[2][8];
#pragma unroll
    for (int mi = 0; mi < 2; ++mi)
#pragma unroll
        for (int e = 0; e < 8; ++e) O[mi][e] = (f32x4){0.f, 0.f, 0.f, 0.f};
    const int nm = 2 * p + 2;
    const int srow = 4 * wid + (lane >> 4), keyK = ((wid >> 1) & 3) * 4 + (lane >> 4), keyV = 4 * (wid & 3) + (lane >> 4);
    const bf16* kbase = Kb + ((size_t)b * SEQ + srow) * 512 + h * 128 + 8 * ((lane & 15) ^ keyK);
    const bf16* vbase = Vt + ((size_t)(h * 128 + srow)) * VT_LD + (size_t)b * SEQ + 8 * ((lane & 15) ^ keyV);
#define RET_STAGE(m_, buf_) do { _Pragma("unroll") for (int i = 0; i < 4; ++i) { \
        __builtin_amdgcn_global_load_lds((const unsigned*)(kbase + ((size_t)(128 * (m_) + 32 * i)) * 512), (LAS unsigned*)(lds + (buf_) * 65536 + (8 * i + wid) * 1024), 16, 0, 0); \
        __builtin_amdgcn_global_load_lds((const unsigned*)(vbase + (size_t)(32 * i) * VT_LD + 128 * (m_)), (LAS unsigned*)(lds + (buf_) * 65536 + 32768 + (8 * i + wid) * 1024), 16, 0, 0); } } while (0)
    RET_STAGE(0, 0);
    asm volatile("s_waitcnt vmcnt(0)" ::: "memory"); __syncthreads();
    for (int m = 0; m < nm; ++m) {
        const int buf = m & 1;
        if (m + 1 < nm) RET_STAGE(m + 1, buf ^ 1);
        if (m <= cq) {
            const LAS unsigned char* Kl = lds + buf * 65536; const LAS unsigned char* Vl = Kl + 32768;
            const float sc = fast_exp2(lg * (float)(128 * (cq - m)));
#pragma unroll
            for (int g32 = 0; g32 < 4; ++g32) {
                f32x4 S[2][2];
#pragma unroll
                for (int n = 0; n < 2; ++n) { S[0][n] = (f32x4){0.f, 0.f, 0.f, 0.f}; S[1][n] = (f32x4){0.f, 0.f, 0.f, 0.f};
                    const int krow = 32 * g32 + 8 * (fr >> 2) + 4 * n + (fr & 3);
#pragma unroll
                    for (int kk = 0; kk < 4; ++kk) { const bf16x8 kf = *(const LAS bf16x8*)(Kl + krow * 256 + (((4 * kk + fq) ^ fr) << 4));
                        S[0][n] = mfma16(kf, qf[0][kk], S[0][n]); S[1][n] = mfma16(kf, qf[1][kk], S[1][n]); } }
                bf16x8 pf[2];
#pragma unroll
                for (int mi = 0; mi < 2; ++mi) { f32x4 v0 = S[mi][0] * sc, v1 = S[mi][1] * sc;
                    if (m == cq) { const int il = iloc0 + 16 * mi + fr, jl = 32 * g32 + 8 * fq;
#pragma unroll
                        for (int t = 0; t < 4; ++t) { v0[t] = (jl + t <= il) ? v0[t] : 0.f; v1[t] = (jl + 4 + t <= il) ? v1[t] : 0.f; } }
                    const pg8::u32x4 w = pack8(v0, v1); pf[mi] = __builtin_bit_cast(bf16x8, w); }
#pragma unroll
                for (int ef = 0; ef < 8; ++ef) { const int vrow = 16 * ef + fr;
                    const bf16x8 vf = *(const LAS bf16x8*)(Vl + vrow * 256 + (((4 * g32 + fq) ^ fr) << 4));
                    O[0][ef] = mfma16(vf, pf[0], O[0][ef]); O[1][ef] = mfma16(vf, pf[1], O[1][ef]); }
            }
        }
        asm volatile("s_waitcnt vmcnt(0)" ::: "memory"); __syncthreads();
    }
#undef RET_STAGE
#pragma unroll
    for (int mi = 0; mi < 2; ++mi) { const size_t tok = tok0 + 16 * mi + fr; float s = 0.f;
#pragma unroll
        for (int ef = 0; ef < 8; ++ef) s += (O[mi][ef][0] + O[mi][ef][1]) + (O[mi][ef][2] + O[mi][ef][3]);
        s += __shfl_xor(s, 16); s += __shfl_xor(s, 32); const float mu = s * (1.0f / 128.0f); float q = 0.f;
#pragma unroll
        for (int ef = 0; ef < 8; ++ef) { const f32x4 d = O[mi][ef] - mu; q += (d[0] * d[0] + d[1] * d[1]) + (d[2] * d[2] + d[3] * d[3]); }
        q += __shfl_xor(q, 16); q += __shfl_xor(q, 32); const float rstd = 1.0f / sqrtf(q * (1.0f / 128.0f) + 1e-6f);
#pragma unroll
        for (int ef = 0; ef < 8; ++ef) { const int col = h * 128 + 16 * ef + 4 * fq; const f32x4 gn = *(const f32x4*)(ret_g + col); const v2u gr = *(const v2u*)(G + tok * 1536 + col);
            const float g0 = bf_lo(gr.x), g1 = bf_hi(gr.x), g2 = bf_lo(gr.y), g3 = bf_hi(gr.y);
            const float y0 = (O[mi][ef][0] - mu) * rstd * gn[0] * silu_f(g0), y1 = (O[mi][ef][1] - mu) * rstd * gn[1] * silu_f(g1);
            const float y2 = (O[mi][ef][2] - mu) * rstd * gn[2] * silu_f(g2), y3 = (O[mi][ef][3] - mu) * rstd * gn[3] * silu_f(g3);
            v2u w; w.x = cvt_pk_bf16(y0, y1); w.y = cvt_pk_bf16(y2, y3); *(v2u*)(MRG + tok * 1024 + col) = w; } }
}

constexpr int LRU_XT = 0, LRU_A = 66560, LRU_BX = 99328, LRU_WF = 132096, LRU_CW = 148480, LRU_CB = 150528, LRU_SEG = 151040, LRU_CAR = 155136;
__device__ __forceinline__ void lru_unit(int b, int g, int q, const bf16* G, const bf16* LW, const float* conv_w, const float* conv_b, const float* b_a, const float* b_i, const float* lam,
                                         bf16* MRG, LAS unsigned char* lds, int tid, int wid, int lane) {
    const int fr = lane & 15, fq = lane >> 4;
    LAS unsigned char* XT = lds + LRU_XT; LAS float* A_ = (LAS float*)(lds + LRU_A); LAS float* BX = (LAS float*)(lds + LRU_BX); LAS unsigned char* WF = lds + LRU_WF;
    LAS float* CW = (LAS float*)(lds + LRU_CW); LAS float* CB = (LAS float*)(lds + LRU_CB); LAS float* SEG = (LAS float*)(lds + LRU_SEG); LAS float* CAR = (LAS float*)(lds + LRU_CAR);
    const bf16* xl = G + (size_t)b * SEQ * 1536 + 512 + 128 * g;
    {
      for (int i = tid; i < 64 * 16; i += 512) { const int r = i >> 4, c = i & 15; const v4u w = *(const v4u*)(LW + ((size_t)((g * 2 + (r >> 5)) * 128 + 32 * q + (r & 31))) * 128 + 8 * c); *(LAS v4u*)(WF + r * 256 + ((c ^ (r & 15)) << 4)) = w; }
      CW[tid] = conv_w[(tid >> 7) * 512 + 128 * g + (tid & 127)]; if (tid < 128) CB[tid] = conv_b[128 * g + tid]; }
    f32x4 gba[2], gbi[2], gsp[2];
#pragma unroll
    for (int nfl = 0; nfl < 2; ++nfl) { const int cg0 = 128 * g + 32 * q + 16 * nfl + 4 * fq; gba[nfl] = *(const f32x4*)(b_a + cg0); gbi[nfl] = *(const f32x4*)(b_i + cg0); const f32x4 lm = *(const f32x4*)(lam + cg0);
#pragma unroll
        for (int t = 0; t < 4; ++t) gsp[nfl][t] = -8.0f * 1.4426950408889634f * log1pf(__expf(-lm[t])); }
    for (int tile = 0; tile < 8; ++tile) {
        { v4u xs[9];
#pragma unroll
          for (int k9 = 0; k9 < 9; ++k9) { const int i = tid + 512 * k9, j = (i >> 4) < 258 ? (i >> 4) : 258, c = i & 15, sp = 256 * tile - 3 + j;
              xs[k9] = *(const v4u*)(xl + (size_t)(sp < 0 ? 0 : sp) * 1536 + 8 * c); if (sp < 0) xs[k9] = (v4u){0u, 0u, 0u, 0u}; }
#pragma unroll
          for (int k9 = 0; k9 < 9; ++k9) { const int i = tid + 512 * k9, j = i >> 4, c = i & 15; if (i < 259 * 16) *(LAS v4u*)(XT + j * 256 + ((c ^ (j & 15)) << 4)) = xs[k9]; } }
        __syncthreads();
        const int r0 = 32 * wid;
        f32x4 acc[2][4];
#pragma unroll
        for (int mi = 0; mi < 2; ++mi)
#pragma unroll
            for (int nf = 0; nf < 4; ++nf) acc[mi][nf] = (f32x4){0.f, 0.f, 0.f, 0.f};
#pragma unroll 1
        for (int kk = 0; kk < 4; ++kk) { const int c16 = 4 * kk + fq, ch0 = 8 * c16;
            bf16x8 wf[4];
#pragma unroll
            for (int nf = 0; nf < 4; ++nf) { const int r = 32 * (nf >> 1) + 16 * (nf & 1) + fr; wf[nf] = *(const LAS bf16x8*)(WF + r * 256 + ((c16 ^ (r & 15)) << 4)); }
            f32x4 cw[4][2], cb[2];
            cb[0] = *(const LAS f32x4*)(CB + ch0); cb[1] = *(const LAS f32x4*)(CB + ch0 + 4);
#pragma unroll
            for (int tap = 0; tap < 4; ++tap) { cw[tap][0] = *(const LAS f32x4*)(CW + tap * 128 + ch0); cw[tap][1] = *(const LAS f32x4*)(CW + tap * 128 + ch0 + 4); }
#pragma unroll
            for (int mi = 0; mi < 2; ++mi) { float xc[8];
                xc[0] = cb[0][0]; xc[1] = cb[0][1]; xc[2] = cb[0][2]; xc[3] = cb[0][3]; xc[4] = cb[1][0]; xc[5] = cb[1][1]; xc[6] = cb[1][2]; xc[7] = cb[1][3];
#pragma unroll
                for (int tap = 0; tap < 4; ++tap) { const int j = r0 + 16 * mi + fr + tap; const v4u x4 = *(const LAS v4u*)(XT + j * 256 + ((c16 ^ (j & 15)) << 4)); const f32x4 w0 = cw[tap][0], w1 = cw[tap][1];
                    xc[0] += w0[0] * bf_lo(x4.x); xc[1] += w0[1] * bf_hi(x4.x); xc[2] += w0[2] * bf_lo(x4.y); xc[3] += w0[3] * bf_hi(x4.y);
                    xc[4] += w1[0] * bf_lo(x4.z); xc[5] += w1[1] * bf_hi(x4.z); xc[6] += w1[2] * bf_lo(x4.w); xc[7] += w1[3] * bf_hi(x4.w); }
                pg8::u32x4 aw; aw.x = cvt_pk_bf16(xc[0], xc[1]); aw.y = cvt_pk_bf16(xc[2], xc[3]); aw.z = cvt_pk_bf16(xc[4], xc[5]); aw.w = cvt_pk_bf16(xc[6], xc[7]);
                const bf16x8 af = __builtin_bit_cast(bf16x8, aw);
#pragma unroll
                for (int nf = 0; nf < 4; ++nf) acc[mi][nf] = mfma16(wf[nf], af, acc[mi][nf]); } }
#pragma unroll
        for (int nfl = 0; nfl < 2; ++nfl) { const int cl_ = 32 * q + 16 * nfl + 4 * fq, c16 = cl_ >> 3, sub = (cl_ & 7) * 2;
            f32x4 gcw[4]; const f32x4 gcb = *(const LAS f32x4*)(CB + cl_);
#pragma unroll
            for (int tap = 0; tap < 4; ++tap) gcw[tap] = *(const LAS f32x4*)(CW + tap * 128 + cl_);
#pragma unroll
            for (int mi = 0; mi < 2; ++mi) { f32x4 xc = gcb;
#pragma unroll
                for (int tap = 0; tap < 4; ++tap) { const int j = r0 + 16 * mi + fr + tap; const v2u xv = *(const LAS v2u*)(XT + j * 256 + ((c16 ^ (j & 15)) << 4) + sub); const f32x4 w0 = gcw[tap];
                    xc[0] += w0[0] * bf_lo(xv.x); xc[1] += w0[1] * bf_hi(xv.x); xc[2] += w0[2] * bf_lo(xv.y); xc[3] += w0[3] * bf_hi(xv.y); }
                f32x4 av, bv;
#pragma unroll
                for (int t = 0; t < 4; ++t) { const float r = sigmoid_f(acc[mi][nfl][t] + gba[nfl][t]), ig = sigmoid_f(acc[mi][nfl + 2][t] + gbi[nfl][t]);
                    const float a_ = fast_exp2(r * gsp[nfl][t]); av[t] = a_; bv[t] = sqrtf(fmaxf(1.0f - a_ * a_, 0.f)) * ig * xc[t]; }
                const int rt = r0 + 16 * mi + fr;
                *(LAS f32x4*)(A_ + rt * 32 + 16 * nfl + 4 * fq) = av; *(LAS f32x4*)(BX + rt * 32 + 16 * nfl + 4 * fq) = bv; } }
        __syncthreads();
        const int c = tid & 31, seg = tid >> 5;
        float sa[16], sb[16];
#pragma unroll
        for (int k = 0; k < 16; ++k) { sa[k] = A_[(16 * seg + k) * 32 + c]; sb[k] = BX[(16 * seg + k) * 32 + c]; }
        const size_t tokb = (size_t)b * SEQ + 256 * tile + 16 * seg;
        float gl[16];
#pragma unroll
        for (int k = 0; k < 16; ++k) gl[k] = bf1(G[(tokb + k) * 1536 + 1024 + 128 * g + 32 * q + c]);
        { float P = 1.f, hl = 0.f;
#pragma unroll
          for (int k = 0; k < 16; ++k) { hl = sa[k] * hl + sb[k]; P *= sa[k]; }
          SEG[(seg * 32 + c) * 2] = P; SEG[(seg * 32 + c) * 2 + 1] = hl; }
        __syncthreads();
        float hin = tile == 0 ? 0.f : CAR[(tile & 1) * 32 + c];
        { f32x2 sg[15];
#pragma unroll
          for (int s2 = 0; s2 < 15; ++s2) sg[s2] = *(const LAS f32x2*)(SEG + (s2 * 32 + c) * 2);
#pragma unroll
          for (int s2 = 0; s2 < 15; ++s2) if (s2 < seg) hin = sg[s2][0] * hin + sg[s2][1]; }
#pragma unroll
        for (int k = 0; k < 16; ++k) { hin = sa[k] * hin + sb[k];
            MRG[(tokb + k) * 1024 + 512 + 128 * g + 32 * q + c] = (bf16)f2bf(hin * gelu_tanh_f(gl[k])); }
        if (seg == 15) CAR[((tile + 1) & 1) * 32 + c] = hin;
        __syncthreads();
    }
}

constexpr int S5_WLDS = 28672, S5_NB = SEQ / 16;
__device__ __forceinline__ void s5_pair(int b, int g, bool helper, KArgP ap, const bf16* xh, const LAS float* rsl, bf16* YS, LAS unsigned char* wl, int lane) {
    const float* lam_re = ap->in[16]; const float* lam_im = ap->in[17]; const float* log_dt = ap->in[18]; const float* b_re = ap->in[19]; const float* b_im = ap->in[20];
    const float* c_re = ap->in[21]; const float* c_im = ap->in[22]; const float* dsk = ap->in[23]; const float* gmix = ap->in[5] + D;
    LAS float* BU = (LAS float*)wl; LAS unsigned char* Hh = wl + 16384; LAS float* U = (LAS float*)(wl + 16384 + 8704);
    const float dt = __expf(log_dt[g]);
    const int c16 = lane & 15, kq = lane >> 4, kh = kq & 1;
    const size_t tokb = (size_t)b * SEQ;
#define S5_BAR() do { LDS_WAIT(); asm volatile("" ::: "memory"); __builtin_amdgcn_s_barrier(); asm volatile("" ::: "memory"); } while (0)
    if (helper) {
        bf16x8 bfr[8];
#pragma unroll
        for (int j = 0; j < 8; ++j) { const int pp = 16 * (j & 3) + c16, comp = j >> 2;
            const float re = lam_re[g * 64 + pp], im = lam_im[g * 64 + pp], mag = __expf(re * dt), lbr = mag * cosf(im * dt), lbi = mag * sinf(im * dt);
            const float den = re * re + im * im, nr = lbr - 1.0f, ni = lbi, fre = (nr * re + ni * im) / den, fim = (ni * re - nr * im) / den;
            const f32x4* pr = (const f32x4*)(b_re + ((size_t)(g * 64 + pp)) * 16 + 8 * kh); const f32x4* pi = (const f32x4*)(b_im + ((size_t)(g * 64 + pp)) * 16 + 8 * kh);
            const f32x4 r0 = pr[0], r1 = pr[1], i0 = pi[0], i1 = pi[1]; f32x4 o0, o1;
#pragma unroll
            for (int t = 0; t < 4; ++t) { o0[t] = comp ? (fre * i0[t] + fim * r0[t]) : (fre * r0[t] - fim * i0[t]); o1[t] = comp ? (fre * i1[t] + fim * r1[t]) : (fre * r1[t] - fim * i1[t]); }
            pg8::u32x4 w = pack8(o0, o1); if (kq >= 2) w = (pg8::u32x4){0u, 0u, 0u, 0u}; bfr[j] = __builtin_bit_cast(bf16x8, w); }
        const f32x4 gm0 = *(const f32x4*)(gmix + 16 * g + 8 * kh), gm1 = *(const f32x4*)(gmix + 16 * g + 8 * kh + 4);
        const bf16* xrow = xh + (tokb + c16) * D + 16 * g + 8 * kh;
        v4u xq[2]; xq[0] = *(const v4u*)(xrow); xq[1] = *(const v4u*)(xrow + (size_t)16 * D);
#define S5_A(kb_, xq_) do { const int kb__ = (kb_); const float rs_ = rsl[16 * kb__ + c16]; \
            f32x4 u0_ = pg8::up_lo((xq_).x, (xq_).y) * rs_ * gm0, u1_ = pg8::up_lo((xq_).z, (xq_).w) * rs_ * gm1; \
            { const int nb_ = kb__ + 2 < S5_NB ? kb__ + 2 : S5_NB - 1; (xq_) = *(const v4u*)(xrow + (size_t)(16 * nb_) * D); } \
            *(LAS f32x4*)(U + (kb__ % 3) * 256 + c16 * 16 + 8 * kh + 4 * (kq >> 1)) = (kq & 2) ? u1_ : u0_; \
            pg8::u32x4 uw_ = pack8(u0_, u1_); if (kq >= 2) uw_ = (pg8::u32x4){0u, 0u, 0u, 0u}; const bf16x8 uf_ = __builtin_bit_cast(bf16x8, uw_); \
            _Pragma("unroll") for (int j = 0; j < 4; ++j) { const f32x4 z_ = (f32x4){0.f, 0.f, 0.f, 0.f}; const f32x4 dr_ = mfma16(uf_, bfr[j], z_), di_ = mfma16(uf_, bfr[j + 4], z_); \
                _Pragma("unroll") for (int r = 0; r < 4; ++r) *(LAS f32x2*)(BU + (kb__ & 1) * 2048 + (4 * kq + r) * 128 + 2 * (16 * j + c16)) = (f32x2){dr_[r], di_[r]}; } } while (0)
        S5_A(0, xq[0]); S5_BAR();
        S5_A(1, xq[1]); S5_BAR();
        for (int k = 1; k < S5_NB - 1; k += 2) { S5_A(k + 1, xq[0]); S5_BAR(); if (k + 2 < S5_NB) S5_A(k + 2, xq[1]); S5_BAR(); }
#undef S5_A
    } else {
        float lr, li;
        { const float re = lam_re[g * 64 + lane], im = lam_im[g * 64 + lane], mag = __expf(re * dt); lr = mag * cosf(im * dt); li = mag * sinf(im * dt); }
        bf16x8 cfr[4];
#pragma unroll
        for (int kk = 0; kk < 4; ++kk) { const int p0 = 16 * kk + 4 * kq;
            const f32x4 cr = *(const f32x4*)(c_re + ((size_t)(g * 16 + c16)) * 64 + p0), ci = *(const f32x4*)(c_im + ((size_t)(g * 16 + c16)) * 64 + p0);
            pg8::u32x4 w; w.x = cvt_pk_bf16(cr[0], -ci[0]); w.y = cvt_pk_bf16(cr[1], -ci[1]); w.z = cvt_pk_bf16(cr[2], -ci[2]); w.w = cvt_pk_bf16(cr[3], -ci[3]); cfr[kk] = __builtin_bit_cast(bf16x8, w); }
        const f32x4 dch4 = *(const f32x4*)(dsk + 16 * g + 4 * kq);
        float hre = 0.f, him = 0.f;
#define S5_B(kb_) do { const int bf_ = (kb_) & 1; f32x2 bu_[16]; \
            _Pragma("unroll") for (int t = 0; t < 16; ++t) bu_[t] = *(const LAS f32x2*)(BU + bf_ * 2048 + t * 128 + 2 * lane); \
            _Pragma("unroll") for (int t = 0; t < 16; ++t) { const float nr_ = lr * hre - li * him + bu_[t][0], ni_ = lr * him + li * hre + bu_[t][1]; hre = nr_; him = ni_; \
                *(LAS unsigned*)(Hh + bf_ * 4352 + t * 272 + 4 * lane) = cvt_pk_bf16(nr_, ni_); } } while (0)
#define S5_C(kb_) do { const int kb__ = (kb_), bf_ = kb__ & 1; f32x4 y_ = (f32x4){0.f, 0.f, 0.f, 0.f}; \
            _Pragma("unroll") for (int kk = 0; kk < 4; ++kk) { const bf16x8 hf_ = *(const LAS bf16x8*)(Hh + bf_ * 4352 + c16 * 272 + (32 * kk + 8 * kq) * 2); y_ = mfma16(cfr[kk], hf_, y_); } \
            const f32x4 uu_ = *(const LAS f32x4*)(U + (kb__ % 3) * 256 + c16 * 16 + 4 * kq); const f32x4 yv_ = y_ + dch4 * uu_; \
            v2u w_; w_.x = cvt_pk_bf16(gelu_tanh_f(yv_[0]), gelu_tanh_f(yv_[1])); w_.y = cvt_pk_bf16(gelu_tanh_f(yv_[2]), gelu_tanh_f(yv_[3])); \
            *(v2u*)(YS + (tokb + 16 * kb__ + c16) * 1024 + 16 * g + 4 * kq) = w_; } while (0)
        S5_BAR();
        S5_B(0); S5_BAR();
        for (int k = 1; k < S5_NB - 1; k += 2) { S5_C(k - 1); S5_B(k); S5_BAR(); S5_C(k); S5_B(k + 1); S5_BAR(); }
        S5_C(S5_NB - 2); S5_B(S5_NB - 1);
        LDS_WAIT(); asm volatile("" ::: "memory");
        S5_C(S5_NB - 1);
#undef S5_B
#undef S5_C
    }
#undef S5_BAR
}

#define XB_TMO      128
#define XB_XCNT(j)  (256  + 64 * (j))
#define XB_XSUB(j)  (1280 + 64 * (j))
#define XB_XGEN(j)  (2304 + 64 * (j))
#define XB_TOP      3328
#define XB_TOPGEN   3392
#define XCD_BAR_WORDS 3456
#define XB_SPIN_CAP (1u << 18)

__device__ __forceinline__ unsigned xb_ld(unsigned* p)              { return __hip_atomic_load(p, __ATOMIC_RELAXED, __HIP_MEMORY_SCOPE_AGENT); }
__device__ __forceinline__ unsigned xb_add(unsigned* p, unsigned v) { return __hip_atomic_fetch_add(p, v, __ATOMIC_RELAXED, __HIP_MEMORY_SCOPE_AGENT); }
__device__ __forceinline__ unsigned xb_xcc_id() { return (unsigned)__builtin_amdgcn_s_getreg((3 << 11) | 20) & 0xFu; }
#define XB_SPIN(cond, bar) do { unsigned _sp = 0; while (cond) { __builtin_amdgcn_s_sleep(1); \
    if ((++_sp & 255u) == 0u) { if (xb_ld(&(bar)[XB_TMO])) break; if (_sp > XB_SPIN_CAP) { atomicAdd(&(bar)[XB_TMO], 1u); break; } } } } while (0)

struct XcdBarrier {
    unsigned* bar; unsigned x; unsigned G;
    volatile LAS unsigned* st;
};

__device__ __forceinline__ XcdBarrier xcd_barrier_post(unsigned* bar, volatile LAS unsigned* st, int tid, unsigned G) {
    XcdBarrier b; b.bar = bar; b.x = xb_xcc_id(); b.st = st; b.G = G;
    if (tid == 0) (void)xb_add(&bar[XB_XCNT(b.x)], 1u);
    return b;
}
__device__ __forceinline__ void xcd_barrier_complete(unsigned* bar, unsigned x, unsigned G, unsigned& nloc, unsigned& nx) {
    unsigned sum, cnt, mine, sp = 0u;
    for (;;) {
        sum = 0u; cnt = 0u; mine = 0u;
#pragma unroll
        for (unsigned j = 0; j < 16; ++j) { const unsigned c = xb_ld(&bar[XB_XCNT(j)]); sum += c; cnt += (c > 0u) ? 1u : 0u; mine = (j == x) ? c : mine; }
        if (sum == G) break;
        __builtin_amdgcn_s_sleep(1);
        if ((++sp & 255u) == 0u) { if (xb_ld(&bar[XB_TMO])) break; if (sp > XB_SPIN_CAP) { atomicAdd(&bar[XB_TMO], 1u); break; } }
    }
    nloc = mine > 0u ? mine : 1u; nx = cnt > 0u ? cnt : 1u;
}

__device__ __forceinline__ void xcd_barrier(const XcdBarrier& b, int tid) {
    asm volatile("s_waitcnt vmcnt(0)" ::: "memory");
    __syncthreads();
    if (tid == 0) {
        unsigned* bar = b.bar;
        __builtin_amdgcn_s_waitcnt(0);
        unsigned nloc = b.st[0], nx = b.st[1];
        if (nloc == 0u) { xcd_barrier_complete(bar, b.x, b.G, nloc, nx); b.st[0] = nloc; b.st[1] = nx; }
        const unsigned old = xb_add(&bar[XB_XSUB(b.x)], 1u);
        const unsigned gen = old / nloc;
        if (old + 1u == (gen + 1u) * nloc) {
            __builtin_amdgcn_fence(__ATOMIC_RELEASE, "agent");
            asm volatile("s_waitcnt vmcnt(0)" ::: "memory");
            const unsigned og = xb_add(&bar[XB_TOP], 1u);
            const unsigned tg = og / nx;
            if (og + 1u == (tg + 1u) * nx) xb_add(&bar[XB_TOPGEN], 1u);
            else XB_SPIN(xb_ld(&bar[XB_TOPGEN]) == tg, bar);
            __builtin_amdgcn_fence(__ATOMIC_ACQUIRE, "agent");
            xb_add(&bar[XB_XGEN(b.x)], 1u);
            asm volatile("s_waitcnt vmcnt(0)" ::: "memory");
        } else {
            XB_SPIN(xb_ld(&bar[XB_XGEN(b.x)]) == gen, bar);
            __builtin_amdgcn_fence(__ATOMIC_ACQUIRE, "agent");
            asm volatile("s_waitcnt vmcnt(0)" ::: "memory");
        }
    }
    __syncthreads();
}

__device__ __forceinline__ int lane_id() { return (int)__builtin_amdgcn_mbcnt_hi(~0u, __builtin_amdgcn_mbcnt_lo(~0u, 0u)); }
struct HotOrder {
    int c;
    __device__ bool next(int i, pg8::Unit& u) const { if (i >= 11) return false; u.pm = c & 3; u.pn = (c >> 2) & 1; return true; }
    __device__ __forceinline__ void a_ready(const pg8::Unit&) const {}
    __device__ __forceinline__ void done(const pg8::Unit&) const {}
};
template <int ph> __device__ __forceinline__ void phase_body(LAS unsigned char* lds, int wave) {
    int lane_ = lane_id(); asm volatile("" : "+v"(lane_));
    const int lane = lane_, tid = wave * 64 + lane;
    const int G_ = gridDim.x, bx = blockIdx.x;
    const int gw = bx * NWAVES + wave, NGW = G_ * NWAVES;
      const int grp = bx & 1, cl = (bx >> 3) * 4 + ((bx & 7) >> 1), GL = G_ >> 1; constexpr int TOKH = TOK / 2; const size_t R0 = (size_t)grp * TOKH;
    (void)GL; (void)cl; (void)R0;
    KArgP ap = (KArgP)__builtin_amdgcn_kernarg_segment_ptr(); asm volatile("" : "+s"(ap));
    unsigned char* ws = ap->ws;
    float* X = ap->out;
    bf16* XB = (bf16*)(ws + WS_XB); bf16* XLO = (bf16*)(ws + WS_XLO); float* SSP = (float*)(ws + WS_SSP); bf16* HID = (bf16*)(ws + WS_R1); bf16* MRG = (bf16*)(ws + WS_MRG);
    (void)gw; (void)NGW; (void)lane; (void)X; (void)XB; (void)XLO; (void)SSP; (void)HID; (void)MRG;
        if constexpr (ph == 0 && (PHM & 1)) { p0_prologue(ap, lds, gw, NGW, wave, lane); }
        else if constexpr ((PHM & 2) && (ph == 1 || ph == 6 || ph == 8 || ph == 12)) {
            const int l = ph == 1 ? 0 : ph == 6 ? 1 : ph == 8 ? 2 : 3;
            pg8::Gemm g{XB + R0 * D, (const bf16*)(ws + WS_W13) + (size_t)l * 5632 * 1024, TOKH, 5632, D}; pg8::StaticOrder S; S.init(TOKH, 5632, GL, cl, 4);
            LAS float* rs_tab = (LAS float*)(lds + 131072 + 16384);
            int pmA = -1, pmB = -1, pmC = -1; { pg8::Unit u0; for (int i = 0; S.next(i, u0); ++i) { if (pmA < 0) pmA = u0.pm; else if (u0.pm != pmA && pmB < 0) pmB = u0.pm; else if (u0.pm != pmA && u0.pm != pmB && pmB >= 0 && pmC < 0) pmC = u0.pm; } }
            if (pmB < 0) pmB = pmA; if (pmC < 0) pmC = pmB;
            { const float* sp = SSP + R0 * 32; const int np = (ph == 12 ? 32 : 16);
#pragma unroll
              for (int s3 = 0; s3 < 3; ++s3) { const int p = s3 == 0 ? pmA : (s3 == 1 ? pmB : pmC); const int row = 256 * p + (tid >> 1); const float rs = row_rs(sp, np, row); if ((tid & 1) == 0) rs_tab[s3 * 256 + (tid >> 1)] = rs; } }
            __syncthreads();
            pg8::EpiSwiglu E{HID + R0 * FF, FF, rs_tab, pmA, pmB};
            pg8::gemm_phase<pg8::EpiSwiglu, pg8::StaticOrder, true, true>(lds, g, S, E, tid);
        }
        else if constexpr ((PHM & 4) && (ph == 2 || ph == 7 || ph == 9 || ph == 13 || ph == 5)) {
            const int l = ph == 2 ? 0 : ph == 7 ? 1 : ph == 9 ? 2 : 3;
            pg8::Gemm g; g.M = TOKH; g.N = D;
            if (ph == 5) { g.A = MRG + R0 * D; g.Bt = (const bf16*)(ws + WS_WOUT); g.K = D; } else { g.A = HID + R0 * FF; g.Bt = (const bf16*)(ws + WS_W2) + (size_t)l * 1024 * FF; g.K = FF; }
            pg8::StaticOrder S; S.init(TOKH, D, GL, cl, 4);
            pg8::EpiResid E{ph == 2 ? ap->in[0] + R0 * D : nullptr, XB + R0 * D, XLO + R0 * D, SSP + R0 * 32, ph == 5 ? 1.0f : 0.5f};
            pg8::gemm_phase<pg8::EpiResid, pg8::StaticOrder, true, true>(lds, g, S, E, tid);
        }
        else if constexpr ((PHM & 8) && ph == 3) {
            { pg8::Gemm g{XB + R0 * D, (const bf16*)(ws + WS_WIN), TOKH, 1024, D}; pg8::StaticOrder S; S.init(TOKH, 1024, GL, cl, 4);
              pg8::EpiRope E{(bf16*)(ws + WS_Q) + R0 * 512, (bf16*)(ws + WS_K) + R0 * 512, (const float*)(ws + WS_ROPE), SSP + R0 * 32, 16, (LAS f32x4*)(lds + 131072) + 2 * tid, -1};
              pg8::gemm_phase<pg8::EpiRope, pg8::StaticOrder, true, true>(lds, g, S, E, tid); }
            { pg8::Gemm g{XB + R0 * D, (const bf16*)(ws + WS_WIN) + (size_t)1024 * 1024, TOKH, 1536, D}; pg8::StaticOrder S; S.init(TOKH, 1536, GL, cl, 4);
              pg8::EpiScaled E{(bf16*)(ws + WS_G) + R0 * 1536, 1536, SSP + R0 * 32, 16, (LAS f32x4*)(lds + 131072) + 2 * tid, -1};
              pg8::gemm_phase<pg8::EpiScaled, pg8::StaticOrder, true, true>(lds, g, S, E, tid); }
            { pg8::Gemm g{(const bf16*)(ws + WS_WV), XB + R0 * D, 512, TOKH, D}; pg8::StaticOrder S; S.init(512, TOKH, GL, cl, 4);
              pg8::EpiPlain E{(bf16*)(ws + WS_VT) + R0, VT_LD};
              pg8::gemm_phase<pg8::EpiPlain, pg8::StaticOrder, true, true>(lds, g, S, E, tid); }
        }
        else if constexpr ((PHM & 16) && ph == 4) {
#ifndef NO_RET
            for (int i = 0; i < ((PROBE_MIXM & 1) ? 4 : 2); ++i) { const int bh = cl >> 2, pp = cl & 3, p = (i & 1) == 0 ? pp : 7 - pp;
                ret_unit(8 * grp + (bh >> 2), bh & 3, p, (const bf16*)(ws + WS_Q), (const bf16*)(ws + WS_K), (const bf16*)(ws + WS_VT), (const bf16*)(ws + WS_G), ap->in[8], MRG, lds, tid, wave, lane); }
#endif
#ifndef NO_LRU
            for (int rep = 0; rep < ((PROBE_MIXM & 2) ? 2 : 1); ++rep)
            lru_unit(8 * grp + (cl >> 4), (cl >> 2) & 3, cl & 3, (const bf16*)(ws + WS_G), (const bf16*)(ws + WS_WLRU), ap->in[9], ap->in[10], ap->in[12], ap->in[14], ap->in[15], MRG, lds, tid, wave, lane);
#endif
        }
        else if constexpr ((PHM & 32) && ph == 10) {
            LAS float* rsl = (LAS float*)(lds + 4 * S5_WLDS);
            { const int bb = 8 * grp + ((cl * 4) >> 6); float r4[4];
#pragma unroll
              for (int i = 0; i < 4; ++i) r4[i] = row_rs(SSP, 16, bb * SEQ + 4 * tid + i);
              *(LAS f32x4*)(rsl + 4 * tid) = (f32x4){r4[0], r4[1], r4[2], r4[3]}; }
            __syncthreads();
            { const int unit = cl * 4 + (wave & 3); s5_pair(8 * grp + (unit >> 6), unit & 63, wave >= 4, ap, XB, rsl, MRG, lds + (wave & 3) * S5_WLDS, lane); }
            if (LATE_IN_S5) { __syncthreads(); p0_weights<true>(ap, (LAS float*)(lds + wave * 8448), cl * 8 + wave, GL * 8, lane); }
        }
        else if constexpr ((PHM & 64) && ph == 11) {
            pg8::Gemm g{MRG + R0 * D, (const bf16*)(ws + WS_WGLU), TOKH, 2048, D}; pg8::StaticOrder S; S.init(TOKH, 2048, GL, cl, 4);
            pg8::EpiGluResid E{XB + R0 * D, XLO + R0 * D, SSP + R0 * 32};
            pg8::gemm_phase<pg8::EpiGluResid, pg8::StaticOrder, true, true>(lds, g, S, E, tid);
        }
        else if constexpr ((PHM & 128) && ph == 14) {
            const float* gf = ap->in[26];
            static_assert(RESID_LO == 0, "the final norm reads the bf16 residual stream only");
            const f32x4* gr = (const f32x4*)gf + lane; f32x4 gg[4];
#pragma unroll
            for (int j = 0; j < 4; ++j) gg[j] = gr[64 * j];
            for (int m0 = (int)R0 + 2 * (cl * NWAVES + wave); m0 < (int)R0 + TOKH; m0 += 2 * GL * NWAVES) {
                v2u h2[2][4]; float rs[2];
#pragma unroll
                for (int h = 0; h < 2; ++h) { const v2u* hr = (const v2u*)(XB + (size_t)(m0 + h) * D) + lane;
#pragma unroll
                    for (int j = 0; j < 4; ++j) h2[h][j] = hr[64 * j];
                    rs[h] = row_rs(SSP, 16, m0 + h); }
#pragma unroll
                for (int h = 0; h < 2; ++h) { f32x4* orow = (f32x4*)(X + (size_t)(m0 + h) * D) + lane;
#pragma unroll
                    for (int j = 0; j < 4; ++j) orow[64 * j] = pg8::up_lo(h2[h][j].x, h2[h][j].y) * rs[h] * gg[j]; } }
        }
}
__global__ void __launch_bounds__(NWAVES * 64, 2) mega_fwd(Args a_) {
    extern __shared__ __attribute__((aligned(16))) unsigned char lds_raw[];
    LAS unsigned char* lds = (LAS unsigned char*)lds_raw;
    cg::grid_group grid = cg::this_grid();
    const int ph_lo = a_.ph_lo, ph_hi = a_.ph_hi;
    const int wave = __builtin_amdgcn_readfirstlane((int)(threadIdx.x >> 6));
    volatile LAS unsigned* bst = (volatile LAS unsigned*)(lds + LDS_BYTES - 32);
    { const int t0 = wave * 64 + lane_id(); if (t0 < 4) bst[t0] = 0u; }
    __syncthreads();
    const int grp_ = (int)blockIdx.x & 1;
    XcdBarrier barG = xcd_barrier_post((unsigned*)a_.ws + 4096 * (1 + grp_), bst + 2, wave * 64 + lane_id(), gridDim.x >> 1);
#define SEAM(k) do { if ((k) == 0) { grid.sync(); if (SKEW_TICKS && grp_) { const unsigned long long t0 = __builtin_amdgcn_s_memrealtime(); while (__builtin_amdgcn_s_memrealtime() - t0 < SKEW_TICKS) __builtin_amdgcn_s_sleep(32); } } \
                     else xcd_barrier(barG, wave * 64 + lane_id()); } while (0)
#define PHASE(k) if (ph_lo <= (k) && (k) < ph_hi) { if ((PROBE_DUPM >> (k)) & 1) { phase_body<k>(lds, wave); if ((k) == 0) grid.sync(); else xcd_barrier(barG, wave * 64 + lane_id()); } phase_body<k>(lds, wave); if ((k) + 1 < ph_hi) SEAM(k); }
    PHASE(0) PHASE(1) PHASE(2) PHASE(3) PHASE(4) PHASE(5) PHASE(6) PHASE(7) PHASE(8) PHASE(9) PHASE(10) PHASE(11) PHASE(12) PHASE(13) PHASE(14)
#undef PHASE
#undef SEAM
}

extern "C" void kernel_launch(void* const* d_in, const int* in_sizes, int n_in, void* d_out, int out_size, void* d_ws, size_t ws_size, hipStream_t stream) {
    static int grid = 0;
    if (grid == 0) {
        if (n_in != 27 || in_sizes[0] != TOK * D || out_size != TOK * D || ws_size < WS_END) { fprintf(stderr, "kernel_launch: unexpected shapes (n_in %d, in0 %d, out %d, ws %zu)\n", n_in, n_in > 0 ? in_sizes[0] : -1, out_size, ws_size); grid = -1; return; }
        int dev = 0, cus = 0, per_cu = 0;
        (void)hipGetDevice(&dev); (void)hipDeviceGetAttribute(&cus, hipDeviceAttributeMultiprocessorCount, dev);
        if (hipFuncSetAttribute((const void*)mega_fwd, hipFuncAttributeMaxDynamicSharedMemorySize, LDS_BYTES) != hipSuccess) { fprintf(stderr, "kernel_launch: hipFuncSetAttribute failed\n"); grid = -1; return; }
        if (hipOccupancyMaxActiveBlocksPerMultiprocessor(&per_cu, (const void*)mega_fwd, NWAVES * 64, LDS_BYTES) != hipSuccess || per_cu < 1) { fprintf(stderr, "kernel_launch: occupancy query says %d blocks per CU\n", per_cu); per_cu = 1; }
        (void)hipGetLastError();
        grid = cus * 1;
    }
    if (grid < 0) return;
    (void)hipMemsetAsync(d_ws, 0, 65536, stream);
    Args a{};
    for (int i = 0; i < 27; ++i) a.in[i] = (const float*)d_in[i];
    a.out = (float*)d_out; a.ws = (unsigned char*)d_ws;
#if MK_PER_PHASE
    for (int ph = 0; ph < NPH; ++ph) { a.ph_lo = ph; a.ph_hi = ph + 1; hipLaunchKernelGGL(mega_fwd, dim3(grid), dim3(NWAVES * 64), LDS_BYTES, stream, a); }
#else
    a.ph_lo = 0; a.ph_hi = NPH;
    void* params[] = {&a};
    const hipError_t e = hipLaunchCooperativeKernel((const void*)mega_fwd, dim3(grid), dim3(NWAVES * 64), params, LDS_BYTES, stream);
    if (e != hipSuccess) fprintf(stderr, "kernel_launch: cooperative launch failed: %s (grid %d)\n", hipGetErrorString(e), grid);
#endif
}
```

```cpp
#include <hip/hip_runtime.h>
#include <hip/hip_cooperative_groups.h>
#include <cstdio>
#include <cstdint>
#include <cmath>
namespace cg = cooperative_groups;
namespace pg8 {
#define PG8_LAS __attribute__((address_space(3)))
typedef unsigned short bf16_t;
typedef short bf16x8 __attribute__((ext_vector_type(8)));
typedef float f32x4 __attribute__((ext_vector_type(4)));
typedef unsigned u32x4 __attribute__((ext_vector_type(4)));
constexpr int BM = 256, BK = 64, HALF = 128, HTB = HALF * BK * 2  , STAGE_BYTES = 8 * HTB, NXCD = 8, WGM = 8;

__host__ __device__ __forceinline__ int lds_byte(int r, int c) { const int st = (r >> 4) * 2 + (c >> 5), rr = r & 15, cc = c & 31, ob = rr * 64 + cc * 2; return st * 1024 + (ob ^ (((ob >> 9) & 1) << 5)); }
__host__ __device__ __forceinline__ void stage_rc(int b, int& R, int& C) { const int st = b / 1024, sb = b % 1024, swz = sb ^ (((sb >> 9) & 1) << 5); R = (st >> 1) * 16 + swz / 64; C = (st & 1) * 32 + (swz % 64) / 2; }
__host__ __device__ __forceinline__ int perm32(int rho) { const int n = rho >> 4, i = rho & 15; return 8 * (i >> 2) + 4 * n + (i & 3); }

struct Unit { int pm, pn; };
struct Gemm { const bf16_t* A; const bf16_t* Bt; int M, N, K; };

struct StaticOrder {
    int nM, nN, nwg, G, c, nx;
    __host__ __device__ void init(int M, int N, int G_, int c_, int nx_ = NXCD) { nM = M / BM; nN = N / BM; nwg = nM * nN; G = G_; c = c_; nx = nx_; }
    __host__ __device__ bool next(int i, Unit& u) const {
        const long L = (long)i * G + c; if (L >= nwg) return false;
        int wgid = (int)L; { const int q = nwg / nx, r = nwg % nx, xcd = wgid % nx, off = wgid / nx; wgid = (xcd < r ? xcd * (q + 1) : r * (q + 1) + (xcd - r) * q) + off; }
        const int nig = WGM * nN, gid = wgid / nig, fm = gid * WGM, gsz = (nM - fm) < WGM ? (nM - fm) : WGM;
        u.pm = fm + ((wgid % nig) % gsz); u.pn = (wgid % nig) / gsz; return true;
    }
    __device__ __forceinline__ void a_ready(const Unit&) const {}
    __device__ __forceinline__ void done(const Unit&) const {}
};

__device__ __forceinline__ unsigned cvt_pk_bf16(float lo, float hi) { unsigned r; asm("v_cvt_pk_bf16_f32 %0, %1, %2" : "=v"(r) : "v"(lo), "v"(hi)); return r; }
__device__ __forceinline__ u32x4 pack8(const f32x4 a, const f32x4 b) { u32x4 w; w.x = cvt_pk_bf16(a[0], a[1]); w.y = cvt_pk_bf16(a[2], a[3]); w.z = cvt_pk_bf16(b[0], b[1]); w.w = cvt_pk_bf16(b[2], b[3]); return w; }
__device__ __forceinline__ float fast_rcp(float x) { return __builtin_amdgcn_rcpf(x); }
__device__ __forceinline__ float fast_exp2(float x) { return __builtin_amdgcn_exp2f(x); }
__device__ __forceinline__ float sigmoid_f(float x) { return fast_rcp(1.0f + fast_exp2(-1.4426950409f * x)); }
__device__ __forceinline__ float silu_f(float x) { return x * sigmoid_f(x); }
__device__ __forceinline__ float gelu_tanh_f(float v) { const float u = v + 0.044715f * v * v * v; return v * sigmoid_f(1.5957691216f * u); }
__device__ __forceinline__ float row_rs(const float* ssp, int nparts, int row) {
    const f32x4* p = (const f32x4*)(ssp + (size_t)row * 32); float s = 0.f;
#pragma unroll
    for (int i = 0; i < 4; ++i) { const f32x4 v = p[i]; s += (v[0] + v[1]) + (v[2] + v[3]); }
    if (nparts > 16) {
#pragma unroll
        for (int i = 4; i < 8; ++i) { const f32x4 v = p[i]; s += (v[0] + v[1]) + (v[2] + v[3]); } }
    return 1.0f / sqrtf(s * (1.0f / 1024.0f) + 1e-6f);
}
__device__ __forceinline__ void row_rs8(float (&rs)[8], const float* ssp, int nparts, int row0) {
#pragma unroll
    for (int h = 0; h < 2; ++h) {
#pragma unroll
        for (int i = 0; i < 4; ++i) rs[4 * h + i] = row_rs(ssp, nparts, row0 + h * HALF + i * 16);
        asm volatile("" : "+v"(rs[4 * h]), "+v"(rs[4 * h + 1]), "+v"(rs[4 * h + 2]), "+v"(rs[4 * h + 3]) :: "memory"); }
}

typedef float f32x2 __attribute__((ext_vector_type(2)));
__device__ __forceinline__ f32x2 swiglu_pk(f32x2 a, f32x2 b) {
    const f32x2 s = a * -1.4426950409f; f32x2 e; e.x = fast_exp2(s.x); e.y = fast_exp2(s.y);
    const f32x2 d = e + 1.0f; f32x2 r; r.x = fast_rcp(d.x); r.y = fast_rcp(d.y);
    return (a * r) * b;
}
struct EpiSwiglu {
    static constexpr bool PERM = true, AFTER_DRAIN = false;
    bf16_t* O; int ldo; const PG8_LAS float* rs_tab; int pmA, pmB;
    __device__ __forceinline__ void operator()(const f32x4 (&acc)[2][2][4][2], const Unit& u, int wr, int wc, int fr, int fq) const {
        const int row0 = u.pm * BM + wr * 64 + fr, col0 = u.pn * 128 + wc * 32 + 8 * fq;
        const PG8_LAS float* rt = rs_tab + (u.pm == pmA ? 0 : (u.pm == pmB ? 256 : 512)) + wr * 64 + fr;
#pragma unroll
        for (int ai = 0; ai < 2; ++ai)
#pragma unroll
            for (int m = 0; m < 4; ++m) { const int row = row0 + ai * HALF + m * 16; const float rs = rt[ai * HALF + m * 16];
                f32x4 h[2];
#pragma unroll
                for (int n = 0; n < 2; ++n) { const f32x4 a4 = acc[ai][0][m][n] * rs, b4 = acc[ai][1][m][n] * rs;
                    const f32x2 h0 = swiglu_pk((f32x2){a4[0], a4[1]}, (f32x2){b4[0], b4[1]}), h1 = swiglu_pk((f32x2){a4[2], a4[3]}, (f32x2){b4[2], b4[3]});
                    h[n] = (f32x4){h0.x, h0.y, h1.x, h1.y}; }
                *(u32x4*)(O + (size_t)row * ldo + col0) = pack8(h[0], h[1]); }
    }
};
__device__ __forceinline__ f32x4 up_lo(unsigned a, unsigned b) { f32x4 r; r[0] = __builtin_bit_cast(float, a << 16); r[1] = __builtin_bit_cast(float, a & 0xffff0000u); r[2] = __builtin_bit_cast(float, b << 16); r[3] = __builtin_bit_cast(float, b & 0xffff0000u); return r; }
#ifndef RESID_LO
#define RESID_LO 0
#endif
__device__ __forceinline__ void split_store(bf16_t* xhi, bf16_t* xlo, size_t off, const f32x4 v0, const f32x4 v1) {
    const u32x4 hw = pack8(v0, v1); *(u32x4*)(xhi + off) = hw;
    if (RESID_LO) { const f32x4 r0 = v0 - up_lo(hw.x, hw.y), r1 = v1 - up_lo(hw.z, hw.w); *(u32x4*)(xlo + off) = pack8(r0, r1); }
}
__device__ __forceinline__ void split_load(const bf16_t* xhi, const bf16_t* xlo, size_t off, f32x4& o0, f32x4& o1) {
    const u32x4 h = *(const u32x4*)(xhi + off); o0 = up_lo(h.x, h.y); o1 = up_lo(h.z, h.w);
    if (RESID_LO) { const u32x4 l = *(const u32x4*)(xlo + off); o0 += up_lo(l.x, l.y); o1 += up_lo(l.z, l.w); }
}
struct EpiResid {
    static constexpr bool PERM = true, AFTER_DRAIN = false;
    const float* xin_f32; bf16_t* xhi; bf16_t* xlo; float* ssp; float alpha;
    __device__ __forceinline__ void operator()(const f32x4 (&acc)[2][2][4][2], const Unit& u, int wr, int wc, int fr, int fq) const {
        const int row0 = u.pm * BM + wr * 64 + fr, col0 = u.pn * BM + wc * 32 + 8 * fq;
#pragma unroll
        for (int ai = 0; ai < 2; ++ai)
#pragma unroll
            for (int m = 0; m < 4; ++m) { const int row = row0 + ai * HALF + m * 16; float ss = 0.f;
#pragma unroll
                for (int bj = 0; bj < 2; ++bj) { const size_t off = (size_t)row * 1024 + col0 + bj * HALF; f32x4 o0, o1;
                    if (xin_f32) { o0 = *(const f32x4*)(xin_f32 + off); o1 = *(const f32x4*)(xin_f32 + off + 4); }
                    else split_load(xhi, xlo, off, o0, o1);
                    const f32x4 v0 = o0 + alpha * acc[ai][bj][m][0], v1 = o1 + alpha * acc[ai][bj][m][1];
                    split_store(xhi, xlo, off, v0, v1);
                    ss += (v0[0] * v0[0] + v0[1] * v0[1]) + (v0[2] * v0[2] + v0[3] * v0[3]) + (v1[0] * v1[0] + v1[1] * v1[1]) + (v1[2] * v1[2] + v1[3] * v1[3]); }
                ss += __shfl_xor(ss, 16); ss += __shfl_xor(ss, 32);
                if (fq == 0) ssp[(size_t)row * 32 + 4 * u.pn + wc] = ss; }
    }
};
struct EpiGluResid {
    static constexpr bool PERM = true, AFTER_DRAIN = false;
    bf16_t* xhi; bf16_t* xlo; float* ssp;
    __device__ __forceinline__ void operator()(const f32x4 (&acc)[2][2][4][2], const Unit& u, int wr, int wc, int fr, int fq) const {
        const int row0 = u.pm * BM + wr * 64 + fr, col0 = u.pn * 128 + wc * 32 + 8 * fq;
#pragma unroll
        for (int ai = 0; ai < 2; ++ai)
#pragma unroll
            for (int m = 0; m < 4; ++m) { const int row = row0 + ai * HALF + m * 16; const size_t off = (size_t)row * 1024 + col0;
                f32x4 o0, o1; split_load(xhi, xlo, off, o0, o1); f32x4 v0, v1;
#pragma unroll
                for (int t = 0; t < 4; ++t) { v0[t] = o0[t] + acc[ai][0][m][0][t] * sigmoid_f(acc[ai][1][m][0][t]); v1[t] = o1[t] + acc[ai][0][m][1][t] * sigmoid_f(acc[ai][1][m][1][t]); }
                split_store(xhi, xlo, off, v0, v1);
                float ss = (v0[0] * v0[0] + v0[1] * v0[1]) + (v0[2] * v0[2] + v0[3] * v0[3]) + (v1[0] * v1[0] + v1[1] * v1[1]) + (v1[2] * v1[2] + v1[3] * v1[3]);
                ss += __shfl_xor(ss, 16); ss += __shfl_xor(ss, 32);
                if (fq == 0) ssp[(size_t)row * 32 + 4 * u.pn + wc] = ss; }
    }
};
struct EpiPlain {
    static constexpr bool PERM = true, AFTER_DRAIN = false;
    bf16_t* O; int ldo;
    __device__ __forceinline__ void operator()(const f32x4 (&acc)[2][2][4][2], const Unit& u, int wr, int wc, int fr, int fq) const {
        const int row0 = u.pm * BM + wr * 64 + fr, col0 = u.pn * BM + wc * 32 + 8 * fq;
#pragma unroll
        for (int ai = 0; ai < 2; ++ai)
#pragma unroll
            for (int m = 0; m < 4; ++m) { bf16_t* rowp = O + (size_t)(row0 + ai * HALF + m * 16) * ldo + col0;
#pragma unroll
                for (int bj = 0; bj < 2; ++bj) *(u32x4*)(rowp + bj * HALF) = pack8(acc[ai][bj][m][0], acc[ai][bj][m][1]); }
    }
};
__device__ __forceinline__ float lg_gamma(int h) { return h == 0 ? -0.04580368961312479f : h == 1 ? -0.02272007650008353f : h == 2 ? -0.011315313227834146f : -0.005646563141142063f; }
struct EpiRope {
    static constexpr bool PERM = true, AFTER_DRAIN = false;
    bf16_t* Q; bf16_t* K; const float* rope; const float* ssp; int nparts; PG8_LAS f32x4* rs_lds; mutable int last_pm;
    __device__ __forceinline__ void operator()(const f32x4 (&acc)[2][2][4][2], const Unit& u, int wr, int wc, int fr, int fq) const {
        typedef unsigned u32x2 __attribute__((ext_vector_type(2)));
        const int row0 = u.pm * BM + wr * 64 + fr;
        const int head = 2 * (u.pn & 1) + (wc >> 1), jj0 = (wc & 1) * 32 + 8 * fq; bf16_t* dst = (u.pn < 2) ? Q : K;
        const float lg = lg_gamma(head);
        float rs8[8];
        if (u.pm != last_pm) { row_rs8(rs8, ssp, nparts, row0); rs_lds[0] = (f32x4){rs8[0], rs8[1], rs8[2], rs8[3]}; rs_lds[1] = (f32x4){rs8[4], rs8[5], rs8[6], rs8[7]}; last_pm = u.pm; }
        else { const f32x4 r0 = rs_lds[0], r1 = rs_lds[1]; rs8[0] = r0[0]; rs8[1] = r0[1]; rs8[2] = r0[2]; rs8[3] = r0[3]; rs8[4] = r1[0]; rs8[5] = r1[1]; rs8[6] = r1[2]; rs8[7] = r1[3]; }
#pragma unroll
        for (int ai = 0; ai < 2; ++ai)
#pragma unroll
            for (int m = 0; m < 4; ++m) { const int row = row0 + ai * HALF + m * 16, pos = row & 2047; const float rs = rs8[4 * ai + m];
                const float sc = (u.pn < 2) ? rs * fast_exp2(lg * (float)(pos & 127)) : rs * rs * 0.08838834764831845f * fast_exp2(-lg * (float)(pos & 127));
                const f32x4* rp = (const f32x4*)(rope + ((size_t)pos * 64 + jj0) * 2);
                bf16_t* rowp = dst + (size_t)row * 512 + head * 128 + jj0;
#pragma unroll
                for (int n = 0; n < 2; ++n) { const f32x4 cs0 = rp[2 * n], cs1 = rp[2 * n + 1]; const f32x4 x1 = acc[ai][0][m][n] * sc, x2 = acc[ai][1][m][n] * sc; f32x4 o1, o2;
                    o1[0] = x1[0] * cs0[0] - x2[0] * cs0[1]; o2[0] = x1[0] * cs0[1] + x2[0] * cs0[0];
                    o1[1] = x1[1] * cs0[2] - x2[1] * cs0[3]; o2[1] = x1[1] * cs0[3] + x2[1] * cs0[2];
                    o1[2] = x1[2] * cs1[0] - x2[2] * cs1[1]; o2[2] = x1[2] * cs1[1] + x2[2] * cs1[0];
                    o1[3] = x1[3] * cs1[2] - x2[3] * cs1[3]; o2[3] = x1[3] * cs1[3] + x2[3] * cs1[2];
                    u32x2 w1, w2; w1.x = cvt_pk_bf16(o1[0], o1[1]); w1.y = cvt_pk_bf16(o1[2], o1[3]); w2.x = cvt_pk_bf16(o2[0], o2[1]); w2.y = cvt_pk_bf16(o2[2], o2[3]);
                    *(u32x2*)(rowp + 4 * n) = w1; *(u32x2*)(rowp + 64 + 4 * n) = w2; } if (m == 3) asm volatile("" ::: "memory"); }
    }
};
struct EpiScaled {
    static constexpr bool PERM = true, AFTER_DRAIN = false;
    bf16_t* O; int ldo; const float* ssp; int nparts; PG8_LAS f32x4* rs_lds; mutable int last_pm;
    __device__ __forceinline__ void operator()(const f32x4 (&acc)[2][2][4][2], const Unit& u, int wr, int wc, int fr, int fq) const {
        const int row0 = u.pm * BM + wr * 64 + fr, col0 = u.pn * BM + wc * 32 + 8 * fq;
        float rs8[8];
        if (u.pm != last_pm) { row_rs8(rs8, ssp, nparts, row0); rs_lds[0] = (f32x4){rs8[0], rs8[1], rs8[2], rs8[3]}; rs_lds[1] = (f32x4){rs8[4], rs8[5], rs8[6], rs8[7]}; last_pm = u.pm; }
        else { const f32x4 r0 = rs_lds[0], r1 = rs_lds[1]; rs8[0] = r0[0]; rs8[1] = r0[1]; rs8[2] = r0[2]; rs8[3] = r0[3]; rs8[4] = r1[0]; rs8[5] = r1[1]; rs8[6] = r1[2]; rs8[7] = r1[3]; }
#pragma unroll
        for (int ai = 0; ai < 2; ++ai)
#pragma unroll
            for (int m = 0; m < 4; ++m) { const int row = row0 + ai * HALF + m * 16; const float rs = rs8[4 * ai + m]; bf16_t* rowp = O + (size_t)row * ldo + col0;
#pragma unroll
                for (int bj = 0; bj < 2; ++bj) *(u32x4*)(rowp + bj * HALF) = pack8(acc[ai][bj][m][0] * rs, acc[ai][bj][m][1] * rs); }
    }
};

struct EpiNull {
    static constexpr bool PERM = true, AFTER_DRAIN = false;
    __device__ __forceinline__ void operator()(const f32x4 (&acc)[2][2][4][2], const Unit& u, int wr, int wc, int fr, int fq) const {
        float s = 0.f;
#pragma unroll
        for (int ai = 0; ai < 2; ++ai)
#pragma unroll
            for (int bj = 0; bj < 2; ++bj)
#pragma unroll
                for (int m = 0; m < 4; ++m) s += acc[ai][bj][m][0][0] + acc[ai][bj][m][1][3];
        asm volatile("" :: "v"(s));
    }
};

template <class Epi, class Sched, bool ALIGN_EPI = false, bool SP2 = false>
__device__ __forceinline__ void gemm_phase(PG8_LAS unsigned char* lds, const Gemm g, const Sched& S, const Epi& E, int tid_in) {
    int tid_ = tid_in; asm volatile("" : "+v"(tid_));
    const int tid = tid_, wid = __builtin_amdgcn_readfirstlane(tid >> 6), lane = tid & 63, wr = wid >> 2, wc = wid & 3, fr = lane & 15, fq = lane >> 4;
    const int K = g.K, nt = K / BK;
    unsigned voffA[2], voffB[2];
#pragma unroll
    for (int i = 0; i < 2; ++i) { int R, C; stage_rc(tid * 16 + i * 8192, R, C); const int Rb = Epi::PERM ? ((R & ~31) + perm32(R & 31)) : R;
        voffA[i] = (unsigned)(R * K + C) * 2u; voffB[i] = (unsigned)(Rb * K + C) * 2u; }
    const size_t kstep = (size_t)(BK * 2);
    const size_t hstep = (size_t)HALF * K * 2;
    const size_t tstep = 2 * hstep;
    const unsigned ldsw = (unsigned)wid * 1024u;
    const int aoff = lds_byte(wr * 64 + fr, fq * 8), boff = lds_byte(wc * 32 + fr, fq * 8);
#define PG8_SA(b, h) (((b) * 2 + (h)) * HTB)
#define PG8_SB(b, h) ((4 + (b) * 2 + (h)) * HTB)
#define PG8_STAGE(bufoff, gbase, voff) do { _Pragma("unroll") for (int _i = 0; _i < 2; ++_i) \
        __builtin_amdgcn_global_load_lds((const unsigned*)((const char*)(gbase) + (voff)[_i]), (PG8_LAS unsigned*)(lds + (bufoff) + ldsw + _i * 8192), 16, 0, 0); } while (0)
#define PG8_LDA(dst, b, h) do { _Pragma("unroll") for (int m = 0; m < 4; ++m) _Pragma("unroll") for (int k = 0; k < 2; ++k) dst[m][k] = *(const PG8_LAS bf16x8*)(lds + PG8_SA(b, h) + aoff + m * 2048 + k * 1024); } while (0)
#define PG8_LDB(dst, b, h) do { _Pragma("unroll") for (int n = 0; n < 2; ++n) _Pragma("unroll") for (int k = 0; k < 2; ++k) dst[n][k] = *(const PG8_LAS bf16x8*)(lds + PG8_SB(b, h) + boff + n * 2048 + k * 1024); } while (0)
#define PG8_MMA(ai, bj, At, Bt) do { __builtin_amdgcn_s_setprio(1); _Pragma("unroll") for (int m = 0; m < 4; ++m) _Pragma("unroll") for (int n = 0; n < 2; ++n) _Pragma("unroll") for (int k = 0; k < 2; ++k) \
        acc[ai][bj][m][n] = __builtin_amdgcn_mfma_f32_16x16x32_bf16(Bt[n][k], At[m][k], acc[ai][bj][m][n], 0, 0, 0); __builtin_amdgcn_s_setprio(0); } while (0)
#define PG8_WAIT_V(n) asm volatile("s_waitcnt vmcnt(" #n ")" ::: "memory")
#define PG8_WAIT_L(n) asm volatile("s_waitcnt lgkmcnt(" #n ")" ::: "memory")
#define PG8_BAR __builtin_amdgcn_s_barrier()
#define PG8_SCHED __builtin_amdgcn_sched_barrier(0)
    Unit cur, nxt; int ui = 0;
    if (!S.next(0, cur)) return;
    f32x4 acc[2][2][4][2];
#pragma unroll
    for (int a = 0; a < 2; ++a)
#pragma unroll
        for (int b = 0; b < 2; ++b)
#pragma unroll
            for (int m = 0; m < 4; ++m)
#pragma unroll
                for (int n = 0; n < 2; ++n) acc[a][b][m][n] = (f32x4){0.f, 0.f, 0.f, 0.f};
    bf16x8 At[4][2], B0[2][2], B1[2][2];
    const char* cA = (const char*)g.A + (size_t)cur.pm * tstep; const char* cB = (const char*)g.Bt + (size_t)cur.pn * tstep;
    S.a_ready(cur);
    if constexpr (SP2) {
        PG8_STAGE(PG8_SB(0, 0), cB, voffB); PG8_STAGE(PG8_SB(0, 1), cB + hstep, voffB); PG8_STAGE(PG8_SA(0, 0), cA, voffA); PG8_STAGE(PG8_SA(0, 1), cA + hstep, voffA);
        if (wr == 1) PG8_BAR;
        PG8_WAIT_V(2); PG8_BAR;
        PG8_STAGE(PG8_SB(1, 0), cB + kstep, voffB); PG8_STAGE(PG8_SA(1, 0), cA + kstep, voffA); PG8_STAGE(PG8_SB(1, 1), cB + hstep + kstep, voffB);
        PG8_WAIT_V(6); PG8_BAR;
    } else {
        PG8_STAGE(PG8_SB(0, 0), cB, voffB); PG8_STAGE(PG8_SA(0, 0), cA, voffA); PG8_STAGE(PG8_SB(0, 1), cB + hstep, voffB); PG8_STAGE(PG8_SA(0, 1), cA + hstep, voffA);
        if (wr == 1) PG8_BAR;
        PG8_WAIT_V(4); PG8_BAR;
        PG8_STAGE(PG8_SB(1, 0), cB + kstep, voffB); PG8_STAGE(PG8_SA(1, 0), cA + kstep, voffA); PG8_STAGE(PG8_SB(1, 1), cB + hstep + kstep, voffB);
        PG8_WAIT_V(6); PG8_BAR;
    }
    for (;;) {
        const bool has_next = S.next(ui + 1, nxt);
        const char* nA = has_next ? (const char*)g.A + (size_t)nxt.pm * tstep : cA; const char* nB = has_next ? (const char*)g.Bt + (size_t)nxt.pn * tstep : cB;
        for (int t = 0; t < nt; t += 2) {
            const bool last = (t == nt - 2);
            const char* a1 = cA + (size_t)(t + 1) * kstep;
            const char* a2 = last ? nA : cA + (size_t)(t + 2) * kstep; const char* b2 = last ? nB : cB + (size_t)(t + 2) * kstep;
            const char* a3 = a2 + kstep; const char* b3 = b2 + kstep;
            if (last && has_next) S.a_ready(nxt);
            if constexpr (SP2) {
            PG8_LDB(B0, 0, 0); PG8_LDB(B1, 0, 1); PG8_SCHED; PG8_LDA(At, 0, 0); PG8_STAGE(PG8_SA(1, 1), a1 + hstep, voffA);
            PG8_WAIT_V(8); PG8_WAIT_L(0); PG8_BAR; PG8_MMA(0, 0, At, B0); PG8_MMA(0, 1, At, B1); PG8_BAR; PG8_SCHED;
            PG8_LDA(At, 0, 1); PG8_STAGE(PG8_SB(0, 0), b2, voffB); PG8_STAGE(PG8_SB(0, 1), b2 + hstep, voffB); PG8_STAGE(PG8_SA(0, 0), a2, voffA);
            PG8_WAIT_V(8); PG8_WAIT_L(0); PG8_BAR; PG8_MMA(1, 0, At, B0); PG8_MMA(1, 1, At, B1); PG8_BAR; PG8_SCHED;
            PG8_LDB(B0, 1, 0); PG8_LDB(B1, 1, 1); PG8_SCHED; PG8_LDA(At, 1, 0); PG8_STAGE(PG8_SA(0, 1), a2 + hstep, voffA);
            PG8_WAIT_V(8); PG8_WAIT_L(0); PG8_BAR; PG8_MMA(0, 0, At, B0); PG8_MMA(0, 1, At, B1); PG8_BAR; PG8_SCHED;
            PG8_LDA(At, 1, 1); PG8_STAGE(PG8_SB(1, 0), b3, voffB); PG8_STAGE(PG8_SB(1, 1), b3 + hstep, voffB); PG8_STAGE(PG8_SA(1, 0), a3, voffA);
            PG8_WAIT_V(8); PG8_WAIT_L(0); PG8_BAR; PG8_MMA(1, 0, At, B0); PG8_MMA(1, 1, At, B1); PG8_BAR; PG8_SCHED;
            } else {
            PG8_LDB(B0, 0, 0); PG8_SCHED; PG8_LDA(At, 0, 0); PG8_STAGE(PG8_SA(1, 1), a1 + hstep, voffA);
            PG8_WAIT_L(8); PG8_BAR; PG8_WAIT_L(0); PG8_MMA(0, 0, At, B0); PG8_BAR; PG8_SCHED;
            PG8_LDB(B1, 0, 1); PG8_STAGE(PG8_SB(0, 0), b2, voffB);
            PG8_BAR; PG8_WAIT_L(0); PG8_MMA(0, 1, At, B1); PG8_BAR;
            PG8_LDA(At, 0, 1); PG8_STAGE(PG8_SA(0, 0), a2, voffA);
            PG8_BAR; PG8_WAIT_L(0); PG8_MMA(1, 0, At, B0); PG8_BAR; PG8_SCHED;
            PG8_STAGE(PG8_SB(0, 1), b2 + hstep, voffB);
            PG8_WAIT_V(6); PG8_BAR; PG8_MMA(1, 1, At, B1); PG8_BAR;
            PG8_LDB(B0, 1, 0); PG8_SCHED; PG8_LDA(At, 1, 0); PG8_STAGE(PG8_SA(0, 1), a2 + hstep, voffA);
            PG8_WAIT_L(8); PG8_BAR; PG8_WAIT_L(0); PG8_MMA(0, 0, At, B0); PG8_BAR; PG8_SCHED;
            PG8_LDB(B1, 1, 1); PG8_STAGE(PG8_SB(1, 0), b3, voffB);
            PG8_BAR; PG8_WAIT_L(0); PG8_MMA(0, 1, At, B1); PG8_BAR;
            PG8_LDA(At, 1, 1); PG8_STAGE(PG8_SA(1, 0), a3, voffA);
            PG8_BAR; PG8_WAIT_L(0); PG8_MMA(1, 0, At, B0); PG8_BAR; PG8_SCHED;
            PG8_STAGE(PG8_SB(1, 1), b3 + hstep, voffB);
            PG8_WAIT_V(6); PG8_BAR; PG8_MMA(1, 1, At, B1); PG8_BAR;
            }
        }
        if constexpr (ALIGN_EPI) { if (wr == 0) PG8_BAR; }
        if constexpr (!Epi::AFTER_DRAIN) { E(acc, cur, wr, wc, fr, fq); S.done(cur); }
        if (!has_next) break;
#pragma unroll
        for (int a = 0; a < 2; ++a)
#pragma unroll
            for (int b = 0; b < 2; ++b)
#pragma unroll
                for (int m = 0; m < 4; ++m)
#pragma unroll
                    for (int n = 0; n < 2; ++n) acc[a][b][m][n] = (f32x4){0.f, 0.f, 0.f, 0.f};
        cur = nxt; cA = nA; cB = nB; ++ui;
        if constexpr (ALIGN_EPI) { if (wr == 1) PG8_BAR; }
    }
    PG8_WAIT_V(0);
    if constexpr (!ALIGN_EPI) { if (wr == 0) PG8_BAR; }
    PG8_BAR;
    if constexpr (Epi::AFTER_DRAIN) { E.fused(acc, cur, wr, wc, fr, fq, lds, wid, lane); S.done(cur); }
#undef PG8_SA
#undef PG8_SB
#undef PG8_STAGE
#undef PG8_LDA
#undef PG8_LDB
#undef PG8_MMA
#undef PG8_WAIT_V
#undef PG8_WAIT_L
#undef PG8_BAR
#undef PG8_SCHED
}
}

#define GAS __attribute__((address_space(1)))
#define LAS __attribute__((address_space(3)))
typedef unsigned short bf16;
typedef unsigned v4u __attribute__((ext_vector_type(4)));
typedef unsigned v2u __attribute__((ext_vector_type(2)));
typedef float f32x4 __attribute__((ext_vector_type(4)));
typedef float f32x2 __attribute__((ext_vector_type(2)));
typedef float f32x16 __attribute__((ext_vector_type(16)));
typedef short bf16x8 __attribute__((ext_vector_type(8)));
#define LDS_WAIT() asm volatile("s_waitcnt lgkmcnt(0)" ::: "memory")
using pg8::cvt_pk_bf16; using pg8::pack8; using pg8::sigmoid_f; using pg8::silu_f; using pg8::gelu_tanh_f; using pg8::row_rs; using pg8::fast_exp2;

#ifndef PHM
#define PHM 255
#endif
#ifndef PROBE_NULLM
#define PROBE_NULLM 0
#endif
#ifndef PROBE_MIXM
#define PROBE_MIXM 0
#endif
#ifndef SKEW_TICKS
#define SKEW_TICKS 0ull
#endif
#ifndef LATE_IN_S5
#define LATE_IN_S5 0
#endif
#ifndef PROBE_DUPM
#define PROBE_DUPM 0
#endif
#ifndef MK_PER_PHASE
#define MK_PER_PHASE 0
#endif
constexpr int NWAVES = 8;
constexpr int BATCH = 16, SEQ = 2048, D = 1024, FF = 2816, TOK = BATCH * SEQ;
constexpr int NPH = 15;
constexpr size_t MiB = 1u << 20;
constexpr size_t WS_W13 = 1 * MiB;
constexpr size_t WS_W2 = 45 * MiB;
constexpr size_t WS_WIN = 67 * MiB;
constexpr size_t WS_WV = 72 * MiB;
constexpr size_t WS_WOUT = 73 * MiB;
constexpr size_t WS_WGLU = 75 * MiB;
constexpr size_t WS_WLRU = 79 * MiB;
constexpr size_t WS_ROPE = 80 * MiB;
constexpr size_t WS_SSP = 81 * MiB;
constexpr size_t WS_XB = 96 * MiB;
constexpr size_t WS_R1 = 160 * MiB;
constexpr size_t WS_Q = WS_R1, WS_K = WS_R1 + 32 * MiB, WS_VT = WS_R1 + 64 * MiB, WS_G = WS_R1 + 97 * MiB;
constexpr int VT_LD = TOK + 64;
constexpr size_t WS_MRG = 354 * MiB;
constexpr size_t WS_XLO = 418 * MiB;
constexpr size_t WS_END = 482 * MiB;
constexpr int LDS_BYTES = 163840;

__device__ __forceinline__ unsigned f2bf(float f) { unsigned u = __builtin_bit_cast(unsigned, f); return (u + 0x7fffu + ((u >> 16) & 1u)) >> 16; }
__device__ __forceinline__ unsigned pk2(float lo, float hi) { return f2bf(lo) | (f2bf(hi) << 16); }
__device__ __forceinline__ float bf_lo(unsigned w) { return __builtin_bit_cast(float, w << 16); }
__device__ __forceinline__ float bf_hi(unsigned w) { return __builtin_bit_cast(float, w & 0xffff0000u); }
__device__ __forceinline__ float bf1(bf16 h) { return __builtin_bit_cast(float, (unsigned)h << 16); }
__device__ __forceinline__ float wave_sum(float v) {
#pragma unroll
    for (int o = 1; o < 64; o <<= 1) v += __shfl_xor(v, o);
    return v;
}
__device__ __forceinline__ f32x4 mfma16(bf16x8 a, bf16x8 b, f32x4 c) { return __builtin_amdgcn_mfma_f32_16x16x32_bf16(a, b, c, 0, 0, 0); }

__device__ __forceinline__ void transpose_item(const float* __restrict__ W, int N, int K, const float* __restrict__ gk, bf16* WT, int dst_row, int k0, int n0, LAS float* scr, int lane) {
    { float v[32];
#pragma unroll
      for (int i = 0; i < 32; ++i) v[i] = W[(size_t)(k0 + 2 * i + (lane >> 5)) * N + n0 + (lane & 31)];
      if (gk) { const float gl = gk[k0 + lane];
#pragma unroll
          for (int i = 0; i < 32; ++i) v[i] *= __shfl(gl, 2 * i + (lane >> 5)); }
#pragma unroll
      for (int i = 0; i < 32; ++i) scr[(2 * i + (lane >> 5)) * 33 + (lane & 31)] = v[i]; }
    LDS_WAIT(); asm volatile("" ::: "memory");
    const int c = lane & 7;
#pragma unroll
    for (int j = 0; j < 4; ++j) { const int n = (lane >> 3) + 8 * j; const LAS float* s = scr + (8 * c) * 33 + n;
        v4u o; o.x = pk2(s[0 * 33], s[1 * 33]); o.y = pk2(s[2 * 33], s[3 * 33]); o.z = pk2(s[4 * 33], s[5 * 33]); o.w = pk2(s[6 * 33], s[7 * 33]);
        *(v4u*)(WT + (size_t)(dst_row + n) * K + k0 + 8 * c) = o; }
    LDS_WAIT(); asm volatile("" ::: "memory");
}
struct Args { const float* in[27]; float* out; unsigned char* ws; int ph_lo, ph_hi; };
typedef const __attribute__((address_space(4))) Args* KArgP;

template <bool LATE> __device__ __forceinline__ void p0_weights(KArgP ap, LAS float* scr, int gw, int NGW, int lane) {
    unsigned char* ws = ap->ws;
    constexpr int I_F = 1408, I_IN = 1536, I_OUT = 512, I_GL = 512, I_LRU = 64;
    constexpr int NITEMS = 12 * I_F + I_IN + I_OUT + 2 * I_GL + I_LRU;
    for (int it = gw; it < NITEMS; it += NGW) {
        int r = it;
        if (r < 8 * I_F) { const int w3 = r >= 4 * I_F; if (w3) r -= 4 * I_F; const int l = r / I_F; r -= l * I_F; if ((l == 3) != LATE) continue; const int kb = r / 88, nb = r % 88, n0 = 32 * nb;
            transpose_item(ap->in[w3 ? 3 : 2] + (size_t)l * D * FF, FF, D, ap->in[1] + l * D, (bf16*)(ws + WS_W13) + (size_t)l * 5632 * 1024, 256 * (n0 >> 7) + (n0 & 127) + (w3 ? 128 : 0), 64 * kb, n0, scr, lane); continue; }
        r -= 8 * I_F;
        if (r < 4 * I_F) { const int l = r / I_F; r -= l * I_F; if ((l == 3) != LATE) continue; const int kb = r / 32, nb = r % 32;
            transpose_item(ap->in[4] + (size_t)l * FF * D, D, FF, nullptr, (bf16*)(ws + WS_W2) + (size_t)l * 1024 * FF, 32 * nb, 64 * kb, 32 * nb, scr, lane); continue; }
        r -= 4 * I_F;
        if (r < I_IN) { if (LATE) continue; const int kb = r / 96, nb = r % 96, n0 = 32 * nb; bf16* dst; int drow;
            if (n0 < 1024) { const int sec = n0 >> 9, nn = n0 & 511, h = nn >> 7, bj = (nn >> 6) & 1, jj0 = nn & 63; dst = (bf16*)(ws + WS_WIN); drow = 512 * sec + 256 * (h >> 1) + 128 * bj + 64 * (h & 1) + jj0; }
            else if (n0 < 1536) { dst = (bf16*)(ws + WS_WV); drow = n0 - 1024; }
            else { dst = (bf16*)(ws + WS_WIN); drow = n0 - 512; }
            transpose_item(ap->in[6], 3072, D, ap->in[5], dst, drow, 64 * kb, n0, scr, lane); continue; }
        r -= I_IN;
        if (r < I_OUT) { if (LATE) continue; const int kb = r / 32, nb = r % 32; transpose_item(ap->in[7], D, D, nullptr, (bf16*)(ws + WS_WOUT), 32 * nb, 64 * kb, 32 * nb, scr, lane); continue; }
        r -= I_OUT;
        if (r < 2 * I_GL) { if (!LATE) continue; const int wb = r >= I_GL; if (wb) r -= I_GL; const int kb = r / 32, nb = r % 32, n0 = 32 * nb;
            transpose_item(ap->in[wb ? 25 : 24], D, D, nullptr, (bf16*)(ws + WS_WGLU), 256 * (n0 >> 7) + (n0 & 127) + (wb ? 128 : 0), 64 * kb, n0, scr, lane); continue; }
        r -= 2 * I_GL;
        if (LATE) continue;
        { const int mat = r >> 3, g = mat >> 1, gate = mat & 1, kb = (r >> 2) & 1, nb = r & 3;
            transpose_item(ap->in[gate ? 13 : 11] + (size_t)g * 128 * 128, 128, 128, nullptr, (bf16*)(ws + WS_WLRU) + (size_t)mat * 128 * 128, 32 * nb, 64 * kb, 32 * nb, scr, lane); }
    }
}
__device__ __forceinline__ void p0_prologue(KArgP ap, LAS unsigned char* lds, int gw, int NGW, int wave, int lane) {
    unsigned char* ws = ap->ws;
    p0_weights<false>(ap, (LAS float*)(lds + wave * 16384), gw, NGW, lane);
    if (!LATE_IN_S5) p0_weights<true>(ap, (LAS float*)(lds + wave * 16384), gw, NGW, lane);
    { float* rope = (float*)(ws + WS_ROPE);
      for (int i = gw * 64 + lane; i < 2048 * 64; i += NGW * 64) { const int pos = i >> 6, j = i & 63; const double inv = pow(10000.0, -(double)j / 64.0); const double ang = (double)pos * inv;
          rope[2 * i] = (float)cos(ang); rope[2 * i + 1] = (float)sin(ang); } }
    { const float* x = ap->in[0]; bf16* xb = (bf16*)(ws + WS_XB); float* ssp = (float*)(ws + WS_SSP);
      for (int m0 = 2 * gw; m0 < TOK; m0 += 2 * NGW) { f32x4 v[2][4]; float s[2];
#pragma unroll
          for (int h = 0; h < 2; ++h) { const f32x4* xr = (const f32x4*)(x + (size_t)(m0 + h) * D) + lane;
#pragma unroll
              for (int j = 0; j < 4; ++j) v[h][j] = xr[64 * j]; }
#pragma unroll
          for (int h = 0; h < 2; ++h) { float t = 0.f;
#pragma unroll
              for (int j = 0; j < 4; ++j) t += (v[h][j][0] * v[h][j][0] + v[h][j][1] * v[h][j][1]) + (v[h][j][2] * v[h][j][2] + v[h][j][3] * v[h][j][3]);
              s[h] = wave_sum(t);
              v2u* o8 = (v2u*)(xb + (size_t)(m0 + h) * D) + lane;
#pragma unroll
              for (int j = 0; j < 4; ++j) { v2u w; w.x = cvt_pk_bf16(v[h][j][0], v[h][j][1]); w.y = cvt_pk_bf16(v[h][j][2], v[h][j][3]); o8[64 * j] = w; }
              if (lane < 16) ssp[(size_t)(m0 + h) * 32 + lane] = lane == 0 ? s[h] : 0.f; } } }
}

__device__ __forceinline__ void ret_unit(int b, int h, int p, const bf16* Q, const bf16* Kb, const bf16* Vt, const bf16* G, const float* ret_g, bf16* MRG, LAS unsigned char* lds, int tid, int wid, int lane) {
    const int fr = lane & 15, fq = lane >> 4;
    const int cq = 2 * p + (wid >> 2), iloc0 = 32 * (wid & 3);
    const size_t tok0 = (size_t)b * SEQ + 256 * p + 32 * wid;
    const float lg = log2f(1.0f - exp2f(-5.0f - (float)h));
    bf16x8 qf[2][4];
#pragma unroll
    for (int mi = 0; mi < 2; ++mi)
#pragma unroll
        for (int kk = 0; kk < 4; ++kk) qf[mi][kk] = *(const bf16x8*)(Q + (tok0 + 16 * mi + fr) * 512 + h * 128 + 32 * kk + 8 * fq);
    f32x4 O[2][8];
#pragma unroll
    for (int mi = 0; mi < 2; ++mi)
#pragma unroll
        for (int e = 0; e < 8; ++e) O[mi][e] = (f32x4){0.f, 0.f, 0.f, 0.f};
    const int nm = 2 * p + 2;
    const int srow = 4 * wid + (lane >> 4), keyK = ((wid >> 1) & 3) * 4 + (lane >> 4), keyV = 4 * (wid & 3) + (lane >> 4);
    const bf16* kbase = Kb + ((size_t)b * SEQ + srow) * 512 + h * 128 + 8 * ((lane & 15) ^ keyK);
    const bf16* vbase = Vt + ((size_t)(h * 128 + srow)) * VT_LD + (size_t)b * SEQ + 8 * ((lane & 15) ^ keyV);
#define RET_STAGE(m_, buf_) do { _Pragma("unroll") for (int i = 0; i < 4; ++i) { \
        __builtin_amdgcn_global_load_lds((const unsigned*)(kbase + ((size_t)(128 * (m_) + 32 * i)) * 512), (LAS unsigned*)(lds + (buf_) * 65536 + (8 * i + wid) * 1024), 16, 0, 0); \
        __builtin_amdgcn_global_load_lds((const unsigned*)(vbase + (size_t)(32 * i) * VT_LD + 128 * (m_)), (LAS unsigned*)(lds + (buf_) * 65536 + 32768 + (8 * i + wid) * 1024), 16, 0, 0); } } while (0)
    RET_STAGE(0, 0);
    asm volatile("s_waitcnt vmcnt(0)" ::: "memory"); __syncthreads();
    for (int m = 0; m < nm; ++m) {
        const int buf = m & 1;
        if (m + 1 < nm) RET_STAGE(m + 1, buf ^ 1);
        if (m <= cq) {
            const LAS unsigned char* Kl = lds + buf * 65536; const LAS unsigned char* Vl = Kl + 32768;
            const float sc = fast_exp2(lg * (float)(128 * (cq - m)));
#pragma unroll
            for (int g32 = 0; g32 < 4; ++g32) {
                f32x4 S[2][2];
#pragma unroll
                for (int n = 0; n < 2; ++n) { S[0][n] = (f32x4){0.f, 0.f, 0.f, 0.f}; S[1][n] = (f32x4){0.f, 0.f, 0.f, 0.f};
                    const int krow = 32 * g32 + 8 * (fr >> 2) + 4 * n + (fr & 3);
#pragma unroll
                    for (int kk = 0; kk < 4; ++kk) { const bf16x8 kf = *(const LAS bf16x8*)(Kl + krow * 256 + (((4 * kk + fq) ^ fr) << 4));
                        S[0][n] = mfma16(kf, qf[0][kk], S[0][n]); S[1][n] = mfma16(kf, qf[1][kk], S[1][n]); } }
                bf16x8 pf[2];
#pragma unroll
                for (int mi = 0; mi < 2; ++mi) { f32x4 v0 = S[mi][0] * sc, v1 = S[mi][1] * sc;
                    if (m == cq) { const int il = iloc0 + 16 * mi + fr, jl = 32 * g32 + 8 * fq;
#pragma unroll
                        for (int t = 0; t < 4; ++t) { v0[t] = (jl + t <= il) ? v0[t] : 0.f; v1[t] = (jl + 4 + t <= il) ? v1[t] : 0.f; } }
                    const pg8::u32x4 w = pack8(v0, v1); pf[mi] = __builtin_bit_cast(bf16x8, w); }
#pragma unroll
                for (int ef = 0; ef < 8; ++ef) { const int vrow = 16 * ef + fr;
                    const bf16x8 vf = *(const LAS bf16x8*)(Vl + vrow * 256 + (((4 * g32 + fq) ^ fr) << 4));
                    O[0][ef] = mfma16(vf, pf[0], O[0][ef]); O[1][ef] = mfma16(vf, pf[1], O[1][ef]); }
            }
        }
        asm volatile("s_waitcnt vmcnt(0)" ::: "memory"); __syncthreads();
    }
#undef RET_STAGE
#pragma unroll
    for (int mi = 0; mi < 2; ++mi) { const size_t tok = tok0 + 16 * mi + fr; float s = 0.f;
#pragma unroll
        for (int ef = 0; ef < 8; ++ef) s += (O[mi][ef][0] + O[mi][ef][1]) + (O[mi][ef][2] + O[mi][ef][3]);
        s += __shfl_xor(s, 16); s += __shfl_xor(s, 32); const float mu = s * (1.0f / 128.0f); float q = 0.f;
#pragma unroll
        for (int ef = 0; ef < 8; ++ef) { const f32x4 d = O[mi][ef] - mu; q += (d[0] * d[0] + d[1] * d[1]) + (d[2] * d[2] + d[3] * d[3]); }
        q += __shfl_xor(q, 16); q += __shfl_xor(q, 32); const float rstd = 1.0f / sqrtf(q * (1.0f / 128.0f) + 1e-6f);
#pragma unroll
        for (int ef = 0; ef < 8; ++ef) { const int col = h * 128 + 16 * ef + 4 * fq; const f32x4 gn = *(const f32x4*)(ret_g + col); const v2u gr = *(const v2u*)(G + tok * 1536 + col);
            const float g0 = bf_lo(gr.x), g1 = bf_hi(gr.x), g2 = bf_lo(gr.y), g3 = bf_hi(gr.y);
            const float y0 = (O[mi][ef][0] - mu) * rstd * gn[0] * silu_f(g0), y1 = (O[mi][ef][1] - mu) * rstd * gn[1] * silu_f(g1);
            const float y2 = (O[mi][ef][2] - mu) * rstd * gn[2] * silu_f(g2), y3 = (O[mi][ef][3] - mu) * rstd * gn[3] * silu_f(g3);
            v2u w; w.x = cvt_pk_bf16(y0, y1); w.y = cvt_pk_bf16(y2, y3); *(v2u*)(MRG + tok * 1024 + col) = w; } }
}

constexpr int LRU_XT = 0, LRU_A = 66560, LRU_BX = 99328, LRU_WF = 132096, LRU_CW = 148480, LRU_CB = 150528, LRU_SEG = 151040, LRU_CAR = 155136;
__device__ __forceinline__ void lru_unit(int b, int g, int q, const bf16* G, const bf16* LW, const float* conv_w, const float* conv_b, const float* b_a, const float* b_i, const float* lam,
                                         bf16* MRG, LAS unsigned char* lds, int tid, int wid, int lane) {
    const int fr = lane & 15, fq = lane >> 4;
    LAS unsigned char* XT = lds + LRU_XT; LAS float* A_ = (LAS float*)(lds + LRU_A); LAS float* BX = (LAS float*)(lds + LRU_BX); LAS unsigned char* WF = lds + LRU_WF;
    LAS float* CW = (LAS float*)(lds + LRU_CW); LAS float* CB = (LAS float*)(lds + LRU_CB); LAS float* SEG = (LAS float*)(lds + LRU_SEG); LAS float* CAR = (LAS float*)(lds + LRU_CAR);
    const bf16* xl = G + (size_t)b * SEQ * 1536 + 512 + 128 * g;
    {
      for (int i = tid; i < 64 * 16; i += 512) { const int r = i >> 4, c = i & 15; const v4u w = *(const v4u*)(LW + ((size_t)((g * 2 + (r >> 5)) * 128 + 32 * q + (r & 31))) * 128 + 8 * c); *(LAS v4u*)(WF + r * 256 + ((c ^ (r & 15)) << 4)) = w; }
      CW[tid] = conv_w[(tid >> 7) * 512 + 128 * g + (tid & 127)]; if (tid < 128) CB[tid] = conv_b[128 * g + tid]; }
    f32x4 gba[2], gbi[2], gsp[2];
#pragma unroll
    for (int nfl = 0; nfl < 2; ++nfl) { const int cg0 = 128 * g + 32 * q + 16 * nfl + 4 * fq; gba[nfl] = *(const f32x4*)(b_a + cg0); gbi[nfl] = *(const f32x4*)(b_i + cg0); const f32x4 lm = *(const f32x4*)(lam + cg0);
#pragma unroll
        for (int t = 0; t < 4; ++t) gsp[nfl][t] = -8.0f * 1.4426950408889634f * log1pf(__expf(-lm[t])); }
    for (int tile = 0; tile < 8; ++tile) {
        { v4u xs[9];
#pragma unroll
          for (int k9 = 0; k9 < 9; ++k9) { const int i = tid + 512 * k9, j = (i >> 4) < 258 ? (i >> 4) : 258, c = i & 15, sp = 256 * tile - 3 + j;
              xs[k9] = *(const v4u*)(xl + (size_t)(sp < 0 ? 0 : sp) * 1536 + 8 * c); if (sp < 0) xs[k9] = (v4u){0u, 0u, 0u, 0u}; }
#pragma unroll
          for (int k9 = 0; k9 < 9; ++k9) { const int i = tid + 512 * k9, j = i >> 4, c = i & 15; if (i < 259 * 16) *(LAS v4u*)(XT + j * 256 + ((c ^ (j & 15)) << 4)) = xs[k9]; } }
        __syncthreads();
        const int r0 = 32 * wid;
        f32x4 acc[2][4];
#pragma unroll
        for (int mi = 0; mi < 2; ++mi)
#pragma unroll
            for (int nf = 0; nf < 4; ++nf) acc[mi][nf] = (f32x4){0.f, 0.f, 0.f, 0.f};
#pragma unroll 1
        for (int kk = 0; kk < 4; ++kk) { const int c16 = 4 * kk + fq, ch0 = 8 * c16;
            bf16x8 wf[4];
#pragma unroll
            for (int nf = 0; nf < 4; ++nf) { const int r = 32 * (nf >> 1) + 16 * (nf & 1) + fr; wf[nf] = *(const LAS bf16x8*)(WF + r * 256 + ((c16 ^ (r & 15)) << 4)); }
            f32x4 cw[4][2], cb[2];
            cb[0] = *(const LAS f32x4*)(CB + ch0); cb[1] = *(const LAS f32x4*)(CB + ch0 + 4);
#pragma unroll
            for (int tap = 0; tap < 4; ++tap) { cw[tap][0] = *(const LAS f32x4*)(CW + tap * 128 + ch0); cw[tap][1] = *(const LAS f32x4*)(CW + tap * 128 + ch0 + 4); }
#pragma unroll
            for (int mi = 0; mi < 2; ++mi) { float xc[8];
                xc[0] = cb[0][0]; xc[1] = cb[0][1]; xc[2] = cb[0][2]; xc[3] = cb[0][3]; xc[4] = cb[1][0]; xc[5] = cb[1][1]; xc[6] = cb[1][2]; xc[7] = cb[1][3];
#pragma unroll
                for (int tap = 0; tap < 4; ++tap) { const int j = r0 + 16 * mi + fr + tap; const v4u x4 = *(const LAS v4u*)(XT + j * 256 + ((c16 ^ (j & 15)) << 4)); const f32x4 w0 = cw[tap][0], w1 = cw[tap][1];
                    xc[0] += w0[0] * bf_lo(x4.x); xc[1] += w0[1] * bf_hi(x4.x); xc[2] += w0[2] * bf_lo(x4.y); xc[3] += w0[3] * bf_hi(x4.y);
                    xc[4] += w1[0] * bf_lo(x4.z); xc[5] += w1[1] * bf_hi(x4.z); xc[6] += w1[2] * bf_lo(x4.w); xc[7] += w1[3] * bf_hi(x4.w); }
                pg8::u32x4 aw; aw.x = cvt_pk_bf16(xc[0], xc[1]); aw.y = cvt_pk_bf16(xc[2], xc[3]); aw.z = cvt_pk_bf16(xc[4], xc[5]); aw.w = cvt_pk_bf16(xc[6], xc[7]);
                const bf16x8 af = __builtin_bit_cast(bf16x8, aw);
#pragma unroll
                for (int nf = 0; nf < 4; ++nf) acc[mi][nf] = mfma16(wf[nf], af, acc[mi][nf]); } }
#pragma unroll
        for (int nfl = 0; nfl < 2; ++nfl) { const int cl_ = 32 * q + 16 * nfl + 4 * fq, c16 = cl_ >> 3, sub = (cl_ & 7) * 2;
            f32x4 gcw[4]; const f32x4 gcb = *(const LAS f32x4*)(CB + cl_);
#pragma unroll
            for (int tap = 0; tap < 4; ++tap) gcw[tap] = *(const LAS f32x4*)(CW + tap * 128 + cl_);
#pragma unroll
            for (int mi = 0; mi < 2; ++mi) { f32x4 xc = gcb;
#pragma unroll
                for (int tap = 0; tap < 4; ++tap) { const int j = r0 + 16 * mi + fr + tap; const v2u xv = *(const LAS v2u*)(XT + j * 256 + ((c16 ^ (j & 15)) << 4) + sub); const f32x4 w0 = gcw[tap];
                    xc[0] += w0[0] * bf_lo(xv.x); xc[1] += w0[1] * bf_hi(xv.x); xc[2] += w0[2] * bf_lo(xv.y); xc[3] += w0[3] * bf_hi(xv.y); }
                f32x4 av, bv;
#pragma unroll
                for (int t = 0; t < 4; ++t) { const float r = sigmoid_f(acc[mi][nfl][t] + gba[nfl][t]), ig = sigmoid_f(acc[mi][nfl + 2][t] + gbi[nfl][t]);
                    const float a_ = fast_exp2(r * gsp[nfl][t]); av[t] = a_; bv[t] = sqrtf(fmaxf(1.0f - a_ * a_, 0.f)) * ig * xc[t]; }
                const int rt = r0 + 16 * mi + fr;
                *(LAS f32x4*)(A_ + rt * 32 + 16 * nfl + 4 * fq) = av; *(LAS f32x4*)(BX + rt * 32 + 16 * nfl + 4 * fq) = bv; } }
        __syncthreads();
        const int c = tid & 31, seg = tid >> 5;
        float sa[16], sb[16];
#pragma unroll
        for (int k = 0; k < 16; ++k) { sa[k] = A_[(16 * seg + k) * 32 + c]; sb[k] = BX[(16 * seg + k) * 32 + c]; }
        const size_t tokb = (size_t)b * SEQ + 256 * tile + 16 * seg;
        float gl[16];
#pragma unroll
        for (int k = 0; k < 16; ++k) gl[k] = bf1(G[(tokb + k) * 1536 + 1024 + 128 * g + 32 * q + c]);
        { float P = 1.f, hl = 0.f;
#pragma unroll
          for (int k = 0; k < 16; ++k) { hl = sa[k] * hl + sb[k]; P *= sa[k]; }
          SEG[(seg * 32 + c) * 2] = P; SEG[(seg * 32 + c) * 2 + 1] = hl; }
        __syncthreads();
        float hin = tile == 0 ? 0.f : CAR[(tile & 1) * 32 + c];
        { f32x2 sg[15];
#pragma unroll
          for (int s2 = 0; s2 < 15; ++s2) sg[s2] = *(const LAS f32x2*)(SEG + (s2 * 32 + c) * 2);
#pragma unroll
          for (int s2 = 0; s2 < 15; ++s2) if (s2 < seg) hin = sg[s2][0] * hin + sg[s2][1]; }
#pragma unroll
        for (int k = 0; k < 16; ++k) { hin = sa[k] * hin + sb[k];
            MRG[(tokb + k) * 1024 + 512 + 128 * g + 32 * q + c] = (bf16)f2bf(hin * gelu_tanh_f(gl[k])); }
        if (seg == 15) CAR[((tile + 1) & 1) * 32 + c] = hin;
        __syncthreads();
    }
}

constexpr int S5_WLDS = 28672, S5_NB = SEQ / 16;
__device__ __forceinline__ void s5_pair(int b, int g, bool helper, KArgP ap, const bf16* xh, const LAS float* rsl, bf16* YS, LAS unsigned char* wl, int lane) {
    const float* lam_re = ap->in[16]; const float* lam_im = ap->in[17]; const float* log_dt = ap->in[18]; const float* b_re = ap->in[19]; const float* b_im = ap->in[20];
    const float* c_re = ap->in[21]; const float* c_im = ap->in[22]; const float* dsk = ap->in[23]; const float* gmix = ap->in[5] + D;
    LAS float* BU = (LAS float*)wl; LAS unsigned char* Hh = wl + 16384; LAS float* U = (LAS float*)(wl + 16384 + 8704);
    const float dt = __expf(log_dt[g]);
    const int c16 = lane & 15, kq = lane >> 4, kh = kq & 1;
    const size_t tokb = (size_t)b * SEQ;
#define S5_BAR() do { LDS_WAIT(); asm volatile("" ::: "memory"); __builtin_amdgcn_s_barrier(); asm volatile("" ::: "memory"); } while (0)
    if (helper) {
        bf16x8 bfr[8];
#pragma unroll
        for (int j = 0; j < 8; ++j) { const int pp = 16 * (j & 3) + c16, comp = j >> 2;
            const float re = lam_re[g * 64 + pp], im = lam_im[g * 64 + pp], mag = __expf(re * dt), lbr = mag * cosf(im * dt), lbi = mag * sinf(im * dt);
            const float den = re * re + im * im, nr = lbr - 1.0f, ni = lbi, fre = (nr * re + ni * im) / den, fim = (ni * re - nr * im) / den;
            const f32x4* pr = (const f32x4*)(b_re + ((size_t)(g * 64 + pp)) * 16 + 8 * kh); const f32x4* pi = (const f32x4*)(b_im + ((size_t)(g * 64 + pp)) * 16 + 8 * kh);
            const f32x4 r0 = pr[0], r1 = pr[1], i0 = pi[0], i1 = pi[1]; f32x4 o0, o1;
#pragma unroll
            for (int t = 0; t < 4; ++t) { o0[t] = comp ? (fre * i0[t] + fim * r0[t]) : (fre * r0[t] - fim * i0[t]); o1[t] = comp ? (fre * i1[t] + fim * r1[t]) : (fre * r1[t] - fim * i1[t]); }
            pg8::u32x4 w = pack8(o0, o1); if (kq >= 2) w = (pg8::u32x4){0u, 0u, 0u, 0u}; bfr[j] = __builtin_bit_cast(bf16x8, w); }
        bf16x8 cfr[4];
#pragma unroll
        for (int kk = 0; kk < 4; ++kk) { const int p0 = 16 * kk + 4 * kq;
            const f32x4 cr = *(const f32x4*)(c_re + ((size_t)(g * 16 + c16)) * 64 + p0), ci = *(const f32x4*)(c_im + ((size_t)(g * 16 + c16)) * 64 + p0);
            pg8::u32x4 w; w.x = cvt_pk_bf16(cr[0], -ci[0]); w.y = cvt_pk_bf16(cr[1], -ci[1]); w.z = cvt_pk_bf16(cr[2], -ci[2]); w.w = cvt_pk_bf16(cr[3], -ci[3]); cfr[kk] = __builtin_bit_cast(bf16x8, w); }
        const f32x4 dch4 = *(const f32x4*)(dsk + 16 * g + 4 * kq);
        const f32x4 gm0 = *(const f32x4*)(gmix + 16 * g + 8 * kh), gm1 = *(const f32x4*)(gmix + 16 * g + 8 * kh + 4);
        const bf16* xrow = xh + (tokb + c16) * D + 16 * g + 8 * kh;
        v4u xq[2]; xq[0] = *(const v4u*)(xrow); xq[1] = *(const v4u*)(xrow + (size_t)16 * D);
#define S5_A(kb_, xq_) do { const int kb__ = (kb_); const float rs_ = rsl[16 * kb__ + c16]; \
            f32x4 u0_ = pg8::up_lo((xq_).x, (xq_).y) * rs_ * gm0, u1_ = pg8::up_lo((xq_).z, (xq_).w) * rs_ * gm1; \
            { const int nb_ = kb__ + 2 < S5_NB ? kb__ + 2 : S5_NB - 1; (xq_) = *(const v4u*)(xrow + (size_t)(16 * nb_) * D); } \
            *(LAS f32x4*)(U + (kb__ % 3) * 256 + c16 * 16 + 8 * kh + 4 * (kq >> 1)) = (kq & 2) ? u1_ : u0_; \
            pg8::u32x4 uw_ = pack8(u0_, u1_); if (kq >= 2) uw_ = (pg8::u32x4){0u, 0u, 0u, 0u}; const bf16x8 uf_ = __builtin_bit_cast(bf16x8, uw_); \
            _Pragma("unroll") for (int j = 0; j < 4; ++j) { const f32x4 z_ = (f32x4){0.f, 0.f, 0.f, 0.f}; const f32x4 dr_ = mfma16(uf_, bfr[j], z_), di_ = mfma16(uf_, bfr[j + 4], z_); \
                _Pragma("unroll") for (int r = 0; r < 4; ++r) *(LAS f32x2*)(BU + (kb__ & 1) * 2048 + (4 * kq + r) * 128 + 2 * (16 * j + c16)) = (f32x2){dr_[r], di_[r]}; } } while (0)
#define S5_C(kb_) do { const int kc__ = (kb_), bf_ = kc__ & 1; f32x4 ya_ = (f32x4){0.f, 0.f, 0.f, 0.f}, yb_ = ya_; \
            _Pragma("unroll") for (int kk = 0; kk < 4; kk += 2) { const bf16x8 h0_ = *(const LAS bf16x8*)(Hh + bf_ * 4352 + c16 * 272 + (32 * kk + 8 * kq) * 2), h1_ = *(const LAS bf16x8*)(Hh + bf_ * 4352 + c16 * 272 + (32 * (kk + 1) + 8 * kq) * 2); \
                ya_ = mfma16(cfr[kk], h0_, ya_); yb_ = mfma16(cfr[kk + 1], h1_, yb_); }        \
            const f32x4 uu_ = *(const LAS f32x4*)(U + (kc__ % 3) * 256 + c16 * 16 + 4 * kq); const f32x4 yv_ = (ya_ + yb_) + dch4 * uu_; \
            v2u w_; w_.x = cvt_pk_bf16(gelu_tanh_f(yv_[0]), gelu_tanh_f(yv_[1])); w_.y = cvt_pk_bf16(gelu_tanh_f(yv_[2]), gelu_tanh_f(yv_[3])); \
            *(v2u*)(YS + (tokb + 16 * kc__ + c16) * 1024 + 16 * g + 4 * kq) = w_; } while (0)
        S5_A(0, xq[0]); S5_BAR();
        S5_A(1, xq[1]); S5_BAR();
        for (int i = 2; i < S5_NB; i += 2) { S5_A(i, xq[0]); S5_C(i - 2); S5_BAR(); S5_A(i + 1, xq[1]); S5_C(i - 1); S5_BAR(); }
        S5_C(S5_NB - 2); S5_BAR();
        S5_C(S5_NB - 1);
#undef S5_A
#undef S5_C
    } else {
        float lr, li;
        { const float re = lam_re[g * 64 + lane], im = lam_im[g * 64 + lane], mag = __expf(re * dt); lr = mag * cosf(im * dt); li = mag * sinf(im * dt); }
        float hre = 0.f, him = 0.f;
#define S5_B(kb_) do { const int bf_ = (kb_) & 1; f32x2 bu_[16]; \
            _Pragma("unroll") for (int t = 0; t < 16; ++t) bu_[t] = *(const LAS f32x2*)(BU + bf_ * 2048 + t * 128 + 2 * lane); \
            _Pragma("unroll") for (int t = 0; t < 16; ++t) { const float nr_ = lr * hre - li * him + bu_[t][0], ni_ = lr * him + li * hre + bu_[t][1]; hre = nr_; him = ni_; \
                *(LAS unsigned*)(Hh + bf_ * 4352 + t * 272 + 4 * lane) = cvt_pk_bf16(nr_, ni_); } } while (0)
        S5_BAR();
        for (int i = 1; i <= S5_NB; ++i) { S5_B(i - 1); S5_BAR(); }
#undef S5_B
    }
#undef S5_BAR
}

#define XB_TMO      128
#define XB_XCNT(j)  (256  + 64 * (j))
#define XB_XSUB(j)  (1280 + 64 * (j))
#define XB_XGEN(j)  (2304 + 64 * (j))
#define XB_TOP      3328
#define XB_TOPGEN   3392
#define XCD_BAR_WORDS 3456
#define XB_SPIN_CAP (1u << 18)

__device__ __forceinline__ unsigned xb_ld(unsigned* p)              { return __hip_atomic_load(p, __ATOMIC_RELAXED, __HIP_MEMORY_SCOPE_AGENT); }
__device__ __forceinline__ unsigned xb_add(unsigned* p, unsigned v) { return __hip_atomic_fetch_add(p, v, __ATOMIC_RELAXED, __HIP_MEMORY_SCOPE_AGENT); }
__device__ __forceinline__ unsigned xb_xcc_id() { return (unsigned)__builtin_amdgcn_s_getreg((3 << 11) | 20) & 0xFu; }
#define XB_SPIN(cond, bar) do { unsigned _sp = 0; while (cond) { __builtin_amdgcn_s_sleep(1); \
    if ((++_sp & 255u) == 0u) { if (xb_ld(&(bar)[XB_TMO])) break; if (_sp > XB_SPIN_CAP) { atomicAdd(&(bar)[XB_TMO], 1u); break; } } } } while (0)

struct XcdBarrier {
    unsigned* bar; unsigned x; unsigned G;
    volatile LAS unsigned* st;
};

__device__ __forceinline__ XcdBarrier xcd_barrier_post(unsigned* bar, volatile LAS unsigned* st, int tid, unsigned G) {
    XcdBarrier b; b.bar = bar; b.x = xb_xcc_id(); b.st = st; b.G = G;
    if (tid == 0) (void)xb_add(&bar[XB_XCNT(b.x)], 1u);
    return b;
}
__device__ __forceinline__ void xcd_barrier_complete(unsigned* bar, unsigned x, unsigned G, unsigned& nloc, unsigned& nx) {
    unsigned sum, cnt, mine, sp = 0u;
    for (;;) {
        sum = 0u; cnt = 0u; mine = 0u;
#pragma unroll
        for (unsigned j = 0; j < 16; ++j) { const unsigned c = xb_ld(&bar[XB_XCNT(j)]); sum += c; cnt += (c > 0u) ? 1u : 0u; mine = (j == x) ? c : mine; }
        if (sum == G) break;
        __builtin_amdgcn_s_sleep(1);
        if ((++sp & 255u) == 0u) { if (xb_ld(&bar[XB_TMO])) break; if (sp > XB_SPIN_CAP) { atomicAdd(&bar[XB_TMO], 1u); break; } }
    }
    nloc = mine > 0u ? mine : 1u; nx = cnt > 0u ? cnt : 1u;
}

__device__ __forceinline__ void xcd_barrier(const XcdBarrier& b, int tid) {
    asm volatile("s_waitcnt vmcnt(0)" ::: "memory");
    __syncthreads();
    if (tid == 0) {
        unsigned* bar = b.bar;
        __builtin_amdgcn_s_waitcnt(0);
        unsigned nloc = b.st[0], nx = b.st[1];
        if (nloc == 0u) { xcd_barrier_complete(bar, b.x, b.G, nloc, nx); b.st[0] = nloc; b.st[1] = nx; }
        const unsigned old = xb_add(&bar[XB_XSUB(b.x)], 1u);
        const unsigned gen = old / nloc;
        if (old + 1u == (gen + 1u) * nloc) {
            __builtin_amdgcn_fence(__ATOMIC_RELEASE, "agent");
            asm volatile("s_waitcnt vmcnt(0)" ::: "memory");
            const unsigned og = xb_add(&bar[XB_TOP], 1u);
            const unsigned tg = og / nx;
            if (og + 1u == (tg + 1u) * nx) xb_add(&bar[XB_TOPGEN], 1u);
            else XB_SPIN(xb_ld(&bar[XB_TOPGEN]) == tg, bar);
            __builtin_amdgcn_fence(__ATOMIC_ACQUIRE, "agent");
            xb_add(&bar[XB_XGEN(b.x)], 1u);
            asm volatile("s_waitcnt vmcnt(0)" ::: "memory");
        } else {
            XB_SPIN(xb_ld(&bar[XB_XGEN(b.x)]) == gen, bar);
            __builtin_amdgcn_fence(__ATOMIC_ACQUIRE, "agent");
            asm volatile("s_waitcnt vmcnt(0)" ::: "memory");
        }
    }
    __syncthreads();
}

__device__ __forceinline__ int lane_id() { return (int)__builtin_amdgcn_mbcnt_hi(~0u, __builtin_amdgcn_mbcnt_lo(~0u, 0u)); }
struct HotOrder {
    int c;
    __device__ bool next(int i, pg8::Unit& u) const { if (i >= 11) return false; u.pm = c & 3; u.pn = (c >> 2) & 1; return true; }
    __device__ __forceinline__ void a_ready(const pg8::Unit&) const {}
    __device__ __forceinline__ void done(const pg8::Unit&) const {}
};
template <int ph> __device__ __forceinline__ void phase_body(LAS unsigned char* lds, int wave) {
    int lane_ = lane_id(); asm volatile("" : "+v"(lane_));
    const int lane = lane_, tid = wave * 64 + lane;
    const int G_ = gridDim.x, bx = blockIdx.x;
    const int gw = bx * NWAVES + wave, NGW = G_ * NWAVES;
      const int grp = bx & 1, cl = (bx >> 3) * 4 + ((bx & 7) >> 1), GL = G_ >> 1; constexpr int TOKH = TOK / 2; const size_t R0 = (size_t)grp * TOKH;
    (void)GL; (void)cl; (void)R0;
    KArgP ap = (KArgP)__builtin_amdgcn_kernarg_segment_ptr(); asm volatile("" : "+s"(ap));
    unsigned char* ws = ap->ws;
    float* X = ap->out;
    bf16* XB = (bf16*)(ws + WS_XB); bf16* XLO = (bf16*)(ws + WS_XLO); float* SSP = (float*)(ws + WS_SSP); bf16* HID = (bf16*)(ws + WS_R1); bf16* MRG = (bf16*)(ws + WS_MRG);
    (void)gw; (void)NGW; (void)lane; (void)X; (void)XB; (void)XLO; (void)SSP; (void)HID; (void)MRG;
        if constexpr (ph == 0 && (PHM & 1)) { p0_prologue(ap, lds, gw, NGW, wave, lane); }
        else if constexpr ((PHM & 2) && (ph == 1 || ph == 6 || ph == 8 || ph == 12)) {
            const int l = ph == 1 ? 0 : ph == 6 ? 1 : ph == 8 ? 2 : 3;
            pg8::Gemm g{XB + R0 * D, (const bf16*)(ws + WS_W13) + (size_t)l * 5632 * 1024, TOKH, 5632, D}; pg8::StaticOrder S; S.init(TOKH, 5632, GL, cl, 4);
            LAS float* rs_tab = (LAS float*)(lds + 131072 + 16384);
            int pmA = -1, pmB = -1, pmC = -1; { pg8::Unit u0; for (int i = 0; S.next(i, u0); ++i) { if (pmA < 0) pmA = u0.pm; else if (u0.pm != pmA && pmB < 0) pmB = u0.pm; else if (u0.pm != pmA && u0.pm != pmB && pmB >= 0 && pmC < 0) pmC = u0.pm; } }
            if (pmB < 0) pmB = pmA; if (pmC < 0) pmC = pmB;
            { const float* sp = SSP + R0 * 32; const int np = (ph == 12 ? 32 : 16);
#pragma unroll
              for (int s3 = 0; s3 < 3; ++s3) { const int p = s3 == 0 ? pmA : (s3 == 1 ? pmB : pmC); const int row = 256 * p + (tid >> 1); const float rs = row_rs(sp, np, row); if ((tid & 1) == 0) rs_tab[s3 * 256 + (tid >> 1)] = rs; } }
            __syncthreads();
            pg8::EpiSwiglu E{HID + R0 * FF, FF, rs_tab, pmA, pmB};
            pg8::gemm_phase<pg8::EpiSwiglu, pg8::StaticOrder, true, true>(lds, g, S, E, tid);
        }
        else if constexpr ((PHM & 4) && (ph == 2 || ph == 7 || ph == 9 || ph == 13 || ph == 5)) {
            const int l = ph == 2 ? 0 : ph == 7 ? 1 : ph == 9 ? 2 : 3;
            pg8::Gemm g; g.M = TOKH; g.N = D;
            if (ph == 5) { g.A = MRG + R0 * D; g.Bt = (const bf16*)(ws + WS_WOUT); g.K = D; } else { g.A = HID + R0 * FF; g.Bt = (const bf16*)(ws + WS_W2) + (size_t)l * 1024 * FF; g.K = FF; }
            pg8::StaticOrder S; S.init(TOKH, D, GL, cl, 4);
            pg8::EpiResid E{ph == 2 ? ap->in[0] + R0 * D : nullptr, XB + R0 * D, XLO + R0 * D, SSP + R0 * 32, ph == 5 ? 1.0f : 0.5f};
            pg8::gemm_phase<pg8::EpiResid, pg8::StaticOrder, true, true>(lds, g, S, E, tid);
        }
        else if constexpr ((PHM & 8) && ph == 3) {
            { pg8::Gemm g{XB + R0 * D, (const bf16*)(ws + WS_WIN), TOKH, 1024, D}; pg8::StaticOrder S; S.init(TOKH, 1024, GL, cl, 4);
              pg8::EpiRope E{(bf16*)(ws + WS_Q) + R0 * 512, (bf16*)(ws + WS_K) + R0 * 512, (const float*)(ws + WS_ROPE), SSP + R0 * 32, 16, (LAS f32x4*)(lds + 131072) + 2 * tid, -1};
              pg8::gemm_phase<pg8::EpiRope, pg8::StaticOrder, true, true>(lds, g, S, E, tid); }
            { pg8::Gemm g{XB + R0 * D, (const bf16*)(ws + WS_WIN) + (size_t)1024 * 1024, TOKH, 1536, D}; pg8::StaticOrder S; S.init(TOKH, 1536, GL, cl, 4);
              pg8::EpiScaled E{(bf16*)(ws + WS_G) + R0 * 1536, 1536, SSP + R0 * 32, 16, (LAS f32x4*)(lds + 131072) + 2 * tid, -1};
              pg8::gemm_phase<pg8::EpiScaled, pg8::StaticOrder, true, true>(lds, g, S, E, tid); }
            { pg8::Gemm g{(const bf16*)(ws + WS_WV), XB + R0 * D, 512, TOKH, D}; pg8::StaticOrder S; S.init(512, TOKH, GL, cl, 4);
              pg8::EpiPlain E{(bf16*)(ws + WS_VT) + R0, VT_LD};
              pg8::gemm_phase<pg8::EpiPlain, pg8::StaticOrder, true, true>(lds, g, S, E, tid); }
        }
        else if constexpr ((PHM & 16) && ph == 4) {
#ifndef NO_RET
            for (int i = 0; i < ((PROBE_MIXM & 1) ? 4 : 2); ++i) { const int bh = cl >> 2, pp = cl & 3, p = (i & 1) == 0 ? pp : 7 - pp;
                ret_unit(8 * grp + (bh >> 2), bh & 3, p, (const bf16*)(ws + WS_Q), (const bf16*)(ws + WS_K), (const bf16*)(ws + WS_VT), (const bf16*)(ws + WS_G), ap->in[8], MRG, lds, tid, wave, lane); }
#endif
#ifndef NO_LRU
            for (int rep = 0; rep < ((PROBE_MIXM & 2) ? 2 : 1); ++rep)
            lru_unit(8 * grp + (cl >> 4), (cl >> 2) & 3, cl & 3, (const bf16*)(ws + WS_G), (const bf16*)(ws + WS_WLRU), ap->in[9], ap->in[10], ap->in[12], ap->in[14], ap->in[15], MRG, lds, tid, wave, lane);
#endif
        }
        else if constexpr ((PHM & 32) && ph == 10) {
            LAS float* rsl = (LAS float*)(lds + 4 * S5_WLDS);
            { const int bb = 8 * grp + ((cl * 4) >> 6); float r4[4];
#pragma unroll
              for (int i = 0; i < 4; ++i) r4[i] = row_rs(SSP, 16, bb * SEQ + 4 * tid + i);
              *(LAS f32x4*)(rsl + 4 * tid) = (f32x4){r4[0], r4[1], r4[2], r4[3]}; }
            __syncthreads();
            { const int unit = cl * 4 + (wave & 3); s5_pair(8 * grp + (unit >> 6), unit & 63, wave >= 4, ap, XB, rsl, MRG, lds + (wave & 3) * S5_WLDS, lane); }
            if (LATE_IN_S5) { __syncthreads(); p0_weights<true>(ap, (LAS float*)(lds + wave * 8448), cl * 8 + wave, GL * 8, lane); }
        }
        else if constexpr ((PHM & 64) && ph == 11) {
            pg8::Gemm g{MRG + R0 * D, (const bf16*)(ws + WS_WGLU), TOKH, 2048, D}; pg8::StaticOrder S; S.init(TOKH, 2048, GL, cl, 4);
            pg8::EpiGluResid E{XB + R0 * D, XLO + R0 * D, SSP + R0 * 32};
            pg8::gemm_phase<pg8::EpiGluResid, pg8::StaticOrder, true, true>(lds, g, S, E, tid);
        }
        else if constexpr ((PHM & 128) && ph == 14) {
            const float* gf = ap->in[26];
            static_assert(RESID_LO == 0, "the final norm reads the bf16 residual stream only");
            const f32x4* gr = (const f32x4*)gf + lane; f32x4 gg[4];
#pragma unroll
            for (int j = 0; j < 4; ++j) gg[j] = gr[64 * j];
            for (int m0 = (int)R0 + 2 * (cl * NWAVES + wave); m0 < (int)R0 + TOKH; m0 += 2 * GL * NWAVES) {
                v2u h2[2][4]; float rs[2];
#pragma unroll
                for (int h = 0; h < 2; ++h) { const v2u* hr = (const v2u*)(XB + (size_t)(m0 + h) * D) + lane;
#pragma unroll
                    for (int j = 0; j < 4; ++j) h2[h][j] = hr[64 * j];
                    rs[h] = row_rs(SSP, 16, m0 + h); }
#pragma unroll
                for (int h = 0; h < 2; ++h) { f32x4* orow = (f32x4*)(X + (size_t)(m0 + h) * D) + lane;
#pragma unroll
                    for (int j = 0; j < 4; ++j) orow[64 * j] = pg8::up_lo(h2[h][j].x, h2[h][j].y) * rs[h] * gg[j]; } }
        }
}
__global__ void __launch_bounds__(NWAVES * 64, 2) mega_fwd(Args a_) {
    extern __shared__ __attribute__((aligned(16))) unsigned char lds_raw[];
    LAS unsigned char* lds = (LAS unsigned char*)lds_raw;
    cg::grid_group grid = cg::this_grid();
    const int ph_lo = a_.ph_lo, ph_hi = a_.ph_hi;
    const int wave = __builtin_amdgcn_readfirstlane((int)(threadIdx.x >> 6));
    volatile LAS unsigned* bst = (volatile LAS unsigned*)(lds + LDS_BYTES - 32);
    { const int t0 = wave * 64 + lane_id(); if (t0 < 4) bst[t0] = 0u; }
    __syncthreads();
    const int grp_ = (int)blockIdx.x & 1;
    XcdBarrier barG = xcd_barrier_post((unsigned*)a_.ws + 4096 * (1 + grp_), bst + 2, wave * 64 + lane_id(), gridDim.x >> 1);
#define SEAM(k) do { if ((k) == 0) { grid.sync(); if (SKEW_TICKS && grp_) { const unsigned long long t0 = __builtin_amdgcn_s_memrealtime(); while (__builtin_amdgcn_s_memrealtime() - t0 < SKEW_TICKS) __builtin_amdgcn_s_sleep(32); } } \
                     else xcd_barrier(barG, wave * 64 + lane_id()); } while (0)
#define PHASE(k) if (ph_lo <= (k) && (k) < ph_hi) { if ((PROBE_DUPM >> (k)) & 1) { phase_body<k>(lds, wave); if ((k) == 0) grid.sync(); else xcd_barrier(barG, wave * 64 + lane_id()); } phase_body<k>(lds, wave); if ((k) + 1 < ph_hi) SEAM(k); }
    PHASE(0) PHASE(1) PHASE(2) PHASE(3) PHASE(4) PHASE(5) PHASE(6) PHASE(7) PHASE(8) PHASE(9) PHASE(10) PHASE(11) PHASE(12) PHASE(13) PHASE(14)
#undef PHASE
#undef SEAM
}

extern "C" void kernel_launch(void* const* d_in, const int* in_sizes, int n_in, void* d_out, int out_size, void* d_ws, size_t ws_size, hipStream_t stream) {
    static int grid = 0;
    if (grid == 0) {
        if (n_in != 27 || in_sizes[0] != TOK * D || out_size != TOK * D || ws_size < WS_END) { fprintf(stderr, "kernel_launch: unexpected shapes (n_in %d, in0 %d, out %d, ws %zu)\n", n_in, n_in > 0 ? in_sizes[0] : -1, out_size, ws_size); grid = -1; return; }
        int dev = 0, cus = 0, per_cu = 0;
        (void)hipGetDevice(&dev); (void)hipDeviceGetAttribute(&cus, hipDeviceAttributeMultiprocessorCount, dev);
        if (hipFuncSetAttribute((const void*)mega_fwd, hipFuncAttributeMaxDynamicSharedMemorySize, LDS_BYTES) != hipSuccess) { fprintf(stderr, "kernel_launch: hipFuncSetAttribute failed\n"); grid = -1; return; }
        if (hipOccupancyMaxActiveBlocksPerMultiprocessor(&per_cu, (const void*)mega_fwd, NWAVES * 64, LDS_BYTES) != hipSuccess || per_cu < 1) { fprintf(stderr, "kernel_launch: occupancy query says %d blocks per CU\n", per_cu); per_cu = 1; }
        (void)hipGetLastError();
        grid = cus * 1;
    }
    if (grid < 0) return;
    (void)hipMemsetAsync(d_ws, 0, 65536, stream);
    Args a{};
    for (int i = 0; i < 27; ++i) a.in[i] = (const float*)d_in[i];
    a.out = (float*)d_out; a.ws = (unsigned char*)d_ws;
#if MK_PER_PHASE
    for (int ph = 0; ph < NPH; ++ph) { a.ph_lo = ph; a.ph_hi = ph + 1; hipLaunchKernelGGL(mega_fwd, dim3(grid), dim3(NWAVES * 64), LDS_BYTES, stream, a); }
#else
    a.ph_lo = 0; a.ph_hi = NPH;
    void* params[] = {&a};
    const hipError_t e = hipLaunchCooperativeKernel((const void*)mega_fwd, dim3(grid), dim3(NWAVES * 64), params, LDS_BYTES, stream);
    if (e != hipSuccess) fprintf(stderr, "kernel_launch: cooperative launch failed: %s (grid %d)\n", hipGetErrorString(e), grid);
#endif
}
```
